# Optimizing an MI355X kernel written in HIP

```python
import math
import numpy as np
import jax
import jax.numpy as jnp
from jax import lax

D_MODEL = 2048
BATCH = 1
SEQ = 8192
DEPTH = 2

MLA_HEADS = 8
MLA_Q_RANK = 512
MLA_KV_RANK = 256
MLA_NOPE = 128
MLA_ROPE = 64
MLA_V = 128
ROPE_THETA = 10000.0
Q_BLOCK = 128
GLA_HEADS = 4
GLA_DK = 64
GLA_DV = 128
GLA_GATE_RANK = 16
GLA_TAU = 16.0
GLA_CHUNK = 64
SWA_HEADS = 8
SWA_KV_HEADS = 2
SWA_HD = 64
SWA_WINDOW = 128
SWA_BLOCK = 128
REL_BUCKETS = 32
REL_MAX_DIST = 128
D_FF = 5632
N_EXPERTS = 8
TOP_K = 2
PLE_DIM = 256
LN_EPS = 1e-5
RMS_EPS = 1e-6
DEEPNORM_ALPHA = (2 * DEPTH) ** 0.25
DEEPNORM_BETA = (8 * DEPTH) ** -0.25

IN_SIZES = (
    MLA_Q_RANK, MLA_KV_RANK, MLA_ROPE,
    GLA_HEADS * GLA_DK, GLA_HEADS * GLA_DK, GLA_HEADS * GLA_DV,
    GLA_GATE_RANK, GLA_HEADS * GLA_DV,
    SWA_HEADS * SWA_HD, SWA_KV_HEADS * SWA_HD, SWA_KV_HEADS * SWA_HD,
)
IN_COLS = sum(IN_SIZES)
IN_SPLITS = tuple(int(v) for v in np.cumsum(IN_SIZES)[:-1])
MIX_WIDTH = MLA_HEADS * MLA_V + GLA_HEADS * GLA_DV + SWA_HEADS * SWA_HD

kernel_name = 'hybrid_mla_gla_swa_moe_block'


def layer_norm(x, g, b):
    xf = x.astype(jnp.float32)
    mu = jnp.mean(xf, -1, keepdims=True)
    var = jnp.mean(jnp.square(xf - mu), -1, keepdims=True)
    return ((xf - mu) * lax.rsqrt(var + LN_EPS) * g + b).astype(x.dtype)


def rms_norm(x, g):
    xf = x.astype(jnp.float32)
    return (xf * lax.rsqrt(jnp.mean(jnp.square(xf), -1, keepdims=True) + RMS_EPS) * g).astype(x.dtype)


def rope(x, positions):
    half = x.shape[-1] // 2
    inv = ROPE_THETA ** (-jnp.arange(half, dtype=jnp.float32) / half)
    ang = positions.astype(jnp.float32)[..., None] * inv
    ang = ang.reshape(ang.shape[:2] + (1,) * (x.ndim - 3) + (half,))
    cos, sin = jnp.cos(ang), jnp.sin(ang)
    xf = x.astype(jnp.float32)
    x1, x2 = xf[..., :half], xf[..., half:]
    return jnp.concatenate([x1 * cos - x2 * sin, x2 * cos + x1 * sin], -1).astype(x.dtype)


def mla_attention(q_a, kv_a, k_rope, positions, q_a_gain, w_q_b, kv_a_gain, w_kv_b):
    B, S, _ = q_a.shape
    H = MLA_HEADS
    q = (rms_norm(q_a, q_a_gain) @ w_q_b).reshape(B, S, H, MLA_NOPE + MLA_ROPE)
    q_nope, q_pe = q[..., :MLA_NOPE], rope(q[..., MLA_NOPE:], positions)
    kv = (rms_norm(kv_a, kv_a_gain) @ w_kv_b).reshape(B, S, H, MLA_NOPE + MLA_V)
    k_nope, v = kv[..., :MLA_NOPE], kv[..., MLA_NOPE:]
    k_pe = rope(k_rope, positions)
    scale = (MLA_NOPE + MLA_ROPE) ** -0.5
    nb = S // Q_BLOCK
    qn_b = q_nope.reshape(B, nb, Q_BLOCK, H, MLA_NOPE).transpose(1, 0, 2, 3, 4)
    qp_b = q_pe.reshape(B, nb, Q_BLOCK, H, MLA_ROPE).transpose(1, 0, 2, 3, 4)
    key_pos = jnp.arange(S)

    def block(args):
        i, qn, qp = args
        s = (jnp.einsum('bqhd,bkhd->bhqk', qn, k_nope).astype(jnp.float32)
             + jnp.einsum('bqhd,bkd->bhqk', qp, k_pe).astype(jnp.float32)) * scale
        qpos = i * Q_BLOCK + jnp.arange(Q_BLOCK)
        s = jnp.where(key_pos[None, :] <= qpos[:, None], s, -jnp.inf)
        pr = jax.nn.softmax(s, axis=-1).astype(v.dtype)
        return jnp.einsum('bhqk,bkhd->bqhd', pr, v)

    out = lax.map(block, (jnp.arange(nb), qn_b, qp_b))
    return out.transpose(1, 0, 2, 3, 4).reshape(B, S, H * MLA_V)


def gla_attention(q, k, v, g_lr, r, w_gate_up, b_gate_up, norm_gain):
    B, S, _ = q.shape
    H, DK, DV, C = GLA_HEADS, GLA_DK, GLA_DV, GLA_CHUNK
    nc = S // C
    f32 = jnp.float32
    gk = jax.nn.log_sigmoid((g_lr @ w_gate_up + b_gate_up).astype(f32)) / GLA_TAU

    def to_chunks(t, d):
        return t.astype(f32).reshape(B, nc, C, H, d).transpose(1, 0, 3, 2, 4)

    qc = to_chunks(q, DK) * (DK ** -0.5)
    kc, vc, gc = to_chunks(k, DK), to_chunks(v, DV), to_chunks(gk, DK)
    causal = jnp.tril(jnp.ones((C, C), dtype=bool))

    def step(state, inp):
        qi, ki, vi, gi = inp
        b = jnp.cumsum(gi, axis=2)
        o_inter = jnp.einsum('bhcd,bhde->bhce', qi * jnp.exp(b), state)
        diff = b[:, :, :, None, :] - b[:, :, None, :, :]
        decay = jnp.exp(jnp.where(causal[:, :, None], diff, -jnp.inf))
        attn = jnp.einsum('bhid,bhjd,bhijd->bhij', qi, ki, decay)
        o_intra = jnp.einsum('bhij,bhje->bhie', attn, vi)
        b_last = b[:, :, -1:, :]
        new_state = (jnp.exp(b_last[:, :, 0, :])[..., None] * state
                     + jnp.einsum('bhcd,bhce->bhde', ki * jnp.exp(b_last - b), vi))
        return new_state, o_inter + o_intra

    _, o = lax.scan(step, jnp.zeros((B, H, DK, DV), f32), (qc, kc, vc, gc))
    o = o.transpose(1, 0, 3, 2, 4).reshape(B, S, H, DV)
    o = rms_norm(o, norm_gain.reshape(H, DV)).reshape(B, S, H * DV)
    return (o * jax.nn.silu(r.astype(f32))).astype(q.dtype)


def t5_bucket(dist):
    max_exact = REL_BUCKETS // 2
    d = jnp.maximum(dist, 1).astype(jnp.float32)
    large = max_exact + (jnp.log(d / max_exact) / math.log(REL_MAX_DIST / max_exact)
                         * (REL_BUCKETS - max_exact)).astype(jnp.int32)
    large = jnp.minimum(large, REL_BUCKETS - 1)
    return jnp.where(dist < max_exact, dist, large)


def swa_attention(q, k, v, sinks, rel_bias):
    B, S, _ = q.shape
    HK, G, D, L = SWA_KV_HEADS, SWA_HEADS // SWA_KV_HEADS, SWA_HD, SWA_BLOCK
    nb = S // L
    qb = q.reshape(B, nb, L, HK, G, D)

    def with_prev(t):
        t = t.reshape(B, nb, L, HK, D)
        prev = jnp.pad(t, ((0, 0), (1, 0), (0, 0), (0, 0), (0, 0)))[:, :-1]
        return jnp.concatenate([prev, t], axis=2)

    kw, vw = with_prev(k), with_prev(v)
    s = jnp.einsum('bnqhgd,bnkhd->bnhgqk', qb, kw).astype(jnp.float32) * (D ** -0.5)
    qi = jnp.arange(L)[:, None]
    kj = jnp.arange(2 * L)[None, :]
    dist = qi + L - kj
    bias = rel_bias[t5_bucket(jnp.clip(dist, 0, None))].astype(jnp.float32)
    s = s + bias.transpose(2, 0, 1).reshape(HK, G, L, 2 * L)
    in_window = (dist >= 0) & (dist < SWA_WINDOW)
    real_key = (jnp.arange(nb)[:, None, None] > 0) | (kj >= L)[None]
    mask = in_window[None] & real_key
    s = jnp.where(mask[None, :, None, None], s, -jnp.inf)
    sink = jnp.broadcast_to(sinks.astype(jnp.float32).reshape(HK, G)[None, None, :, :, None, None],
                            s.shape[:-1] + (1,))
    pr = jax.nn.softmax(jnp.concatenate([s, sink], -1), axis=-1)[..., :-1]
    o = jnp.einsum('bnhgqk,bnkhd->bnqhgd', pr.astype(v.dtype), vw)
    return o.reshape(B, S, SWA_HEADS * D)


def token_mixer(x, positions, w_in, q_a_gain, w_q_b, kv_a_gain, w_kv_b,
                gla_w_gate, gla_b_gate, gla_norm_gain, sinks, rel_bias, w_out):
    h = x @ w_in
    (q_a, kv_a, k_rope, g_q, g_k, g_v, g_lr, g_r, s_q, s_k, s_v) = jnp.split(h, IN_SPLITS, axis=-1)
    a = mla_attention(q_a, kv_a, k_rope, positions, q_a_gain, w_q_b, kv_a_gain, w_kv_b)
    b = gla_attention(g_q, g_k, g_v, g_lr, g_r, gla_w_gate, gla_b_gate, gla_norm_gain)
    c = swa_attention(s_q, s_k, s_v, sinks, rel_bias)
    return jnp.concatenate([a, b.astype(a.dtype), c], axis=-1) @ w_out


def swiglu(x, w_gate, w_up, w_down):
    return (jax.nn.silu(x @ w_gate) * (x @ w_up)) @ w_down


def moe_swiglu(x, w_router, w_gate, w_up, w_down):
    logits = (x @ w_router).astype(jnp.float32)
    top_val, top_idx = lax.top_k(logits, TOP_K)
    top_w = jax.nn.softmax(top_val, axis=-1)
    combine = jnp.sum(jax.nn.one_hot(top_idx, N_EXPERTS, dtype=jnp.float32) * top_w[..., None], axis=-2)
    out = jnp.zeros(x.shape, jnp.float32)
    for e in range(N_EXPERTS):
        out = out + combine[..., e:e + 1] * swiglu(x, w_gate[e], w_up[e], w_down[e]).astype(jnp.float32)
    return out.astype(x.dtype)


def setup_inputs(seed: int = 0) -> dict:
    key = jax.random.key(seed)
    ks = jax.random.split(key, 32)
    f32 = jnp.float32

    def nrm(i, shape, scale):
        return jax.random.normal(ks[i], shape, f32) * scale

    n_dense = (DEPTH + 1) // 2
    n_moe = DEPTH // 2
    return {
        'x': nrm(0, (BATCH, SEQ, D_MODEL), 1.0),
        'p': nrm(1, (DEPTH, BATCH, SEQ, PLE_DIM), 1.0),
        'positions': jnp.broadcast_to(jnp.arange(SEQ, dtype=jnp.int32), (BATCH, SEQ)),
        'w_in': nrm(2, (DEPTH, D_MODEL, IN_COLS), D_MODEL ** -0.5),
        'mla_q_a_gain': 1.0 + nrm(3, (DEPTH, MLA_Q_RANK), 0.02),
        'mla_w_q_b': nrm(4, (DEPTH, MLA_Q_RANK, MLA_HEADS * (MLA_NOPE + MLA_ROPE)), MLA_Q_RANK ** -0.5),
        'mla_kv_a_gain': 1.0 + nrm(5, (DEPTH, MLA_KV_RANK), 0.02),
        'mla_w_kv_b': nrm(6, (DEPTH, MLA_KV_RANK, MLA_HEADS * (MLA_NOPE + MLA_V)), MLA_KV_RANK ** -0.5),
        'gla_w_gate': nrm(7, (DEPTH, GLA_GATE_RANK, GLA_HEADS * GLA_DK), GLA_GATE_RANK ** -0.5),
        'gla_b_gate': nrm(8, (DEPTH, GLA_HEADS * GLA_DK), 0.1),
        'gla_norm_gain': 1.0 + nrm(9, (DEPTH, GLA_HEADS * GLA_DV), 0.02),
        'swa_sinks': nrm(10, (DEPTH, SWA_HEADS), 1.0),
        'rel_bias': nrm(11, (REL_BUCKETS, SWA_HEADS), 0.5),
        'w_out': nrm(12, (DEPTH, MIX_WIDTH, D_MODEL), DEEPNORM_BETA * MIX_WIDTH ** -0.5),
        'ln1_g': 1.0 + nrm(13, (DEPTH, D_MODEL), 0.02),
        'ln1_b': nrm(14, (DEPTH, D_MODEL), 0.02),
        'ffn_w_gate': nrm(15, (n_dense, D_MODEL, D_FF), D_MODEL ** -0.5),
        'ffn_w_up': nrm(16, (n_dense, D_MODEL, D_FF), D_MODEL ** -0.5),
        'ffn_w_down': nrm(17, (n_dense, D_FF, D_MODEL), DEEPNORM_BETA * D_FF ** -0.5),
        'moe_router': nrm(18, (n_moe, D_MODEL, N_EXPERTS), D_MODEL ** -0.5),
        'moe_w_gate': nrm(19, (n_moe, N_EXPERTS, D_MODEL, D_FF), D_MODEL ** -0.5),
        'moe_w_up': nrm(20, (n_moe, N_EXPERTS, D_MODEL, D_FF), D_MODEL ** -0.5),
        'moe_w_down': nrm(21, (n_moe, N_EXPERTS, D_FF, D_MODEL), DEEPNORM_BETA * D_FF ** -0.5),
        'ple_w_up': nrm(22, (DEPTH, PLE_DIM, D_MODEL), DEEPNORM_BETA * PLE_DIM ** -0.5),
        'ple_w_gate': nrm(23, (DEPTH, D_MODEL, D_MODEL), D_MODEL ** -0.5),
        'ple_b_gate': nrm(24, (DEPTH, D_MODEL), 0.02),
        'ln2_g': 1.0 + nrm(25, (DEPTH, D_MODEL), 0.02),
        'ln2_b': nrm(26, (DEPTH, D_MODEL), 0.02),
    }


def reference(x, p, positions, w_in, mla_q_a_gain, mla_w_q_b, mla_kv_a_gain, mla_w_kv_b,
              gla_w_gate, gla_b_gate, gla_norm_gain, swa_sinks, rel_bias, w_out, ln1_g, ln1_b,
              ffn_w_gate, ffn_w_up, ffn_w_down, moe_router, moe_w_gate, moe_w_up, moe_w_down,
              ple_w_up, ple_w_gate, ple_b_gate, ln2_g, ln2_b):
    for i in range(DEPTH):
        m = token_mixer(x, positions, w_in[i], mla_q_a_gain[i], mla_w_q_b[i], mla_kv_a_gain[i],
                        mla_w_kv_b[i], gla_w_gate[i], gla_b_gate[i], gla_norm_gain[i],
                        swa_sinks[i], rel_bias, w_out[i])
        x = layer_norm(DEEPNORM_ALPHA * x + m, ln1_g[i], ln1_b[i])
        if i % 2 == 0:
            j = i // 2
            f = swiglu(x, ffn_w_gate[j], ffn_w_up[j], ffn_w_down[j])
        else:
            j = i // 2
            f = moe_swiglu(x, moe_router[j], moe_w_gate[j], moe_w_up[j], moe_w_down[j])
        ple = (p[i] @ ple_w_up[i]) * jax.nn.sigmoid(x @ ple_w_gate[i] + ple_b_gate[i])
        x = layer_norm(DEEPNORM_ALPHA * x + f + ple, ln2_g[i], ln2_b[i])
    return x
```

```cpp
#include <hip/hip_runtime.h>
#include <cstdio>
#include <cstdint>
namespace pg8 {
#define PG8_LAS __attribute__((address_space(3)))
typedef unsigned short bf16_t;
typedef short bf16x8 __attribute__((ext_vector_type(8)));
typedef float f32x4 __attribute__((ext_vector_type(4)));
typedef unsigned u32x4 __attribute__((ext_vector_type(4)));
constexpr int BM = 256, BK = 64, HALF = 128, HTB = HALF * BK * 2  , STAGE_BYTES = 8 * HTB, NXCD = 8, WGM = 8;

__host__ __device__ __forceinline__ int lds_byte(int r, int c) { const int st = (r >> 4) * 2 + (c >> 5), rr = r & 15, cc = c & 31, ob = rr * 64 + cc * 2; return st * 1024 + (ob ^ (((ob >> 9) & 1) << 5)); }
__host__ __device__ __forceinline__ void stage_rc(int b, int& R, int& C) { const int st = b / 1024, sb = b % 1024, swz = sb ^ (((sb >> 9) & 1) << 5); R = (st >> 1) * 16 + swz / 64; C = (st & 1) * 32 + (swz % 64) / 2; }
__host__ __device__ __forceinline__ int perm32(int rho) { const int n = rho >> 4, i = rho & 15; return 8 * (i >> 2) + 4 * n + (i & 3); }

struct Unit { int pm, pn, pb, rows; };
struct Gemm { const bf16_t* A; const bf16_t* Bt; int lda, ldb, K; };

struct StaticOrder {
    static constexpr bool PARTIAL = false;
    int nM, nN, nwg, G, c;
    __host__ __device__ void init(int M, int N, int G_, int c_) { nM = M / BM; nN = N / BM; nwg = nM * nN; G = G_; c = c_; }
    __host__ __device__ bool next(int i, Unit& u) const {
        const long L = (long)i * G + c; if (L >= nwg) return false;
        int wgid = (int)L; { const int q = nwg / NXCD, r = nwg % NXCD, xcd = wgid % NXCD, off = wgid / NXCD; wgid = (xcd < r ? xcd * (q + 1) : r * (q + 1) + (xcd - r) * q) + off; }
        const int nig = WGM * nN, gid = wgid / nig, fm = gid * WGM, gsz = (nM - fm) < WGM ? (nM - fm) : WGM;
        u.pm = fm + ((wgid % nig) % gsz); u.pn = (wgid % nig) / gsz; u.pb = u.pn; u.rows = BM; return true;
    }
    __device__ __forceinline__ void a_ready(const Unit&) const {}
    __device__ __forceinline__ void done(const Unit&) const {}
};
#ifndef MOE_PARTIAL
#define MOE_PARTIAL false
#endif
template <int nN> struct MoeOrder {
    static constexpr bool PARTIAL = MOE_PARTIAL;
    const PG8_LAS int* te; const PG8_LAS int* trow; const PG8_LAS int* tval; int ntiles, G, c;
    __device__ __forceinline__ bool next(int i, Unit& u) const {
        const int L = i * G + c; if (L >= ntiles * nN) return false;
        const int idx = L / nN; u.pn = L - idx * nN; u.pm = trow[idx]; u.pb = te[idx] * nN + u.pn; u.rows = tval[idx]; return true;
    }
    __device__ __forceinline__ void a_ready(const Unit&) const {}
    __device__ __forceinline__ void done(const Unit&) const {}
};
typedef float f32x2v __attribute__((ext_vector_type(2))); typedef __bf16 bf16x2v __attribute__((ext_vector_type(2)));
__device__ __forceinline__ unsigned cvt_pk_bf16(float lo, float hi) { const f32x2v v = {lo, hi}; const bf16x2v r = __builtin_convertvector(v, bf16x2v); return __builtin_bit_cast(unsigned, r); }
typedef float f32x2 __attribute__((ext_vector_type(2)));
__device__ __forceinline__ float fast_sigmoid(float v) { return __builtin_amdgcn_rcpf(1.0f + __builtin_amdgcn_exp2f(-1.4426950408889634f * v)); }
__device__ __forceinline__ u32x4 pack8(const f32x4 a, const f32x4 b) { u32x4 w; w.x = cvt_pk_bf16(a[0], a[1]); w.y = cvt_pk_bf16(a[2], a[3]); w.z = cvt_pk_bf16(b[0], b[1]); w.w = cvt_pk_bf16(b[2], b[3]); return w; }
__device__ __forceinline__ void rope8(f32x4& a, f32x4& b, const f32x4 c4, const f32x4 s4) {
    const f32x4 a0 = a, b0 = b;
    a[0] = a0[0] * c4[0] - a0[1] * s4[0]; a[1] = a0[1] * c4[0] + a0[0] * s4[0];
    a[2] = a0[2] * c4[1] - a0[3] * s4[1]; a[3] = a0[3] * c4[1] + a0[2] * s4[1];
    b[0] = b0[0] * c4[2] - b0[1] * s4[2]; b[1] = b0[1] * c4[2] + b0[0] * s4[2];
    b[2] = b0[2] * c4[3] - b0[3] * s4[3]; b[3] = b0[3] * c4[3] + b0[2] * s4[3];
}
struct EpiIn {
    static constexpr bool PERM = true, AFTER_DRAIN = false;
    bf16_t* H; int ldc; float* ssq; const float* cs;
    __device__ __forceinline__ void operator()(const f32x4 (&acc)[2][2][4][2], const Unit& u, int wr, int wc, int fr, int fq) const {
        const int row0 = u.pm * BM + wr * 64 + fr, col0 = u.pn * BM + wc * 32 + 8 * fq;
#pragma unroll
        for (int ai = 0; ai < 2; ++ai)
#pragma unroll
            for (int m = 0; m < 4; ++m) { const int row = row0 + ai * HALF + m * 16; bf16_t* rowp = H + (size_t)row * ldc + col0; float s = 0.f;
#pragma unroll
                for (int bj = 0; bj < 2; ++bj) { f32x4 v0 = acc[ai][bj][m][0], v1 = acc[ai][bj][m][1];
                    if (bj == 0 && u.pn == 3 && wc < 2) { const int p0 = (wc * 32 + 8 * fq) >> 1; const f32x4 c4 = *(const f32x4*)(cs + (size_t)row * 64 + p0), s4 = *(const f32x4*)(cs + (size_t)row * 64 + 32 + p0); rope8(v0, v1, c4, s4); }
                    s += (v0[0] * v0[0] + v0[1] * v0[1]) + (v0[2] * v0[2] + v0[3] * v0[3]) + (v1[0] * v1[0] + v1[1] * v1[1]) + (v1[2] * v1[2] + v1[3] * v1[3]);
                    *(u32x4*)(rowp + bj * HALF) = pack8(v0, v1); }
                if (u.pn < 3) { s += __shfl_xor(s, 16); s += __shfl_xor(s, 32); if (fq == 0) ssq[(size_t)row * 12 + u.pn * 4 + wc] = s; } }
    }
};
template <bool ISQ> struct EpiUp {
    static constexpr bool PERM = true, AFTER_DRAIN = false;
    bf16_t* O; int ldc; const float* ssq; const float* cs;
    __device__ __forceinline__ void operator()(const f32x4 (&acc)[2][2][4][2], const Unit& u, int wr, int wc, int fr, int fq) const {
        const int row0 = u.pm * BM + wr * 64 + fr, col0 = u.pn * BM + wc * 32 + 8 * fq;
#pragma unroll
        for (int ai = 0; ai < 2; ++ai)
#pragma unroll
            for (int m = 0; m < 4; ++m) { const int row = row0 + ai * HALF + m * 16; bf16_t* rowp = O + (size_t)row * ldc + col0;
                const float* sp = ssq + (size_t)row * 12 + (ISQ ? 0 : 8); float r;
                if (ISQ) { const f32x4 a = *(const f32x4*)sp, b = *(const f32x4*)(sp + 4);
                    const float s = ((a[0] + a[1]) + (a[2] + a[3])) + ((b[0] + b[1]) + (b[2] + b[3])); r = 1.0f / sqrtf(s * (1.0f / 512.0f) + 1e-6f); }
                else { const f32x4 a = *(const f32x4*)sp; const float s = (a[0] + a[1]) + (a[2] + a[3]); r = 1.0f / sqrtf(s * (1.0f / 256.0f) + 1e-6f); }
#pragma unroll
                for (int bj = 0; bj < 2; ++bj) { f32x4 v0 = acc[ai][bj][m][0] * r, v1 = acc[ai][bj][m][1] * r;
                    if (ISQ) { const int col = col0 + bj * HALF, hc = col % 192;
                        if (hc >= 128) { const int p0 = (hc - 128) >> 1; const f32x4 c4 = *(const f32x4*)(cs + (size_t)row * 64 + p0), s4 = *(const f32x4*)(cs + (size_t)row * 64 + 32 + p0); rope8(v0, v1, c4, s4); } }
                    *(u32x4*)(rowp + bj * HALF) = pack8(v0, v1); } }
    }
};
struct EpiOutRes {
    static constexpr bool PERM = false, AFTER_DRAIN = false;
    float* C; int ldc; const bf16_t* res; float alpha;
    __device__ __forceinline__ void operator()(const f32x4 (&acc)[2][2][4][2], const Unit& u, int wr, int wc, int fr, int fq) const {
        const int row0 = u.pm * BM + wr * 64 + fr, col0 = u.pn * BM + wc * 32 + 4 * fq;
        typedef unsigned u32x2 __attribute__((ext_vector_type(2)));
#pragma unroll
        for (int ai = 0; ai < 2; ++ai)
#pragma unroll
            for (int m = 0; m < 4; ++m) { const size_t ro = (size_t)(row0 + ai * HALF + m * 16) * ldc + col0;
#pragma unroll
                for (int bj = 0; bj < 2; ++bj)
#pragma unroll
                    for (int n = 0; n < 2; ++n) { f32x4 v = acc[ai][bj][m][n]; const u32x2 r = *(const u32x2*)(res + ro + bj * HALF + n * 16);
                        v[0] += alpha * __builtin_bit_cast(float, r.x << 16); v[1] += alpha * __builtin_bit_cast(float, r.x & 0xffff0000u);
                        v[2] += alpha * __builtin_bit_cast(float, r.y << 16); v[3] += alpha * __builtin_bit_cast(float, r.y & 0xffff0000u);
                        *(f32x4*)(C + ro + bj * HALF + n * 16) = v; } }
    }
};
struct EpiBf16 {
    static constexpr bool PERM = true, AFTER_DRAIN = false;
    bf16_t* O; int ldc;
    __device__ __forceinline__ void operator()(const f32x4 (&acc)[2][2][4][2], const Unit& u, int wr, int wc, int fr, int fq) const {
        const int row0 = u.pm * BM + wr * 64 + fr, col0 = u.pn * BM + wc * 32 + 8 * fq;
#pragma unroll
        for (int ai = 0; ai < 2; ++ai)
#pragma unroll
            for (int m = 0; m < 4; ++m) { bf16_t* rowp = O + (size_t)(row0 + ai * HALF + m * 16) * ldc + col0;
#pragma unroll
                for (int bj = 0; bj < 2; ++bj) *(u32x4*)(rowp + bj * HALF) = pack8(acc[ai][bj][m][0], acc[ai][bj][m][1]); }
    }
};
template <int MODE> struct EpiPle {
    static constexpr bool PERM = true, AFTER_DRAIN = false;
    bf16_t* C; int ldc; const float* bias;
    __device__ __forceinline__ void operator()(const f32x4 (&acc)[2][2][4][2], const Unit& u, int wr, int wc, int fr, int fq) const {
        const int row0 = u.pm * BM + wr * 64 + fr, col0 = u.pn * BM + wc * 32 + 8 * fq;
#pragma unroll
        for (int ai = 0; ai < 2; ++ai)
#pragma unroll
            for (int m = 0; m < 4; ++m) { bf16_t* rowp = C + (size_t)(row0 + ai * HALF + m * 16) * ldc + col0;
#pragma unroll
                for (int bj = 0; bj < 2; ++bj) { f32x4 v0 = acc[ai][bj][m][0], v1 = acc[ai][bj][m][1]; bf16_t* cp = rowp + bj * HALF;
                    if (MODE == 0) { const f32x4 b0 = *(const f32x4*)(bias + col0 + bj * HALF), b1 = *(const f32x4*)(bias + col0 + bj * HALF + 4); v0 = v0 + b0; v1 = v1 + b1;
#pragma unroll
                        for (int e = 0; e < 4; ++e) { v0[e] = fast_sigmoid(v0[e]); v1[e] = fast_sigmoid(v1[e]); } }
                    else { const u32x4 s = *(const u32x4*)cp;
                        v0[0] *= __builtin_bit_cast(float, s.x << 16); v0[1] *= __builtin_bit_cast(float, s.x & 0xffff0000u); v0[2] *= __builtin_bit_cast(float, s.y << 16); v0[3] *= __builtin_bit_cast(float, s.y & 0xffff0000u);
                        v1[0] *= __builtin_bit_cast(float, s.z << 16); v1[1] *= __builtin_bit_cast(float, s.z & 0xffff0000u); v1[2] *= __builtin_bit_cast(float, s.w << 16); v1[3] *= __builtin_bit_cast(float, s.w & 0xffff0000u); }
                    *(u32x4*)cp = pack8(v0, v1); } }
    }
};
struct EpiSwiGLU {
    static constexpr bool PERM = true, AFTER_DRAIN = false;
    bf16_t* O; int ldc;
    __device__ __forceinline__ void operator()(const f32x4 (&acc)[2][2][4][2], const Unit& u, int wr, int wc, int fr, int fq) const {
        const int row0 = u.pm * BM + wr * 64 + fr, col0 = u.pn * HALF + wc * 32 + 8 * fq;
#pragma unroll
        for (int ai = 0; ai < 2; ++ai)
#pragma unroll
            for (int m = 0; m < 4; ++m) { bf16_t* rowp = O + (size_t)(row0 + ai * HALF + m * 16) * ldc + col0;
                f32x4 o[2];
#pragma unroll
                for (int n = 0; n < 2; ++n) { const f32x4 g = acc[ai][0][m][n], up = acc[ai][1][m][n];
#pragma unroll
                    for (int e = 0; e < 4; ++e) o[n][e] = g[e] * fast_sigmoid(g[e]) * up[e]; }
                *(u32x4*)rowp = pack8(o[0], o[1]); }
    }
};
template <class Epi, class Sched, bool ALIGN_EPI = false, bool SP2 = false>
__device__ __forceinline__ void gemm_phase(PG8_LAS unsigned char* lds, const Gemm g, const Sched& S, const Epi& E, const int tid) {
    const int wid = __builtin_amdgcn_readfirstlane(tid >> 6), lane = tid & 63, wr = wid >> 2, wc = wid & 3, fr = lane & 15, fq = lane >> 4;
    const int K = g.K, nt = K / BK;
    unsigned voffA[2], voffB[2];
#pragma unroll
    for (int i = 0; i < 2; ++i) { int R, C; stage_rc(tid * 16 + i * 8192, R, C); const int Rb = Epi::PERM ? ((R & ~31) + perm32(R & 31)) : R;
        voffA[i] = (unsigned)(R * g.lda + C) * 2u; voffB[i] = (unsigned)(Rb * g.ldb + C) * 2u; }
    const size_t kstep = (size_t)(BK * 2);
    const size_t hstepA = (size_t)HALF * g.lda * 2, hstepB = (size_t)HALF * g.ldb * 2;
    const size_t tstepA = 2 * hstepA, tstepB = 2 * hstepB;
    const unsigned ldsw = (unsigned)wid * 1024u;
    const int aoff = lds_byte(wr * 64 + fr, fq * 8), boff = lds_byte(wc * 32 + fr, fq * 8);
#define PG8_SA(b, h) (((b) * 2 + (h)) * HTB)
#define PG8_SB(b, h) ((4 + (b) * 2 + (h)) * HTB)
#define PG8_STAGE(bufoff, gbase, voff) do { _Pragma("unroll") for (int _i = 0; _i < 2; ++_i) \
        __builtin_amdgcn_global_load_lds((const unsigned*)((const char*)(gbase) + (voff)[_i]), (PG8_LAS unsigned*)(lds + (bufoff) + ldsw + _i * 8192), 16, 0, 0); } while (0)
#define PG8_LDA(dst, b, h) do { _Pragma("unroll") for (int m = 0; m < 4; ++m) _Pragma("unroll") for (int k = 0; k < 2; ++k) dst[m][k] = *(const PG8_LAS bf16x8*)(lds + PG8_SA(b, h) + aoff + m * 2048 + k * 1024); } while (0)
#define PG8_LDB(dst, b, h) do { _Pragma("unroll") for (int n = 0; n < 2; ++n) _Pragma("unroll") for (int k = 0; k < 2; ++k) dst[n][k] = *(const PG8_LAS bf16x8*)(lds + PG8_SB(b, h) + boff + n * 2048 + k * 1024); } while (0)
#define PG8_MMA(ai, bj, At, Bt) do { __builtin_amdgcn_s_setprio(1); _Pragma("unroll") for (int m = 0; m < 4; ++m) _Pragma("unroll") for (int n = 0; n < 2; ++n) _Pragma("unroll") for (int k = 0; k < 2; ++k) \
        acc[ai][bj][m][n] = __builtin_amdgcn_mfma_f32_16x16x32_bf16(Bt[n][k], At[m][k], acc[ai][bj][m][n], 0, 0, 0); __builtin_amdgcn_s_setprio(0); } while (0)
#define PG8_MMAG(ai, bj, At, Bt) do { if (Sched::PARTIAL && !((ai) == 0 ? on0 : on1)) break; __builtin_amdgcn_s_setprio(1); _Pragma("unroll") for (int m = 0; m < 4; ++m) _Pragma("unroll") for (int n = 0; n < 2; ++n) _Pragma("unroll") for (int k = 0; k < 2; ++k) \
        acc[ai][bj][m][n] = __builtin_amdgcn_mfma_f32_16x16x32_bf16(Bt[n][k], At[m][k], acc[ai][bj][m][n], 0, 0, 0); __builtin_amdgcn_s_setprio(0); } while (0)
#define PG8_WAIT_V(n) asm volatile("s_waitcnt vmcnt(" #n ")" ::: "memory")
#define PG8_WAIT_L(n) asm volatile("s_waitcnt lgkmcnt(" #n ")" ::: "memory")
#define PG8_BAR __builtin_amdgcn_s_barrier()
#define PG8_SCHED __builtin_amdgcn_sched_barrier(0)
    Unit cur, nxt; int ui = 0;
    if (!S.next(0, cur)) return;
    bool on0 = true, on1 = true;
    if constexpr (Sched::PARTIAL) { on0 = cur.rows > wr * 64; on1 = cur.rows > HALF + wr * 64; }
    f32x4 acc[2][2][4][2];
#pragma unroll
    for (int a = 0; a < 2; ++a)
#pragma unroll
        for (int b = 0; b < 2; ++b)
#pragma unroll
            for (int m = 0; m < 4; ++m)
#pragma unroll
                for (int n = 0; n < 2; ++n) acc[a][b][m][n] = (f32x4){0.f, 0.f, 0.f, 0.f};
    bf16x8 At[4][2], B0[2][2], B1[2][2];
    const char* cA = (const char*)g.A + (size_t)cur.pm * tstepA; const char* cB = (const char*)g.Bt + (size_t)cur.pb * tstepB;
    S.a_ready(cur);
    if constexpr (SP2) {
        PG8_STAGE(PG8_SB(0, 0), cB, voffB); PG8_STAGE(PG8_SB(0, 1), cB + hstepB, voffB); PG8_STAGE(PG8_SA(0, 0), cA, voffA); PG8_STAGE(PG8_SA(0, 1), cA + hstepA, voffA);
        if (wr == 1) PG8_BAR;
        PG8_WAIT_V(2); PG8_BAR;
        PG8_STAGE(PG8_SB(1, 0), cB + kstep, voffB); PG8_STAGE(PG8_SA(1, 0), cA + kstep, voffA); PG8_STAGE(PG8_SB(1, 1), cB + hstepB + kstep, voffB);
        PG8_WAIT_V(6); PG8_BAR;
    } else {
        PG8_STAGE(PG8_SB(0, 0), cB, voffB); PG8_STAGE(PG8_SA(0, 0), cA, voffA); PG8_STAGE(PG8_SB(0, 1), cB + hstepB, voffB); PG8_STAGE(PG8_SA(0, 1), cA + hstepA, voffA);
        if (wr == 1) PG8_BAR;
        PG8_WAIT_V(4); PG8_BAR;
        PG8_STAGE(PG8_SB(1, 0), cB + kstep, voffB); PG8_STAGE(PG8_SA(1, 0), cA + kstep, voffA); PG8_STAGE(PG8_SB(1, 1), cB + hstepB + kstep, voffB);
        PG8_WAIT_V(6); PG8_BAR;
    }
    for (;;) {
        const bool has_next = S.next(ui + 1, nxt);
        const char* nA = has_next ? (const char*)g.A + (size_t)nxt.pm * tstepA : cA; const char* nB = has_next ? (const char*)g.Bt + (size_t)nxt.pb * tstepB : cB;
        if (Sched::PARTIAL && !(on0 && on1)) {
        for (int t = 0; t < nt; t += 2) {
            const bool last = (t == nt - 2);
            const char* a1 = cA + (size_t)(t + 1) * kstep;
            const char* a2 = last ? nA : cA + (size_t)(t + 2) * kstep; const char* b2 = last ? nB : cB + (size_t)(t + 2) * kstep;
            const char* a3 = a2 + kstep; const char* b3 = b2 + kstep;
            if (last && has_next) S.a_ready(nxt);
            if constexpr (SP2) {
            PG8_LDB(B0, 0, 0); PG8_LDB(B1, 0, 1); PG8_SCHED; PG8_LDA(At, 0, 0); PG8_STAGE(PG8_SA(1, 1), a1 + hstepA, voffA);
            PG8_WAIT_V(8); PG8_WAIT_L(0); PG8_BAR; PG8_MMAG(0, 0, At, B0); PG8_MMAG(0, 1, At, B1); PG8_BAR; PG8_SCHED;
            PG8_LDA(At, 0, 1); PG8_STAGE(PG8_SB(0, 0), b2, voffB); PG8_STAGE(PG8_SB(0, 1), b2 + hstepB, voffB); PG8_STAGE(PG8_SA(0, 0), a2, voffA);
            PG8_WAIT_V(8); PG8_WAIT_L(0); PG8_BAR; PG8_MMAG(1, 0, At, B0); PG8_MMAG(1, 1, At, B1); PG8_BAR; PG8_SCHED;
            PG8_LDB(B0, 1, 0); PG8_LDB(B1, 1, 1); PG8_SCHED; PG8_LDA(At, 1, 0); PG8_STAGE(PG8_SA(0, 1), a2 + hstepA, voffA);
            PG8_WAIT_V(8); PG8_WAIT_L(0); PG8_BAR; PG8_MMAG(0, 0, At, B0); PG8_MMAG(0, 1, At, B1); PG8_BAR; PG8_SCHED;
            PG8_LDA(At, 1, 1); PG8_STAGE(PG8_SB(1, 0), b3, voffB); PG8_STAGE(PG8_SB(1, 1), b3 + hstepB, voffB); PG8_STAGE(PG8_SA(1, 0), a3, voffA);
            PG8_WAIT_V(8); PG8_WAIT_L(0); PG8_BAR; PG8_MMAG(1, 0, At, B0); PG8_MMAG(1, 1, At, B1); PG8_BAR; PG8_SCHED;
            } else {
            PG8_LDB(B0, 0, 0); PG8_SCHED; PG8_LDA(At, 0, 0); PG8_STAGE(PG8_SA(1, 1), a1 + hstepA, voffA);
            PG8_WAIT_L(8); PG8_BAR; PG8_WAIT_L(0); PG8_MMAG(0, 0, At, B0); PG8_BAR; PG8_SCHED;
            PG8_LDB(B1, 0, 1); PG8_STAGE(PG8_SB(0, 0), b2, voffB);
            PG8_BAR; PG8_WAIT_L(0); PG8_MMAG(0, 1, At, B1); PG8_BAR;
            PG8_LDA(At, 0, 1); PG8_STAGE(PG8_SA(0, 0), a2, voffA);
            PG8_BAR; PG8_WAIT_L(0); PG8_MMAG(1, 0, At, B0); PG8_BAR; PG8_SCHED;
            PG8_STAGE(PG8_SB(0, 1), b2 + hstepB, voffB);
            PG8_WAIT_V(6); PG8_BAR; PG8_MMAG(1, 1, At, B1); PG8_BAR;
            PG8_LDB(B0, 1, 0); PG8_SCHED; PG8_LDA(At, 1, 0); PG8_STAGE(PG8_SA(0, 1), a2 + hstepA, voffA);
            PG8_WAIT_L(8); PG8_BAR; PG8_WAIT_L(0); PG8_MMAG(0, 0, At, B0); PG8_BAR; PG8_SCHED;
            PG8_LDB(B1, 1, 1); PG8_STAGE(PG8_SB(1, 0), b3, voffB);
            PG8_BAR; PG8_WAIT_L(0); PG8_MMAG(0, 1, At, B1); PG8_BAR;
            PG8_LDA(At, 1, 1); PG8_STAGE(PG8_SA(1, 0), a3, voffA);
            PG8_BAR; PG8_WAIT_L(0); PG8_MMAG(1, 0, At, B0); PG8_BAR; PG8_SCHED;
            PG8_STAGE(PG8_SB(1, 1), b3 + hstepB, voffB);
            PG8_WAIT_V(6); PG8_BAR; PG8_MMAG(1, 1, At, B1); PG8_BAR;
            }
        }
        } else {
        for (int t = 0; t < nt; t += 2) {
            const bool last = (t == nt - 2);
            const char* a1 = cA + (size_t)(t + 1) * kstep;
            const char* a2 = last ? nA : cA + (size_t)(t + 2) * kstep; const char* b2 = last ? nB : cB + (size_t)(t + 2) * kstep;
            const char* a3 = a2 + kstep; const char* b3 = b2 + kstep;
            if (last && has_next) S.a_ready(nxt);
            if constexpr (SP2) {
            PG8_LDB(B0, 0, 0); PG8_LDB(B1, 0, 1); PG8_SCHED; PG8_LDA(At, 0, 0); PG8_STAGE(PG8_SA(1, 1), a1 + hstepA, voffA);
            PG8_WAIT_V(8); PG8_WAIT_L(0); PG8_BAR; PG8_MMA(0, 0, At, B0); PG8_MMA(0, 1, At, B1); PG8_BAR; PG8_SCHED;
            PG8_LDA(At, 0, 1); PG8_STAGE(PG8_SB(0, 0), b2, voffB); PG8_STAGE(PG8_SB(0, 1), b2 + hstepB, voffB); PG8_STAGE(PG8_SA(0, 0), a2, voffA);
            PG8_WAIT_V(8); PG8_WAIT_L(0); PG8_BAR; PG8_MMA(1, 0, At, B0); PG8_MMA(1, 1, At, B1); PG8_BAR; PG8_SCHED;
            PG8_LDB(B0, 1, 0); PG8_LDB(B1, 1, 1); PG8_SCHED; PG8_LDA(At, 1, 0); PG8_STAGE(PG8_SA(0, 1), a2 + hstepA, voffA);
            PG8_WAIT_V(8); PG8_WAIT_L(0); PG8_BAR; PG8_MMA(0, 0, At, B0); PG8_MMA(0, 1, At, B1); PG8_BAR; PG8_SCHED;
            PG8_LDA(At, 1, 1); PG8_STAGE(PG8_SB(1, 0), b3, voffB); PG8_STAGE(PG8_SB(1, 1), b3 + hstepB, voffB); PG8_STAGE(PG8_SA(1, 0), a3, voffA);
            PG8_WAIT_V(8); PG8_WAIT_L(0); PG8_BAR; PG8_MMA(1, 0, At, B0); PG8_MMA(1, 1, At, B1); PG8_BAR; PG8_SCHED;
            } else {
            PG8_LDB(B0, 0, 0); PG8_SCHED; PG8_LDA(At, 0, 0); PG8_STAGE(PG8_SA(1, 1), a1 + hstepA, voffA);
            PG8_WAIT_L(8); PG8_BAR; PG8_WAIT_L(0); PG8_MMA(0, 0, At, B0); PG8_BAR; PG8_SCHED;
            PG8_LDB(B1, 0, 1); PG8_STAGE(PG8_SB(0, 0), b2, voffB);
            PG8_BAR; PG8_WAIT_L(0); PG8_MMA(0, 1, At, B1); PG8_BAR;
            PG8_LDA(At, 0, 1); PG8_STAGE(PG8_SA(0, 0), a2, voffA);
            PG8_BAR; PG8_WAIT_L(0); PG8_MMA(1, 0, At, B0); PG8_BAR; PG8_SCHED;
            PG8_STAGE(PG8_SB(0, 1), b2 + hstepB, voffB);
            PG8_WAIT_V(6); PG8_BAR; PG8_MMA(1, 1, At, B1); PG8_BAR;
            PG8_LDB(B0, 1, 0); PG8_SCHED; PG8_LDA(At, 1, 0); PG8_STAGE(PG8_SA(0, 1), a2 + hstepA, voffA);
            PG8_WAIT_L(8); PG8_BAR; PG8_WAIT_L(0); PG8_MMA(0, 0, At, B0); PG8_BAR; PG8_SCHED;
            PG8_LDB(B1, 1, 1); PG8_STAGE(PG8_SB(1, 0), b3, voffB);
            PG8_BAR; PG8_WAIT_L(0); PG8_MMA(0, 1, At, B1); PG8_BAR;
            PG8_LDA(At, 1, 1); PG8_STAGE(PG8_SA(1, 0), a3, voffA);
            PG8_BAR; PG8_WAIT_L(0); PG8_MMA(1, 0, At, B0); PG8_BAR; PG8_SCHED;
            PG8_STAGE(PG8_SB(1, 1), b3 + hstepB, voffB);
            PG8_WAIT_V(6); PG8_BAR; PG8_MMA(1, 1, At, B1); PG8_BAR;
            }
        }
        }
        if constexpr (ALIGN_EPI) { if (wr == 0) PG8_BAR; }
        if constexpr (!Epi::AFTER_DRAIN) { E(acc, cur, wr, wc, fr, fq); S.done(cur); }
        if (!has_next) break;
#pragma unroll
        for (int a = 0; a < 2; ++a)
#pragma unroll
            for (int b = 0; b < 2; ++b)
#pragma unroll
                for (int m = 0; m < 4; ++m)
#pragma unroll
                    for (int n = 0; n < 2; ++n) acc[a][b][m][n] = (f32x4){0.f, 0.f, 0.f, 0.f};
        cur = nxt; cA = nA; cB = nB; ++ui;
        if constexpr (Sched::PARTIAL) { on0 = cur.rows > wr * 64; on1 = cur.rows > HALF + wr * 64; }
        if constexpr (ALIGN_EPI) { if (wr == 1) PG8_BAR; }
    }
    PG8_WAIT_V(0);
    if constexpr (!ALIGN_EPI) { if (wr == 0) PG8_BAR; }
    PG8_BAR;
    if constexpr (Epi::AFTER_DRAIN) { E.fused(acc, cur, wr, wc, fr, fq, lds, wid, lane); S.done(cur); }
#undef PG8_SA
#undef PG8_SB
#undef PG8_STAGE
#undef PG8_LDA
#undef PG8_LDB
#undef PG8_MMA
#undef PG8_MMAG
#undef PG8_WAIT_V
#undef PG8_WAIT_L
#undef PG8_BAR
#undef PG8_SCHED
}
}
#ifndef PLE_LIGHT
#define PLE_LIGHT 1
#endif
constexpr int NWAVES = 8;
constexpr int S = 8192, DM = 2048, DEPTH = 2;
constexpr int IN_COLS = 3152, LDH = 3328;
constexpr int QW = 1536, KVW = 2048;
constexpr int DFF = 5632, NGU = 2 * DFF, NE = 8, PLE = 256;
constexpr int ECAP = 2304;
constexpr int MAXTILES = 72, XG_ROWS = MAXTILES * 256;
constexpr int H_QA = 0, H_KVA = 512, H_KPE = 768, H_GQ = 832, H_GK = 1088, H_GV = 1344, H_GR = 1856, H_SQ = 2368, H_SK = 2880, H_SV = 3008, H_GLR = 3136;
constexpr float LN_EPS = 1e-5f, RMS_EPS = 1e-6f, ALPHA = 1.4142135623730951f;
constexpr float QSCALE = 0.07216878364870322f * 1.4426950408889634f;

constexpr size_t MiB = 1u << 20;
constexpr size_t WS_CTL = 0, CTL_ZERO_BYTES = 1 * MiB;
constexpr size_t WS_CS = 1 * MiB, WS_SSQ = 3 * MiB, WS_ROUTE = 4 * MiB, WS_GDEC = 5 * MiB, WS_PB = 6 * MiB, WS_XB = 14 * MiB;
constexpr size_t WS_WIN = 46 * MiB, WS_WQB = 72 * MiB, WS_WKVB = 75 * MiB, WS_WOUT = 77 * MiB, WS_WPU = 93 * MiB, WS_WPG = 95 * MiB;
constexpr size_t WS_FGU = 111 * MiB, WS_FD = 155 * MiB, WS_MGU = 177 * MiB, WS_MD = 529 * MiB;
constexpr size_t WS_R1 = 705 * MiB;
constexpr size_t WS_HB = WS_R1, WS_QB = WS_R1 + 52 * MiB, WS_KVB = WS_R1 + 76 * MiB, WS_MIX = WS_R1 + 108 * MiB, WS_GUT = WS_R1 + 140 * MiB, WS_GSP = WS_R1 + 156 * MiB, WS_HMID = WS_R1;
constexpr size_t WS_R2 = 905 * MiB;
constexpr size_t WS_X1F = 1049 * MiB, WS_X1B = 1113 * MiB, WS_PLE = 1145 * MiB, WS_XG = 1209 * MiB, WS_XF = 1281 * MiB, WS_END = 1345 * MiB;
static_assert((size_t)DEPTH * LDH * DM * 2 <= 26 * MiB && (size_t)S * LDH * 2 <= 52 * MiB && (size_t)XG_ROWS * DFF * 2 <= 200 * MiB && (size_t)XG_ROWS * DM * 4 <= 144 * MiB && (size_t)XG_ROWS * DM * 2 <= 72 * MiB, "ws map");
constexpr int CW_TMO = 0, CW_CODE = 1;
constexpr int CW_ECNT = 64;
constexpr int CW_BAR = 4096;
constexpr size_t RT_E = 0, RT_POS = 64 * 1024, RT_W = 128 * 1024, RT_SLOT = 192 * 1024;

constexpr int RING_OFF = 0, RING_BYTES = 131072;
constexpr int TBL = MAXTILES + 24;
constexpr int LDSCTL_OFF = RING_BYTES, MISC_OFF = LDSCTL_OFF + 320, TE_OFF = MISC_OFF + 128;
constexpr int LDS_BYTES = 147456;
static_assert(TE_OFF + 3 * TBL * 4 <= LDS_BYTES, "LDS map");

#define GAS __attribute__((address_space(1)))
#define LAS __attribute__((address_space(3)))
typedef unsigned short bf16;
typedef unsigned v4u __attribute__((ext_vector_type(4)));
typedef unsigned v2u __attribute__((ext_vector_type(2)));
typedef float f32x4 __attribute__((ext_vector_type(4)));
typedef float f32x16 __attribute__((ext_vector_type(16)));
typedef short bf16x8 __attribute__((ext_vector_type(8)));
typedef short s16x4 __attribute__((ext_vector_type(4)));
typedef GAS unsigned gu32;
typedef GAS unsigned long long gu64;
#define RLX_AGENT __ATOMIC_RELAXED, __HIP_MEMORY_SCOPE_AGENT
#define LDS_WAIT() asm volatile("s_waitcnt lgkmcnt(0)" ::: "memory")
#define VM_WAIT() asm volatile("s_waitcnt vmcnt(0)" ::: "memory")
__device__ __forceinline__ float bf2f(unsigned h) { return __builtin_bit_cast(float, h << 16); }
__device__ __forceinline__ unsigned f2bf(float f) { unsigned u = __builtin_bit_cast(unsigned, f); return (u + 0x7fffu + ((u >> 16) & 1u)) >> 16; }
__device__ __forceinline__ unsigned pk2(float lo, float hi) { return f2bf(lo) | (f2bf(hi) << 16); }

#define XB_TMO      128
#define XB_XCNT(j)  (256  + 64 * (j))
#define XB_XSUB(j)  (1280 + 64 * (j))
#define XB_XGEN(j)  (2304 + 64 * (j))
#define XB_TOP      3328
#define XB_TOPGEN   3392
#define XCD_BAR_WORDS 3456
#define XB_SPIN_CAP (1u << 18)

__device__ __forceinline__ unsigned xb_ld(unsigned* p)              { return __hip_atomic_load(p, __ATOMIC_RELAXED, __HIP_MEMORY_SCOPE_AGENT); }
__device__ __forceinline__ unsigned xb_add(unsigned* p, unsigned v) { return __hip_atomic_fetch_add(p, v, __ATOMIC_RELAXED, __HIP_MEMORY_SCOPE_AGENT); }
__device__ __forceinline__ unsigned xb_xcc_id() { return (unsigned)__builtin_amdgcn_s_getreg((3 << 11) | 20) & 0xFu; }
#define XB_SPIN(cond, bar) do { unsigned _sp = 0; while (cond) { __builtin_amdgcn_s_sleep(1); \
    if ((++_sp & 255u) == 0u) { if (xb_ld(&(bar)[XB_TMO])) break; if (_sp > XB_SPIN_CAP) { atomicAdd(&(bar)[XB_TMO], 1u); break; } } } } while (0)

struct XcdBarrier {
    unsigned* bar; unsigned x;
    volatile LAS unsigned* st;
};

__device__ __forceinline__ XcdBarrier xcd_barrier_post(unsigned* bar, volatile LAS unsigned* st) {
    XcdBarrier b; b.bar = bar; b.x = xb_xcc_id(); b.st = st;
    if (threadIdx.x == 0) (void)xb_add(&bar[XB_XCNT(b.x)], 1u);
    return b;
}
__device__ __forceinline__ void xcd_barrier_complete(unsigned* bar, unsigned x, unsigned& nloc, unsigned& nx) {
    const unsigned G = gridDim.x * gridDim.y * gridDim.z;
    unsigned sum, cnt, mine, sp = 0u;
    for (;;) {
        sum = 0u; cnt = 0u; mine = 0u;
#pragma unroll
        for (unsigned j = 0; j < 16; ++j) { const unsigned c = xb_ld(&bar[XB_XCNT(j)]); sum += c; cnt += (c > 0u) ? 1u : 0u; mine = (j == x) ? c : mine; }
        if (sum == G) break;
        __builtin_amdgcn_s_sleep(1);
        if ((++sp & 255u) == 0u) { if (xb_ld(&bar[XB_TMO])) break; if (sp > XB_SPIN_CAP) { atomicAdd(&bar[XB_TMO], 1u); break; } }
    }
    nloc = mine > 0u ? mine : 1u; nx = cnt > 0u ? cnt : 1u;
}

__device__ __forceinline__ void xcd_barrier(const XcdBarrier& b) {
    asm volatile("s_waitcnt vmcnt(0)" ::: "memory");
    __syncthreads();
    if (threadIdx.x == 0) {
        unsigned* bar = b.bar;
        __builtin_amdgcn_s_waitcnt(0);
        unsigned nloc = b.st[0], nx = b.st[1];
        if (nloc == 0u) { xcd_barrier_complete(bar, b.x, nloc, nx); b.st[0] = nloc; b.st[1] = nx; }
        const unsigned old = xb_add(&bar[XB_XSUB(b.x)], 1u);
        const unsigned gen = old / nloc;
        if (old + 1u == (gen + 1u) * nloc) {
            __builtin_amdgcn_fence(__ATOMIC_RELEASE, "agent");
            asm volatile("s_waitcnt vmcnt(0)" ::: "memory");
            const unsigned og = xb_add(&bar[XB_TOP], 1u);
            const unsigned tg = og / nx;
            if (og + 1u == (tg + 1u) * nx) xb_add(&bar[XB_TOPGEN], 1u);
            else XB_SPIN(xb_ld(&bar[XB_TOPGEN]) == tg, bar);
            __builtin_amdgcn_fence(__ATOMIC_ACQUIRE, "agent");
            xb_add(&bar[XB_XGEN(b.x)], 1u);
            asm volatile("s_waitcnt vmcnt(0)" ::: "memory");
        } else {
            XB_SPIN(xb_ld(&bar[XB_XGEN(b.x)]) == gen, bar);
            __builtin_amdgcn_fence(__ATOMIC_ACQUIRE, "agent");
            asm volatile("s_waitcnt vmcnt(0)" ::: "memory");
        }
    }
    __syncthreads();
}

struct Frame {
    LAS unsigned char* lds;
    volatile LAS unsigned* MISC;
    gu32* ctl;
    unsigned char* ws;
    int tid, lane, wave;
    int G, c;
};
__device__ __forceinline__ float wave_sum(float v) {
#pragma unroll
    for (int o = 1; o < 64; o <<= 1) v += __shfl_xor(v, o);
    return v;
}
__device__ __forceinline__ unsigned pk2h(float lo, float hi) { return pg8::cvt_pk_bf16(lo, hi); }

template <int MAP> __device__ __forceinline__ int rowmap(int n) {
    if (MAP == 1) { if (n < 768) return n; if (n < 832) { const int j = n - 768; return 768 + ((j & 31) << 1) + (j >> 5); } if (n < 1856) return n; if (n < 1872) return H_GLR + (n - 1856); return n - 16; }
    if (MAP == 2) { const int hd = n / 192; int j = n - hd * 192; if (j >= 128) { const int jj = j - 128; j = 128 + ((jj & 31) << 1) + (jj >> 5); } return hd * 192 + j; }
    if (MAP == 3) return ((n >> 7) << 8) + (n & 127);
    if (MAP == 4) return ((n >> 7) << 8) + 128 + (n & 127);
    return n;
}
constexpr int P0_PD = 33;
template <int MAP> __device__ __forceinline__ void p0_item(const float* W, int K, int N, bf16* WT, const float* gain, float sc, LAS unsigned* scr, int item, int lane) {
    const int nblk = (N + 127) >> 7, kb = item / nblk, nb = item - kb * nblk, k0 = 64 * kb, n0 = 128 * nb;
    const int g = lane >> 4, n4 = lane & 15;
    f32x4 v[2][16];
#pragma unroll
    for (int hf = 0; hf < 2; ++hf) { const bool nok = (n0 + 64 * hf + 4 * n4) < N;
#pragma unroll
        for (int i = 0; i < 16; ++i) { const int k = 8 * (i >> 1) + 2 * g + (i & 1); v[hf][i] = nok ? __builtin_nontemporal_load((const GAS f32x4*)(W + (size_t)(k0 + k) * N + n0 + 64 * hf + 4 * n4)) : (f32x4){0.f, 0.f, 0.f, 0.f}; } }
    const int c = lane & 7;
#pragma unroll
    for (int hf = 0; hf < 2; ++hf) {
#pragma unroll
        for (int j = 0; j < 8; ++j) { const int k = 8 * j + 2 * g; float s0 = sc, s1 = sc; if (gain) { s0 *= gain[k0 + k]; s1 *= gain[k0 + k + 1]; }
#pragma unroll
            for (int e = 0; e < 4; ++e) scr[(4 * n4 + e) * P0_PD + 4 * j + g] = pk2h(v[hf][2 * j][e] * s0, v[hf][2 * j + 1][e] * s1); }
        LDS_WAIT(); asm volatile("" ::: "memory");
#pragma unroll
        for (int s = 0; s < 8; ++s) { const int nl = 8 * s + (lane >> 3); const LAS unsigned* p = scr + nl * P0_PD + 4 * c;
            v4u o; o.x = p[0]; o.y = p[1]; o.z = p[2]; o.w = p[3];
            if (n0 + 64 * hf + nl < N) *(GAS v4u*)(WT + (size_t)rowmap<MAP>(n0 + 64 * hf + nl) * K + k0 + 8 * c) = o; }
        LDS_WAIT(); asm volatile("" ::: "memory"); }
}
struct In {
    const float *x, *p; const int* pos; const float *w_in, *q_gain, *w_qb, *kv_gain, *w_kvb, *gla_wg, *gla_bg, *gla_ng, *sinks, *relb, *w_out, *ln1g, *ln1b,
        *f_wg, *f_wu, *f_wd, *router, *m_wg, *m_wu, *m_wd, *p_wu, *p_wg, *p_bg, *ln2g, *ln2b;
};
constexpr int I_IN = (DM / 64) * ((IN_COLS + 127) / 128), I_QB = (512 / 64) * (QW / 128), I_KVB = (256 / 64) * (KVW / 128), I_OUT = (DM / 64) * (DM / 128), I_PU = (PLE / 64) * (DM / 128), I_PG = I_OUT;
constexpr int I_GU = (DM / 64) * (DFF / 128), I_D = (DFF / 64) * (DM / 128);
constexpr int I_LAYER = I_IN + I_QB + I_KVB + I_OUT + I_PU + I_PG;
constexpr int NITEMS = DEPTH * I_LAYER + 3 * I_GU + 24 * I_GU;
static_assert(I_D == I_GU, "item counts");
#ifndef BGQ1
#define BGQ1 5
#endif
#ifndef BGQ2
#define BGQ2 5
#endif
#ifndef BGQ3
#define BGQ3 5
#endif
constexpr int HOLE1_WG = 96, HOLE2_WG = 128, HOLE3_WG = 96;
constexpr int HOLE1_N = HOLE1_WG * BGQ1 * 8, HOLE2_N = HOLE2_WG * BGQ2 * 8, HOLE3_N = HOLE3_WG * BGQ3 * 8;
constexpr int N_PRO256 = NITEMS - HOLE1_N - HOLE2_N - HOLE3_N;
static_assert(N_PRO256 >= DEPTH * I_LAYER + 3 * I_GU, "only MoE items may be deferred");
__device__ __forceinline__ void p0_dispatch(const In& I, unsigned char* ws, LAS unsigned* scr, int it, int lane) {
        int r = it;
        if (r < DEPTH * I_LAYER) {
            const int l = r / I_LAYER; r -= l * I_LAYER;
            if (r < I_IN) { p0_item<1>(I.w_in + (size_t)l * DM * IN_COLS, DM, IN_COLS, (bf16*)(ws + WS_WIN) + (size_t)l * LDH * DM, nullptr, 1.f, scr, r, lane); return; } r -= I_IN;
            if (r < I_QB) { p0_item<2>(I.w_qb + (size_t)l * 512 * QW, 512, QW, (bf16*)(ws + WS_WQB) + (size_t)l * QW * 512, I.q_gain + l * 512, QSCALE, scr, r, lane); return; } r -= I_QB;
            if (r < I_KVB) { p0_item<0>(I.w_kvb + (size_t)l * 256 * KVW, 256, KVW, (bf16*)(ws + WS_WKVB) + (size_t)l * KVW * 256, I.kv_gain + l * 256, 1.f, scr, r, lane); return; } r -= I_KVB;
            if (r < I_OUT) { p0_item<0>(I.w_out + (size_t)l * DM * DM, DM, DM, (bf16*)(ws + WS_WOUT) + (size_t)l * DM * DM, nullptr, 1.f, scr, r, lane); return; } r -= I_OUT;
            if (r < I_PU) { p0_item<0>(I.p_wu + (size_t)l * PLE * DM, PLE, DM, (bf16*)(ws + WS_WPU) + (size_t)l * DM * PLE, nullptr, 1.f, scr, r, lane); return; } r -= I_PU;
            p0_item<0>(I.p_wg + (size_t)l * DM * DM, DM, DM, (bf16*)(ws + WS_WPG) + (size_t)l * DM * DM, nullptr, 1.f, scr, r, lane); return;
        }
        r -= DEPTH * I_LAYER;
        if (r < I_GU) { p0_item<3>(I.f_wg, DM, DFF, (bf16*)(ws + WS_FGU), nullptr, 1.f, scr, r, lane); return; } r -= I_GU;
        if (r < I_GU) { p0_item<4>(I.f_wu, DM, DFF, (bf16*)(ws + WS_FGU), nullptr, 1.f, scr, r, lane); return; } r -= I_GU;
        if (r < I_D) { p0_item<0>(I.f_wd, DFF, DM, (bf16*)(ws + WS_FD), nullptr, 1.f, scr, r, lane); return; } r -= I_D;
        { const int e = r / (3 * I_GU); r -= e * 3 * I_GU;
          if (r < I_GU) { p0_item<3>(I.m_wg + (size_t)e * DM * DFF, DM, DFF, (bf16*)(ws + WS_MGU) + (size_t)e * NGU * DM, nullptr, 1.f, scr, r, lane); return; } r -= I_GU;
          if (r < I_GU) { p0_item<4>(I.m_wu + (size_t)e * DM * DFF, DM, DFF, (bf16*)(ws + WS_MGU) + (size_t)e * NGU * DM, nullptr, 1.f, scr, r, lane); return; } r -= I_GU;
          p0_item<0>(I.m_wd + (size_t)e * DFF * DM, DFF, DM, (bf16*)(ws + WS_MD) + (size_t)e * DM * DFF, nullptr, 1.f, scr, r, lane); }
}
__device__ __forceinline__ void bg_convert(Frame& F, const In& I, int first, int rank, int nw, int q) {
    LAS unsigned* scr = (LAS unsigned*)(F.lds + RING_OFF + F.wave * 16384);
    for (int b = 0; b < q; ++b) { const int it = first + (b * nw + rank) * 8 + F.wave; if (it < NITEMS) p0_dispatch(I, F.ws, scr, it, F.lane); }
    __syncthreads();
}
__device__ __forceinline__ void p0_prologue(Frame& F, const In& I) {
    LAS unsigned* scr = (LAS unsigned*)(F.lds + RING_OFF + F.wave * 16384);
    const int gw = F.c * NWAVES + F.wave, NGW = F.G * NWAVES;
    unsigned char* ws = F.ws;
    const int npro = (F.G == 256) ? N_PRO256 : NITEMS;
    for (int it = gw; it < npro; it += NGW) p0_dispatch(I, ws, scr, it, F.lane);
    const int gt = F.c * (NWAVES * 64) + F.tid, NGT = F.G * NWAVES * 64;
    { const GAS f32x4* xs = (const GAS f32x4*)I.x; GAS v4u* xd = (GAS v4u*)(ws + WS_XB);
      for (int i = gt; i < S * DM / 8; i += NGT) { const f32x4 a = __builtin_nontemporal_load(xs + 2 * i), b = __builtin_nontemporal_load(xs + 2 * i + 1); v4u o; o.x = pk2h(a[0], a[1]); o.y = pk2h(a[2], a[3]); o.z = pk2h(b[0], b[1]); o.w = pk2h(b[2], b[3]); xd[i] = o; }
      const GAS f32x4* ps = (const GAS f32x4*)I.p; GAS v4u* pd = (GAS v4u*)(ws + WS_PB);
      for (int i = gt; i < DEPTH * S * PLE / 8; i += NGT) { const f32x4 a = __builtin_nontemporal_load(ps + 2 * i), b = __builtin_nontemporal_load(ps + 2 * i + 1); v4u o; o.x = pk2h(a[0], a[1]); o.y = pk2h(a[2], a[3]); o.z = pk2h(b[0], b[1]); o.w = pk2h(b[2], b[3]); pd[i] = o; } }
    { float* cs = (float*)(ws + WS_CS);
      for (int i = gt; i < S * 32; i += NGT) { const int t = i >> 5, j = i & 31;
          const float inv = (float)exp2(-(double)j * (13.287712379549449 / 32.0));
          const float ang = (float)I.pos[t] * inv;
          double sn, cn; sincos((double)ang, &sn, &cn);
          cs[(size_t)t * 64 + j] = (float)cn; cs[(size_t)t * 64 + 32 + j] = (float)sn; } }
}

__device__ __forceinline__ f32x4 mfma16(bf16x8 a, bf16x8 b, f32x4 c) { return __builtin_amdgcn_mfma_f32_16x16x32_bf16(a, b, c, 0, 0, 0); }
__device__ __forceinline__ f32x16 mfma32(bf16x8 a, bf16x8 b, f32x16 c) { return __builtin_amdgcn_mfma_f32_32x32x16_bf16(a, b, c, 0, 0, 0); }
__device__ __forceinline__ s16x4 tr_read(const LAS bf16* p) { return __builtin_bit_cast(s16x4, __builtin_amdgcn_ds_read_tr16_b64_v4i16((LAS s16x4*)p)); }
__device__ __forceinline__ int crow(int r, int hi) { return (r & 3) + 8 * (r >> 2) + 4 * hi; }
__device__ __forceinline__ bf16x8 pack8f(float a0, float a1, float a2, float a3, float a4, float a5, float a6, float a7) {
    v4u w; w.x = pk2h(a0, a1); w.y = pk2h(a2, a3); w.z = pk2h(a4, a5); w.w = pk2h(a6, a7); return __builtin_bit_cast(bf16x8, w); }

constexpr int SW_KP = 72, SW_VP = 80;
__device__ __forceinline__ void swa_unit(Frame& F, int n, int hq, const bf16* HB, bf16* MIX, const float* sinks, const float* relb) {
    LAS bf16* Ks = (LAS bf16*)(F.lds + RING_OFF); LAS bf16* Vs = Ks + 256 * SW_KP; LAS float* bias = (LAS float*)(Vs + 256 * SW_VP);
    const int tid = F.tid, lane = F.lane, w = F.wave, hk = hq >> 2;
    const int q = lane & 15, kq = lane >> 4, qi = 16 * w + q; const size_t tq = (size_t)n * 128 + qi;
    bf16x8 qf[2];
#pragma unroll
    for (int ks = 0; ks < 2; ++ks) qf[ks] = *(const GAS bf16x8*)(HB + tq * LDH + H_SQ + hq * 64 + 32 * ks + 8 * kq);
#pragma unroll
    for (int i = 0; i < 4; ++i) { const int c = tid + 512 * i, row = c >> 3, ch = c & 7, tk = (n - 1) * 128 + row;
        v4u kv = (v4u){0u, 0u, 0u, 0u}, vv = (v4u){0u, 0u, 0u, 0u};
        if (tk >= 0) { kv = *(const GAS v4u*)(HB + (size_t)tk * LDH + H_SK + hk * 64 + ch * 8); vv = *(const GAS v4u*)(HB + (size_t)tk * LDH + H_SV + hk * 64 + ch * 8); }
        *(LAS v4u*)(Ks + row * SW_KP + ch * 8) = kv; *(LAS v4u*)(Vs + row * SW_VP + ch * 8) = vv; }
    if (tid < 128) { const int d = tid; int b;
        if (d < 16) b = d; else { const float lg = logf((float)d / 16.0f) / 2.0794415416798357f * 16.0f; b = 16 + (int)lg; if (b > 31) b = 31; }
        bias[d] = relb[b * 8 + hq]; }
    __syncthreads();
    f32x4 s[16];
#pragma unroll
    for (int blk = 0; blk < 16; ++blk) { f32x4 a = (f32x4){0.f, 0.f, 0.f, 0.f};
#pragma unroll
        for (int ks = 0; ks < 2; ++ks) { const bf16x8 kf = *(const LAS bf16x8*)(Ks + (16 * blk + q) * SW_KP + 32 * ks + 8 * kq); a = mfma16(kf, qf[ks], a); }
        s[blk] = a; }
    const float sink = sinks[hq]; float mx = sink;
#pragma unroll
    for (int blk = 0; blk < 16; ++blk)
#pragma unroll
        for (int i = 0; i < 4; ++i) { const int kj = 16 * blk + 4 * kq + i, dist = qi + 128 - kj; const bool valid = (dist >= 0) && (dist < 128) && (n > 0 || kj >= 128);
            const float v = valid ? s[blk][i] * 0.125f + bias[dist & 127] : -1e30f; s[blk][i] = v; mx = fmaxf(mx, v); }
    mx = fmaxf(mx, __shfl_xor(mx, 16)); mx = fmaxf(mx, __shfl_xor(mx, 32));
    float sum = 0.f;
#pragma unroll
    for (int blk = 0; blk < 16; ++blk)
#pragma unroll
        for (int i = 0; i < 4; ++i) { const float p = (s[blk][i] > -1e29f) ? __expf(s[blk][i] - mx) : 0.f; s[blk][i] = p; sum += p; }
    sum += __shfl_xor(sum, 16); sum += __shfl_xor(sum, 32);
    const float inv = 1.0f / (sum + __expf(sink - mx));
    f32x4 o[4];
#pragma unroll
    for (int db = 0; db < 4; ++db) o[db] = (f32x4){0.f, 0.f, 0.f, 0.f};
#pragma unroll
    for (int kk = 0; kk < 8; ++kk) {
        const bf16x8 pf = pack8f(s[2 * kk][0] * inv, s[2 * kk][1] * inv, s[2 * kk][2] * inv, s[2 * kk][3] * inv, s[2 * kk + 1][0] * inv, s[2 * kk + 1][1] * inv, s[2 * kk + 1][2] * inv, s[2 * kk + 1][3] * inv);
#pragma unroll
        for (int db = 0; db < 4; ++db) { const LAS bf16* vp = Vs + (32 * kk + 4 * kq + (q >> 2)) * SW_VP + 16 * db + 4 * (q & 3);
            const s16x4 lo = tr_read(vp), hh = tr_read(vp + 16 * SW_VP);
            o[db] = mfma16((bf16x8){lo[0], lo[1], lo[2], lo[3], hh[0], hh[1], hh[2], hh[3]}, pf, o[db]); } }
#pragma unroll
    for (int db = 0; db < 4; ++db) { v2u ov; ov.x = pk2h(o[db][0], o[db][1]); ov.y = pk2h(o[db][2], o[db][3]);
        *(GAS v2u*)(MIX + tq * DM + 1536 + hq * 64 + 16 * db + 4 * kq) = ov; }
    __syncthreads();
}

constexpr int GP = 72;
constexpr int GVP = 144, GKP = 80;
__device__ __forceinline__ bf16x8 gla_trfrag(const LAS bf16* base, int pitch, int j0, int c0, int fr) {
    const LAS bf16* p = base + (j0 + (fr >> 2)) * pitch + c0 + 4 * (fr & 3); const s16x4 lo = tr_read(p), hh = tr_read(p + 4 * pitch);
    return (bf16x8){lo[0], lo[1], lo[2], lo[3], hh[0], hh[1], hh[2], hh[3]}; }
constexpr int GL_GLR = 0, GL_WG = 4096, GL_BG = 8192, GL_B = 8704, GL_QT = 25344, GL_KT = 34560, GL_KDT = 43776, GL_VT = 52992, GL_SPT = 71424, GL_PP = 89856, GL_END = 99072, GL_OO = 0;
template <int STAGE> __device__ __forceinline__ void gla_unit(Frame& F, int c, int h, const bf16* HB, const float* wg, const float* bg, float* UT, float* DEC, const bf16* SPT, const float* ng, bf16* MIX) {
    LAS unsigned char* L = F.lds + RING_OFF;
    LAS float* glr = (LAS float*)(L + GL_GLR); LAS float* Wg = (LAS float*)(L + GL_WG); LAS float* Bg = (LAS float*)(L + GL_BG); LAS float* B = (LAS float*)(L + GL_B);
    LAS bf16* QT = (LAS bf16*)(L + GL_QT); LAS bf16* KT = (LAS bf16*)(L + GL_KT); LAS bf16* KD = (LAS bf16*)(L + GL_QT)  ; LAS bf16* VR = (LAS bf16*)(L + GL_VT);
    LAS bf16* SP = (LAS bf16*)(L + GL_SPT); LAS bf16* PP = (LAS bf16*)(L + GL_PP); LAS float* OO = (LAS float*)(L + GL_OO);
    const int tid = F.tid, lane = F.lane, w = F.wave; const size_t t0 = (size_t)c * 64;
    const v4u kraw = *(const GAS v4u*)(HB + (t0 + (tid >> 3)) * LDH + H_GK + h * 64 + (tid & 7) * 8);
    v4u qraw = (v4u){0u, 0u, 0u, 0u}; if (STAGE == 3) qraw = *(const GAS v4u*)(HB + (t0 + (tid >> 3)) * LDH + H_GQ + h * 64 + (tid & 7) * 8);
    for (int i = tid; i < 1024; i += 512) { const int r = i >> 4, k = i & 15; glr[i] = bf2f(HB[(t0 + r) * LDH + H_GLR + k]); }
    for (int i = tid; i < 1024; i += 512) { const int r = i >> 6, d = i & 63; Wg[i] = wg[r * 256 + h * 64 + d]; }
    if (tid < 64) Bg[tid] = bg[h * 64 + tid];
#pragma unroll
    for (int i = 0; i < 2; ++i) { const int cc = tid + 512 * i, row = cc >> 4, ch = cc & 15; const v4u vv = *(const GAS v4u*)(HB + (t0 + row) * LDH + H_GV + h * 128 + ch * 8);
        *(LAS v4u*)(VR + row * GVP + ch * 8) = vv; }
    if (STAGE == 3) {
#pragma unroll
        for (int i = 0; i < 2; ++i) { const int cc = tid + 512 * i, row = cc >> 3, ch = cc & 7; *(LAS v4u*)(SP + row * GP + ch * 8) = *(const GAS v4u*)(SPT + ((size_t)(c * 4 + h) * 128 + row) * 64 + ch * 8); } }
    __syncthreads();
#pragma unroll
    for (int i = 0; i < 8; ++i) { const int idx = tid + 512 * i, r = idx >> 6, d = idx & 63; float z = Bg[d];
#pragma unroll
        for (int k = 0; k < 16; ++k) z += glr[r * 16 + k] * Wg[k * 64 + d];
        const float ls = fminf(z, 0.f) - 0.6931471805599453f * __builtin_amdgcn_logf(1.0f + __builtin_amdgcn_exp2f(-1.4426950408889634f * fabsf(z))); B[r * 65 + d] = ls * (1.0f / 16.0f); }
    __syncthreads();
    { const int col = tid & 63, seg = tid >> 6; LAS float* SEG = glr;
      float v[8]; float a = 0.f;
#pragma unroll
      for (int k = 0; k < 8; ++k) { a += B[(8 * seg + k) * 65 + col]; v[k] = a; }
      SEG[seg * 64 + col] = a;
      __syncthreads();
      float off = 0.f;
#pragma unroll
      for (int q = 0; q < 7; ++q) off += (q < seg) ? SEG[q * 64 + col] : 0.f;
#pragma unroll
      for (int k = 0; k < 8; ++k) B[(8 * seg + k) * 65 + col] = v[k] + off; }
    __syncthreads();
    { const int i = tid >> 3, d0 = (tid & 7) * 8;
      if (STAGE == 1) {
          float kd[8];
#pragma unroll
          for (int e = 0; e < 8; ++e) { const float kv = bf2f((kraw[e >> 1] >> (16 * (e & 1))) & 0xffffu); kd[e] = kv * __expf(B[63 * 65 + d0 + e] - B[i * 65 + d0 + e]); }
          *(LAS bf16x8*)(KD + i * GKP + d0) = pack8f(kd[0], kd[1], kd[2], kd[3], kd[4], kd[5], kd[6], kd[7]);
          if (i == 63) {
#pragma unroll
              for (int e = 0; e < 8; ++e) DEC[(size_t)(c * 4 + h) * 64 + d0 + e] = __expf(B[63 * 65 + d0 + e]); }
      } else {
          float qv[8], kv[8];
#pragma unroll
          for (int e = 0; e < 8; ++e) { const float b = B[i * 65 + d0 + e]; qv[e] = bf2f((qraw[e >> 1] >> (16 * (e & 1))) & 0xffffu) * 0.125f * __expf(b); kv[e] = bf2f((kraw[e >> 1] >> (16 * (e & 1))) & 0xffffu) * __expf(-b); }
          *(LAS bf16x8*)(QT + i * GP + d0) = pack8f(qv[0], qv[1], qv[2], qv[3], qv[4], qv[5], qv[6], qv[7]);
          *(LAS bf16x8*)(KT + i * GP + d0) = pack8f(kv[0], kv[1], kv[2], kv[3], kv[4], kv[5], kv[6], kv[7]); } }
    __syncthreads();
    const int fr = lane & 15, fq = lane >> 4, rb = w & 3, cb = w >> 2;
    if (STAGE == 1) {
        bf16x8 af[2];
#pragma unroll
        for (int ks = 0; ks < 2; ++ks) af[ks] = gla_trfrag(KD, GKP, 32 * ks + 8 * fq, 16 * rb, fr);
#pragma unroll
        for (int eb = 0; eb < 4; ++eb) { f32x4 a = (f32x4){0.f, 0.f, 0.f, 0.f}; const int e0 = 16 * (4 * cb + eb);
#pragma unroll
            for (int ks = 0; ks < 2; ++ks) { const bf16x8 bfr = gla_trfrag(VR, GVP, 32 * ks + 8 * fq, e0, fr); a = mfma16(af[ks], bfr, a); }
            *(GAS f32x4*)(UT + ((size_t)(c * 4 + h) * 128 + e0 + fr) * 64 + 16 * rb + 4 * fq) = a; }
        __syncthreads();
    } else {
        { bf16x8 af[2];
#pragma unroll
          for (int ks = 0; ks < 2; ++ks) af[ks] = *(const LAS bf16x8*)(QT + (16 * rb + fr) * GP + 32 * ks + 8 * fq);
#pragma unroll
          for (int jb = 0; jb < 2; ++jb) { f32x4 a = (f32x4){0.f, 0.f, 0.f, 0.f}; const int j0 = 16 * (2 * cb + jb);
#pragma unroll
              for (int ks = 0; ks < 2; ++ks) { const bf16x8 bfr = *(const LAS bf16x8*)(KT + (j0 + fr) * GP + 32 * ks + 8 * fq); a = mfma16(af[ks], bfr, a); }
#pragma unroll
              for (int i = 0; i < 4; ++i) { const int ii = 16 * rb + 4 * fq + i, jj = j0 + fr; PP[ii * GP + jj] = (bf16)(pk2h(jj <= ii ? a[i] : 0.f, 0.f) & 0xffffu); } } }
        __syncthreads();
        f32x4 o[4];
        { bf16x8 pf[2], qf[2];
#pragma unroll
          for (int ks = 0; ks < 2; ++ks) { pf[ks] = *(const LAS bf16x8*)(PP + (16 * rb + fr) * GP + 32 * ks + 8 * fq); qf[ks] = *(const LAS bf16x8*)(QT + (16 * rb + fr) * GP + 32 * ks + 8 * fq); }
#pragma unroll
          for (int eb = 0; eb < 4; ++eb) { f32x4 a = (f32x4){0.f, 0.f, 0.f, 0.f}; const int e0 = 16 * (4 * cb + eb);
#pragma unroll
              for (int ks = 0; ks < 2; ++ks) { const bf16x8 vb = gla_trfrag(VR, GVP, 32 * ks + 8 * fq, e0, fr); a = mfma16(pf[ks], vb, a);
                  const bf16x8 sb = *(const LAS bf16x8*)(SP + (e0 + fr) * GP + 32 * ks + 8 * fq); a = mfma16(qf[ks], sb, a); }
              o[eb] = a; } }
        __syncthreads();
#pragma unroll
        for (int eb = 0; eb < 4; ++eb)
#pragma unroll
            for (int i = 0; i < 4; ++i) OO[(16 * rb + 4 * fq + i) * 132 + 16 * (4 * cb + eb) + fr] = o[eb][i];
        __syncthreads();
        { const int i = tid >> 3, e0 = (tid & 7) * 16; float v[16]; float ss = 0.f;
#pragma unroll
          for (int e = 0; e < 16; ++e) { v[e] = OO[i * 132 + e0 + e]; ss += v[e] * v[e]; }
          ss += __shfl_xor(ss, 1); ss += __shfl_xor(ss, 2); ss += __shfl_xor(ss, 4);
          const float rinv = 1.0f / sqrtf(ss * (1.0f / 128.0f) + RMS_EPS);
          const bf16* rp = HB + (t0 + i) * LDH + H_GR + h * 128 + e0; const float* gp = ng + h * 128 + e0;
          const v4u r0 = *(const GAS v4u*)rp, r1 = *(const GAS v4u*)(rp + 8);
          float ov[16];
#pragma unroll
          for (int e = 0; e < 16; ++e) { const unsigned rw = (e < 8 ? r0[e >> 1] : r1[(e - 8) >> 1]); const float rv = bf2f((rw >> (16 * (e & 1))) & 0xffffu);
              ov[e] = v[e] * rinv * gp[e] * (rv * pg8::fast_sigmoid(rv)); }
          bf16* op = MIX + (t0 + i) * DM + 1024 + h * 128 + e0;
          *(GAS bf16x8*)op = pack8f(ov[0], ov[1], ov[2], ov[3], ov[4], ov[5], ov[6], ov[7]);
          *(GAS bf16x8*)(op + 8) = pack8f(ov[8], ov[9], ov[10], ov[11], ov[12], ov[13], ov[14], ov[15]); }
        __syncthreads();
    }
}
__device__ __forceinline__ void gla_scan(Frame& F, const float* UT, const float* DEC, bf16* SPT) {
    const int gt = F.c * (NWAVES * 64) + F.tid; if (gt >= 4 * 128 * 64) return;
    const int d = gt & 63, he = gt >> 6, h = he >> 7;
    float s = 0.f;
#pragma unroll 8
    for (int c = 0; c < 128; ++c) { const size_t o = ((size_t)c * 512 + he) * 64 + d; SPT[o] = (bf16)(pk2h(s, 0.f) & 0xffffu); s = DEC[(size_t)(c * 4 + h) * 64 + d] * s + UT[o]; }
}

constexpr int ML_KP = 200, ML_VP = 160;
constexpr int ML_KB = 64 * ML_KP * 2, ML_VB = 64 * ML_VP * 2, ML_STAGE = ML_KB + ML_VB;
static_assert(2 * ML_STAGE <= RING_BYTES && 4 * 64 * 64 * 4 + 4 * 2 * 64 * 4 <= 2 * ML_STAGE, "MLA LDS");
__device__ __forceinline__ void mla_unit(Frame& F, int h, int qb, const bf16* QB, const bf16* KVB, const bf16* HB, bf16* MIX) {
    LAS unsigned char* L = F.lds + RING_OFF;
    int tid_ = F.tid; asm volatile("" : "+v"(tid_));
    const int tid = tid_, lane = tid & 63, w = F.wave, rg = w & 3, kh = w >> 2, r32 = lane & 31, hi = lane >> 5;
    const int q0 = 128 * qb, NT = 2 * qb + 2, qabs = q0 + 32 * rg + r32;
    bf16x8 qf[12];
    { const bf16* qp = QB + (size_t)qabs * QW + h * 192 + 8 * hi;
#pragma unroll
      for (int ks = 0; ks < 12; ++ks) qf[ks] = *(const GAS bf16x8*)(qp + 16 * ks); }
    unsigned doff[6]; bool dpe[6];
#pragma unroll
    for (int i = 0; i < 6; ++i) { const int jn = w + 8 * i;
        if (jn < 25) { const int c = 64 * jn + lane, row = c / 25, ch = c - 25 * row;
            dpe[i] = (ch >= 16 && ch < 24);
            doff[i] = dpe[i] ? (unsigned)(row * LDH + H_KPE + (ch - 16) * 8) * 2u : (unsigned)(row * KVW + h * 256 + (ch < 16 ? ch : 0) * 8) * 2u; }
        else { const int c = 64 * (jn - 25) + lane, row = c / 20, ch = c - 20 * row;
            dpe[i] = false; doff[i] = (unsigned)(row * KVW + h * 256 + 128 + (ch < 16 ? ch : 0) * 8) * 2u; } }
#define ML_DMA(t, b) do { const char* kb_ = (const char*)KVB + (size_t)(t) * (64 * KVW * 2); const char* pb_ = (const char*)HB + (size_t)(t) * (64 * LDH * 2); \
        _Pragma("unroll") for (int i_ = 0; i_ < 6; ++i_) { const int jn_ = w + 8 * i_; if (jn_ < 45) { const char* g_ = (dpe[i_] ? pb_ : kb_) + doff[i_]; \
            __builtin_amdgcn_global_load_lds((const unsigned*)g_, (LAS unsigned*)(L + (b) * ML_STAGE + jn_ * 1024), 16, 0, 0); } } } while (0)
    ML_DMA(0, 0);
    asm volatile("s_waitcnt vmcnt(0)" ::: "memory");
    __syncthreads();
    float m = -60000.f, l = 0.f; f32x16 o[4];
#pragma unroll
    for (int db = 0; db < 4; ++db)
#pragma unroll
        for (int r = 0; r < 16; ++r) o[db][r] = 0.f;
    const int li = lane & 15, trow = li >> 2, tcol = 16 * ((lane >> 4) & 1) + 4 * (li & 3);
    for (int t = 0; t < NT; ++t) {
        const bool more = (t + 1 < NT);
        if (more) ML_DMA(t + 1, (t + 1) & 1);
        const LAS bf16* Kb = (const LAS bf16*)(L + (t & 1) * ML_STAGE); const LAS bf16* Vb = (const LAS bf16*)(L + (t & 1) * ML_STAGE + ML_KB);
        f32x16 p;
#pragma unroll
        for (int r = 0; r < 16; ++r) p[r] = 0.f;
        { const LAS bf16* kp = Kb + (32 * kh + r32) * ML_KP + 8 * hi; bf16x8 kf[12];
#pragma unroll
          for (int ks = 0; ks < 12; ++ks) kf[ks] = *(const LAS bf16x8*)(kp + 16 * ks);
          __builtin_amdgcn_sched_barrier(0);
#pragma unroll
          for (int ks = 0; ks < 12; ++ks) p = mfma32(kf[ks], qf[ks], p); }
        if (t >= NT - 2) { const int kb = 64 * t + 32 * kh;
#pragma unroll
            for (int r = 0; r < 16; ++r) if (kb + crow(r, hi) > qabs) p[r] = -1e30f; }
        float tm = p[0];
#pragma unroll
        for (int r = 1; r < 16; ++r) tm = fmaxf(tm, p[r]);
        { float sa = tm, sb = tm;
          asm volatile("s_nop 1\n\tv_permlane32_swap_b32_e32 %0, %1\n\ts_nop 1\n\tv_max_f32_e32 %0, %0, %1\n\ts_nop 0" : "+v"(sa), "+v"(sb));
          tm = sa; }
        const float mn = fmaxf(m, tm), alpha = __builtin_amdgcn_exp2f(m - mn);
        float rs = 0.f;
#pragma unroll
        for (int r = 0; r < 16; ++r) { const float e = __builtin_amdgcn_exp2f(p[r] - mn); p[r] = e; rs += e; }
        { float sa = rs, sb = rs;
          asm volatile("s_nop 1\n\tv_permlane32_swap_b32_e32 %0, %1\n\ts_nop 1\n\tv_add_f32_e32 %0, %0, %1\n\ts_nop 0" : "+v"(sa), "+v"(sb));
          rs = sa; }
        l = l * alpha + rs; m = mn;
        if (__any(alpha != 1.0f)) {
#pragma unroll
            for (int db = 0; db < 4; ++db)
#pragma unroll
                for (int r = 0; r < 16; ++r) o[db][r] *= alpha; }
        bf16x8 pf[2];
        pf[0] = pack8f(p[0], p[1], p[2], p[3], p[4], p[5], p[6], p[7]); pf[1] = pack8f(p[8], p[9], p[10], p[11], p[12], p[13], p[14], p[15]);
        { s16x4 vlo[2][4], vhh[2][4];
#pragma unroll
          for (int s = 0; s < 2; ++s) { const LAS bf16* vp = Vb + (32 * kh + 16 * s + 4 * hi + trow) * ML_VP + tcol;
#pragma unroll
              for (int db = 0; db < 4; ++db) { vlo[s][db] = tr_read(vp + 32 * db); vhh[s][db] = tr_read(vp + 8 * ML_VP + 32 * db); } }
          __builtin_amdgcn_sched_barrier(0);
#pragma unroll
          for (int s = 0; s < 2; ++s)
#pragma unroll
              for (int db = 0; db < 4; ++db) { const bf16x8 vf = (bf16x8){vlo[s][db][0], vlo[s][db][1], vlo[s][db][2], vlo[s][db][3], vhh[s][db][0], vhh[s][db][1], vhh[s][db][2], vhh[s][db][3]};
                  o[db] = mfma32(vf, pf[s], o[db]); } }
        asm volatile("s_waitcnt vmcnt(0)" ::: "memory");
        __syncthreads();
    }
#undef ML_DMA
    LAS float* MS = (LAS float*)L; LAS float* ML = (LAS float*)(L + 4 * 64 * 64 * 4);
    if (kh == 1) {
#pragma unroll
        for (int db = 0; db < 4; ++db)
#pragma unroll
            for (int r = 0; r < 16; ++r) MS[(rg * 64 + db * 16 + r) * 64 + lane] = o[db][r];
        ML[(rg * 2 + 0) * 64 + lane] = m; ML[(rg * 2 + 1) * 64 + lane] = l; }
    __syncthreads();
    if (kh == 0) {
        const float m1 = ML[(rg * 2 + 0) * 64 + lane], l1 = ML[(rg * 2 + 1) * 64 + lane];
        const float mt = fmaxf(m, m1), a0 = __builtin_amdgcn_exp2f(m - mt), a1 = __builtin_amdgcn_exp2f(m1 - mt);
        const float inv = 1.0f / (l * a0 + l1 * a1), w0 = a0 * inv, w1 = a1 * inv;
        bf16* op = MIX + (size_t)qabs * DM + h * 128 + 4 * hi;
#pragma unroll
        for (int db = 0; db < 4; ++db)
#pragma unroll
            for (int g = 0; g < 4; ++g) { float v[4];
#pragma unroll
                for (int e = 0; e < 4; ++e) { const int r = 4 * g + e; v[e] = o[db][r] * w0 + MS[(rg * 64 + db * 16 + r) * 64 + lane] * w1; }
                v2u ov; ov.x = pk2h(v[0], v[1]); ov.y = pk2h(v[2], v[3]); *(GAS v2u*)(op + 32 * db + 8 * g) = ov; } }
    __syncthreads();
}

__device__ __forceinline__ f32x4 ld4bf(const bf16* p) { const v2u r = __builtin_nontemporal_load((const GAS v2u*)p);     return (f32x4){__builtin_bit_cast(float, r.x << 16), __builtin_bit_cast(float, r.x & 0xffff0000u), __builtin_bit_cast(float, r.y << 16), __builtin_bit_cast(float, r.y & 0xffff0000u)}; }
template <int MODE, bool ROUTE> __device__ __forceinline__ void ln_phase(Frame& F, const void* Yv, const bf16* X1, const bf16* PLEB, const float* gam, const float* bet, float* OF, bf16* OB, const float* router, bf16* XGR = nullptr) {
    unsigned char* ws = F.ws;
    LAS float* Wr = (LAS float*)(F.lds + RING_OFF);
    if (ROUTE) { for (int i = F.tid; i < DM * 8 / 4; i += NWAVES * 64) ((LAS f32x4*)Wr)[i] = ((const GAS f32x4*)router)[i]; __syncthreads(); }
    const int gw = F.c * NWAVES + F.wave, NGW = F.G * NWAVES, lane = F.lane;
    for (int row = gw; row < S; row += NGW) {
        f32x4 v[8]; float s = 0.f;
        if (MODE == 0) { const GAS f32x4* yp = (const GAS f32x4*)((const float*)Yv + (size_t)row * DM) + lane;
#pragma unroll
            for (int j = 0; j < 8; ++j) v[j] = __builtin_nontemporal_load(yp + 64 * j);
        } else {
            const bf16* xp = X1 + (size_t)row * DM + 4 * lane; const bf16* pp = PLEB + (size_t)row * DM + 4 * lane; const bf16* Y = (const bf16*)Yv;
            if (MODE == 1) { const bf16* yp = Y + (size_t)row * DM + 4 * lane;
#pragma unroll
                for (int j = 0; j < 8; ++j) v[j] = ALPHA * ld4bf(xp + 256 * j) + ld4bf(yp + 256 * j) + ld4bf(pp + 256 * j);
            } else {
                const int* slot = (const int*)(ws + WS_ROUTE + RT_SLOT) + 2 * row; const float* tw = (const float*)(ws + WS_ROUTE + RT_W) + 2 * row;
                const int s0 = slot[0], s1 = slot[1]; const float w0 = tw[0], w1 = tw[1];
                const bf16* y0 = Y + (size_t)s0 * DM + 4 * lane; const bf16* y1 = Y + (size_t)s1 * DM + 4 * lane;
#pragma unroll
                for (int j = 0; j < 8; ++j) v[j] = ALPHA * ld4bf(xp + 256 * j) + (w0 * ld4bf(y0 + 256 * j) + w1 * ld4bf(y1 + 256 * j)) + ld4bf(pp + 256 * j);
            }
        }
#pragma unroll
        for (int j = 0; j < 8; ++j) s += (v[j][0] + v[j][1]) + (v[j][2] + v[j][3]);
        const float mean = wave_sum(s) * (1.0f / DM); float s2 = 0.f;
#pragma unroll
        for (int j = 0; j < 8; ++j) { v[j] = v[j] - mean; s2 += (v[j][0] * v[j][0] + v[j][1] * v[j][1]) + (v[j][2] * v[j][2] + v[j][3] * v[j][3]); }
        const float rstd = 1.0f / sqrtf(wave_sum(s2) * (1.0f / DM) + LN_EPS);
#pragma unroll
        for (int j = 0; j < 8; ++j) { const f32x4 g = ((const GAS f32x4*)gam)[lane + 64 * j], b = ((const GAS f32x4*)bet)[lane + 64 * j]; v[j] = v[j] * rstd * g + b; }
        if (OF) { GAS f32x4* of = (GAS f32x4*)(OF + (size_t)row * DM) + lane;
#pragma unroll
            for (int j = 0; j < 8; ++j) of[64 * j] = v[j]; }
        if (OB) { GAS v2u* ob = (GAS v2u*)(OB + (size_t)row * DM) + lane;
#pragma unroll
            for (int j = 0; j < 8; ++j) { v2u o; o.x = pk2h(v[j][0], v[j][1]); o.y = pk2h(v[j][2], v[j][3]); ob[64 * j] = o; } }
        if (ROUTE) {
            float lg[8];
#pragma unroll
            for (int e = 0; e < 8; ++e) lg[e] = 0.f;
#pragma unroll
            for (int j = 0; j < 8; ++j) { __builtin_amdgcn_sched_barrier(0);
#pragma unroll
                for (int k = 0; k < 4; ++k) { const int col = 4 * (lane + 64 * j) + k; const f32x4 wa = *(const LAS f32x4*)(Wr + col * 8), wb = *(const LAS f32x4*)(Wr + col * 8 + 4); const float xv = v[j][k];
                    lg[0] += xv * wa[0]; lg[1] += xv * wa[1]; lg[2] += xv * wa[2]; lg[3] += xv * wa[3]; lg[4] += xv * wb[0]; lg[5] += xv * wb[1]; lg[6] += xv * wb[2]; lg[7] += xv * wb[3]; } }
#pragma unroll
            for (int e = 0; e < 8; ++e) lg[e] = wave_sum(lg[e]);
            int i0 = 0; float v0 = lg[0];
#pragma unroll
            for (int e = 1; e < 8; ++e) if (lg[e] > v0) { v0 = lg[e]; i0 = e; }
            int i1 = -1; float v1 = -3.0e38f;
#pragma unroll
            for (int e = 0; e < 8; ++e) if (e != i0 && lg[e] > v1) { v1 = lg[e]; i1 = e; }
            int p0 = 0, p1 = 0;
            if (lane == 0) { const float w0 = 1.0f / (1.0f + __expf(v1 - v0));
                p0 = (int)__hip_atomic_fetch_add(F.ctl + CW_ECNT + i0, 1u, RLX_AGENT); p1 = (int)__hip_atomic_fetch_add(F.ctl + CW_ECNT + i1, 1u, RLX_AGENT);
                int* te = (int*)(ws + WS_ROUTE + RT_E) + 2 * row; int* tp = (int*)(ws + WS_ROUTE + RT_POS) + 2 * row; float* tw = (float*)(ws + WS_ROUTE + RT_W) + 2 * row; int* tsl = (int*)(ws + WS_ROUTE + RT_SLOT) + 2 * row;
                te[0] = i0; te[1] = i1; tp[0] = p0; tp[1] = p1; tw[0] = w0; tw[1] = 1.0f - w0; tsl[0] = i0 * ECAP + p0; tsl[1] = i1 * ECAP + p1; }
            p0 = __builtin_amdgcn_readfirstlane(p0); p1 = __builtin_amdgcn_readfirstlane(p1);
            { v2u pk[8];
#pragma unroll
              for (int j = 0; j < 8; ++j) { pk[j].x = pk2h(v[j][0], v[j][1]); pk[j].y = pk2h(v[j][2], v[j][3]); }
              if (p0 < ECAP) { GAS v2u* xg = (GAS v2u*)(XGR + (size_t)(i0 * ECAP + p0) * DM) + lane;
#pragma unroll
                  for (int j = 0; j < 8; ++j) xg[64 * j] = pk[j]; }
              if (p1 < ECAP) { GAS v2u* xg = (GAS v2u*)(XGR + (size_t)(i1 * ECAP + p1) * DM) + lane;
#pragma unroll
                  for (int j = 0; j < 8; ++j) xg[64 * j] = pk[j]; } }
        }
    }
    if (ROUTE) __syncthreads();
}
__device__ __forceinline__ void moe_tables(Frame& F) {
    LAS int* TE = (LAS int*)(F.lds + TE_OFF); LAS int* TR = TE + TBL; LAS int* TV = TR + TBL; LAS int* CN = TE + MAXTILES + 8;
    if (F.tid < NE) CN[F.tid] = (int)__hip_atomic_load(F.ctl + CW_ECNT + F.tid, RLX_AGENT);
    __syncthreads();
    if (F.tid == 0) { int t = 0;
        bool ovf = false; for (int e = 0; e < NE; ++e) ovf |= CN[e] > ECAP;
        for (int pass = 0; pass < 2; ++pass) { int ptile = 0;
            for (int e = 0; e < NE; ++e) { const int cnt = CN[e], nt = (cnt + 255) >> 8; if (!ovf) ptile = 9 * e;
                for (int k = 0; k < nt; ++k, ++ptile) { const int rows = (cnt - 256 * k) < 256 ? (cnt - 256 * k) : 256;
                    if ((MOE_PARTIAL ? ((rows < 256) == (pass == 0)) : (pass == 0)) && t < MAXTILES) { TE[t] = e; TR[t] = ptile; TV[t] = rows; ++t; } } } }
        TE[MAXTILES] = t; }
    __syncthreads();
}
__device__ __forceinline__ void moe_gather(Frame& F, const bf16* X1B, bf16* XG) {
    unsigned char* ws = F.ws;
    int base[NE]; { int acc = 0;
#pragma unroll
        for (int e = 0; e < NE; ++e) { base[e] = acc; const int cnt = (int)__hip_atomic_load(F.ctl + CW_ECNT + e, RLX_AGENT); acc += ((cnt + 255) >> 8) << 8; } }
    const int gw = F.c * NWAVES + F.wave, NGW = F.G * NWAVES, lane = F.lane;
    for (int it = gw; it < 2 * S; it += NGW) { const int row = it >> 1, k = it & 1;
        const int e = ((const int*)(ws + WS_ROUTE + RT_E))[it], pos = ((const int*)(ws + WS_ROUTE + RT_POS))[it];
        int b = 0;
#pragma unroll
        for (int j = 0; j < NE; ++j) b = (e == j) ? base[j] : b;
        const int slot = b + pos;
        if (lane == 0) ((int*)(ws + WS_ROUTE + RT_SLOT))[it] = slot;
        const GAS v4u* src = (const GAS v4u*)(X1B + (size_t)row * DM) + lane; GAS v4u* dst = (GAS v4u*)(XG + (size_t)slot * DM) + lane;
#pragma unroll
        for (int j = 0; j < 4; ++j) dst[64 * j] = src[64 * j]; (void)k; }
}

#ifndef PG8_SP2
#define PG8_SP2 true
#endif
constexpr int PT_OFF = TE_OFF + 3 * TBL * 4;
static_assert(PT_OFF % 8 == 0 && PT_OFF + 32 * 8 <= LDS_BYTES, "LDS map");
extern __shared__ __attribute__((aligned(16))) unsigned char lds_dyn[];
__device__ __forceinline__ const float* ptr_in(int i) { const unsigned long long v = ((const LAS unsigned long long*)((LAS unsigned char*)lds_dyn + PT_OFF))[i];
    const unsigned lo = __builtin_amdgcn_readfirstlane((unsigned)v), hi = __builtin_amdgcn_readfirstlane((unsigned)(v >> 32)); return (const float*)(const GAS float*)(((unsigned long long)hi << 32) | lo); }
__device__ __forceinline__ void make_frame(Frame& F) {
    F.lds = (LAS unsigned char*)lds_dyn; F.MISC = (volatile LAS unsigned*)(F.lds + MISC_OFF);
    { int t = threadIdx.x; asm volatile("" : "+v"(t)); F.tid = t; } F.lane = F.tid & 63; F.wave = __builtin_amdgcn_readfirstlane(F.tid >> 6);
    { int gg = gridDim.x, cc = blockIdx.x; asm volatile("" : "+s"(gg), "+s"(cc)); F.G = gg; F.c = cc; } F.ws = (unsigned char*)ptr_in(29); F.ctl = (gu32*)(F.ws + WS_CTL);
}
__device__ __forceinline__ void load_in(In& I) {
    I.x = ptr_in(0); I.p = ptr_in(1); I.pos = (const int*)ptr_in(2); I.w_in = ptr_in(3); I.q_gain = ptr_in(4); I.w_qb = ptr_in(5); I.kv_gain = ptr_in(6); I.w_kvb = ptr_in(7);
    I.gla_wg = ptr_in(8); I.gla_bg = ptr_in(9); I.gla_ng = ptr_in(10); I.sinks = ptr_in(11); I.relb = ptr_in(12); I.w_out = ptr_in(13); I.ln1g = ptr_in(14); I.ln1b = ptr_in(15);
    I.f_wg = ptr_in(16); I.f_wu = ptr_in(17); I.f_wd = ptr_in(18); I.router = ptr_in(19); I.m_wg = ptr_in(20); I.m_wu = ptr_in(21); I.m_wd = ptr_in(22); I.p_wu = ptr_in(23);
    I.p_wg = ptr_in(24); I.p_bg = ptr_in(25); I.ln2g = ptr_in(26); I.ln2b = ptr_in(27);
}
typedef pg8::bf16_t pb;
#define WSP(T, off) ((T*)(F.ws + (off)))
#ifndef PHASE_ATTR
#define PHASE_ATTR __forceinline__
#endif
#define PHASE static __device__ PHASE_ATTR void

PHASE ph_prologue() { Frame F; make_frame(F); In I; load_in(I); p0_prologue(F, I); }
PHASE ph_in(int l) { Frame F; make_frame(F);
    pg8::Gemm g{WSP(const pb, WS_XB), WSP(const pb, WS_WIN) + (size_t)l * LDH * DM, DM, DM, DM}; pg8::StaticOrder So; So.init(S, LDH, F.G, F.c);
    pg8::EpiIn E{WSP(pb, WS_HB), LDH, WSP(float, WS_SSQ), WSP(const float, WS_CS)};
    pg8::gemm_phase<pg8::EpiIn, pg8::StaticOrder, true, PG8_SP2>(F.lds + RING_OFF, g, So, E, F.tid);
    if (F.G == 256 && F.c >= 256 - HOLE1_WG) { In I; load_in(I); if (l == 0) bg_convert(F, I, N_PRO256, F.c - (256 - HOLE1_WG), HOLE1_WG, BGQ1); else bg_convert(F, I, N_PRO256 + HOLE1_N + HOLE2_N, F.c - (256 - HOLE3_WG), HOLE3_WG, BGQ3); } }
PHASE ph_upq(int l) { Frame F; make_frame(F);
    pg8::Gemm g{WSP(const pb, WS_HB) + H_QA, WSP(const pb, WS_WQB) + (size_t)l * QW * 512, LDH, 512, 512}; pg8::StaticOrder So; So.init(S, QW, F.G, F.c);
    pg8::EpiUp<true> E{WSP(pb, WS_QB), QW, WSP(const float, WS_SSQ), WSP(const float, WS_CS)};
    pg8::gemm_phase<pg8::EpiUp<true>, pg8::StaticOrder, true, PG8_SP2>(F.lds + RING_OFF, g, So, E, F.tid); }
PHASE ph_upkv(int l) { Frame F; make_frame(F);
    pg8::Gemm g{WSP(const pb, WS_HB) + H_KVA, WSP(const pb, WS_WKVB) + (size_t)l * KVW * 256, LDH, 256, 256}; pg8::StaticOrder So; So.init(S, KVW, F.G, F.c);
    pg8::EpiUp<false> E{WSP(pb, WS_KVB), KVW, WSP(const float, WS_SSQ), WSP(const float, WS_CS)};
    pg8::gemm_phase<pg8::EpiUp<false>, pg8::StaticOrder, true, PG8_SP2>(F.lds + RING_OFF, g, So, E, F.tid); }
PHASE ph_swa(int l) { Frame F; make_frame(F); const float* sinks = ptr_in(11) + l * 8; const float* relb = ptr_in(12);
    for (int u = F.c; u < 512; u += F.G) swa_unit(F, u >> 3, u & 7, WSP(const bf16, WS_HB), WSP(bf16, WS_MIX), sinks, relb); }
PHASE ph_gla1(int l) { Frame F; make_frame(F); const float* wg = ptr_in(8) + (size_t)l * 16 * 256; const float* bg = ptr_in(9) + l * 256; const float* ng = ptr_in(10) + l * 512;
    for (int u = F.c; u < 512; u += F.G) gla_unit<1>(F, u >> 2, u & 3, WSP(const bf16, WS_HB), wg, bg, WSP(float, WS_GUT), WSP(float, WS_GDEC), WSP(const bf16, WS_GSP), ng, WSP(bf16, WS_MIX)); }
PHASE ph_gla3(int l) { Frame F; make_frame(F); const float* wg = ptr_in(8) + (size_t)l * 16 * 256; const float* bg = ptr_in(9) + l * 256; const float* ng = ptr_in(10) + l * 512;
    for (int u = F.c; u < 512; u += F.G) gla_unit<3>(F, u >> 2, u & 3, WSP(const bf16, WS_HB), wg, bg, WSP(float, WS_GUT), WSP(float, WS_GDEC), WSP(const bf16, WS_GSP), ng, WSP(bf16, WS_MIX)); }
PHASE ph_scan() { Frame F; make_frame(F); gla_scan(F, WSP(const float, WS_GUT), WSP(const float, WS_GDEC), WSP(bf16, WS_GSP)); }
PHASE ph_mla() { Frame F; make_frame(F);
    for (int pr = F.c; pr < 256; pr += F.G) { const int h = pr >> 5, qb = pr & 31;
#pragma unroll 1
        for (int k = 0; k < 2; ++k) mla_unit(F, h, k ? qb : 63 - qb, WSP(const bf16, WS_QB), WSP(const bf16, WS_KVB), WSP(const bf16, WS_HB), WSP(bf16, WS_MIX)); } }
PHASE ph_out(int l) { Frame F; make_frame(F);
    pg8::Gemm g{WSP(const pb, WS_MIX), WSP(const pb, WS_WOUT) + (size_t)l * DM * DM, DM, DM, DM}; pg8::StaticOrder So; So.init(S, DM, F.G, F.c);
    pg8::EpiOutRes E{WSP(float, WS_R2), DM, WSP(const pb, WS_XB), ALPHA};
    pg8::gemm_phase<pg8::EpiOutRes, pg8::StaticOrder, true, PG8_SP2>(F.lds + RING_OFF, g, So, E, F.tid); }
PHASE ph_ln1(int l) { Frame F; make_frame(F);
    ln_phase<0, false>(F, WSP(const void, WS_R2), nullptr, nullptr, ptr_in(14) + l * DM, ptr_in(15) + l * DM, nullptr, WSP(bf16, WS_X1B), nullptr); }
PHASE ph_ln1_route(int l) { Frame F; make_frame(F);
    ln_phase<0, true>(F, WSP(const void, WS_R2), nullptr, nullptr, ptr_in(14) + l * DM, ptr_in(15) + l * DM, nullptr, WSP(bf16, WS_X1B), ptr_in(19), WSP(bf16, WS_XG)); }
PHASE ph_gu_dense() { Frame F; make_frame(F);
    pg8::Gemm g{WSP(const pb, WS_X1B), WSP(const pb, WS_FGU), DM, DM, DM}; pg8::StaticOrder So; So.init(S, NGU, F.G, F.c);
    pg8::EpiSwiGLU E{WSP(pb, WS_HMID), DFF};
    pg8::gemm_phase<pg8::EpiSwiGLU, pg8::StaticOrder, true, PG8_SP2>(F.lds + RING_OFF, g, So, E, F.tid);
    if (F.G == 256 && F.c >= 256 - HOLE2_WG) { In I; load_in(I); bg_convert(F, I, N_PRO256 + HOLE1_N, F.c - (256 - HOLE2_WG), HOLE2_WG, BGQ2); } }
PHASE ph_gather() { Frame F; make_frame(F); moe_gather(F, WSP(const bf16, WS_X1B), WSP(bf16, WS_XG)); }
__device__ __forceinline__ bool moe_overflow() {
    const unsigned char* wsp = (const unsigned char*)ptr_in(29); gu32* ctl = (gu32*)(wsp + WS_CTL); bool o = false;
#pragma unroll
    for (int e = 0; e < NE; ++e) o |= (int)__builtin_amdgcn_readfirstlane((int)__hip_atomic_load(ctl + CW_ECNT + e, RLX_AGENT)) > ECAP;
    return o; }
PHASE ph_gu_moe() { Frame F; make_frame(F); moe_tables(F);
    pg8::Gemm g{WSP(const pb, WS_XG), WSP(const pb, WS_MGU), DM, DM, DM};
    pg8::MoeOrder<NGU / 256> Mo{(const PG8_LAS int*)(F.lds + TE_OFF), (const PG8_LAS int*)(F.lds + TE_OFF) + TBL, (const PG8_LAS int*)(F.lds + TE_OFF) + 2 * TBL, ((const LAS int*)(F.lds + TE_OFF))[MAXTILES], F.G, F.c};
    pg8::EpiSwiGLU E{WSP(pb, WS_HMID), DFF};
    pg8::gemm_phase<pg8::EpiSwiGLU, pg8::MoeOrder<NGU / 256>, true, PG8_SP2>(F.lds + RING_OFF, g, Mo, E, F.tid); }
PHASE ph_plegate(int l) { Frame F; make_frame(F);
    pg8::Gemm g{WSP(const pb, WS_X1B), WSP(const pb, WS_WPG) + (size_t)l * DM * DM, DM, DM, DM}; pg8::StaticOrder So; So.init(S, DM, F.G, F.c);
    pg8::EpiPle<0> E{WSP(pb, WS_PLE), DM, ptr_in(25) + l * DM};
    pg8::gemm_phase<pg8::EpiPle<0>, pg8::StaticOrder, true, PG8_SP2>(F.lds + RING_OFF, g, So, E, F.tid); }
PHASE ph_ple_light(int l) { Frame F; make_frame(F); moe_tables(F);
    const int ntot = ((const LAS int*)(F.lds + TE_OFF))[MAXTILES] * (DM / 256), nheavy = ntot - (ntot / F.G) * F.G;
    if (F.c < nheavy) return;
    pg8::StaticOrder So; So.init(S, DM, F.G - nheavy, F.c - nheavy);
    { pg8::Gemm g{WSP(const pb, WS_X1B), WSP(const pb, WS_WPG) + (size_t)l * DM * DM, DM, DM, DM}; pg8::EpiPle<0> E{WSP(pb, WS_PLE), DM, ptr_in(25) + l * DM};
      pg8::gemm_phase<pg8::EpiPle<0>, pg8::StaticOrder, true, PG8_SP2>(F.lds + RING_OFF, g, So, E, F.tid); }
    { pg8::Gemm g{WSP(const pb, WS_PB) + (size_t)l * S * PLE, WSP(const pb, WS_WPU) + (size_t)l * DM * PLE, PLE, PLE, PLE}; pg8::EpiPle<1> E{WSP(pb, WS_PLE), DM, nullptr};
      pg8::gemm_phase<pg8::EpiPle<1>, pg8::StaticOrder, true, PG8_SP2>(F.lds + RING_OFF, g, So, E, F.tid); } }
PHASE ph_down_dense() { Frame F; make_frame(F);
    pg8::Gemm g{WSP(const pb, WS_HMID), WSP(const pb, WS_FD), DFF, DFF, DFF}; pg8::StaticOrder So; So.init(S, DM, F.G, F.c);
    pg8::EpiBf16 E{WSP(pb, WS_R2), DM};
    pg8::gemm_phase<pg8::EpiBf16, pg8::StaticOrder, true, PG8_SP2>(F.lds + RING_OFF, g, So, E, F.tid); }
PHASE ph_down_moe() { Frame F; make_frame(F); moe_tables(F);
    pg8::Gemm g{WSP(const pb, WS_HMID), WSP(const pb, WS_MD), DFF, DFF, DFF};
    pg8::MoeOrder<DM / 256> Mo{(const PG8_LAS int*)(F.lds + TE_OFF), (const PG8_LAS int*)(F.lds + TE_OFF) + TBL, (const PG8_LAS int*)(F.lds + TE_OFF) + 2 * TBL, ((const LAS int*)(F.lds + TE_OFF))[MAXTILES], F.G, F.c};
    pg8::EpiBf16 E{WSP(pb, WS_R2), DM};
    pg8::gemm_phase<pg8::EpiBf16, pg8::MoeOrder<DM / 256>, true, PG8_SP2>(F.lds + RING_OFF, g, Mo, E, F.tid); }
PHASE ph_pleup(int l) { Frame F; make_frame(F);
    pg8::Gemm g{WSP(const pb, WS_PB) + (size_t)l * S * PLE, WSP(const pb, WS_WPU) + (size_t)l * DM * PLE, PLE, PLE, PLE}; pg8::StaticOrder So; So.init(S, DM, F.G, F.c);
    pg8::EpiPle<1> E{WSP(pb, WS_PLE), DM, nullptr};
    pg8::gemm_phase<pg8::EpiPle<1>, pg8::StaticOrder, true, PG8_SP2>(F.lds + RING_OFF, g, So, E, F.tid); }
PHASE ph_ln2_dense(int l) { Frame F; make_frame(F);
    ln_phase<1, false>(F, WSP(const void, WS_R2), WSP(const bf16, WS_X1B), WSP(const bf16, WS_PLE), ptr_in(26) + l * DM, ptr_in(27) + l * DM, nullptr, WSP(bf16, WS_XB), nullptr); }
PHASE ph_ln2_moe(int l) { Frame F; make_frame(F);
    ln_phase<2, false>(F, WSP(const void, WS_R2), WSP(const bf16, WS_X1B), WSP(const bf16, WS_PLE), ptr_in(26) + l * DM, ptr_in(27) + l * DM, (float*)ptr_in(28), nullptr, nullptr); }
PHASE ph_bar() { Frame F; make_frame(F); XcdBarrier bar; bar.bar = (unsigned*)(F.ctl + CW_BAR); bar.x = xb_xcc_id(); bar.st = F.MISC + 8; xcd_barrier(bar); }

struct Args { const float* in[28]; float* out; unsigned char* ws; };
__global__ void __launch_bounds__(NWAVES * 64, 2) fwd_kernel(Args args) {
    { LAS unsigned char* L = (LAS unsigned char*)lds_dyn;
      for (int u = threadIdx.x; u < (LDS_BYTES - LDSCTL_OFF) / 4; u += NWAVES * 64) ((LAS unsigned*)(L + LDSCTL_OFF))[u] = 0u;
      __syncthreads();
      if (threadIdx.x == 0) { LAS unsigned long long* pt = (LAS unsigned long long*)(L + PT_OFF);
#pragma unroll
          for (int i = 0; i < 28; ++i) pt[i] = (unsigned long long)args.in[i];
          pt[28] = (unsigned long long)args.out; pt[29] = (unsigned long long)args.ws; }
      __syncthreads();
      (void)xcd_barrier_post((unsigned*)((gu32*)(args.ws + WS_CTL) + CW_BAR), (volatile LAS unsigned*)(L + MISC_OFF) + 8); }
#ifndef DUP
#define DUP 0
#endif
#define D(bit, call) do { call; if (DUP & (bit)) { call; } } while (0)
#ifdef ONLY
    ONLY; ph_bar();
#else
    D(1, ph_prologue()); ph_bar();
    D(2, ph_in(0)); ph_bar();
    D(4, ph_upq(0)); D(4, ph_upkv(0)); D(8, ph_swa(0)); D(16, ph_gla1(0)); ph_bar();
    D(32, ph_scan()); D(64, ph_mla()); ph_bar();
    D(128, ph_gla3(0)); ph_bar();
    D(256, ph_out(0)); ph_bar();
    D(512, ph_ln1(0)); ph_bar();
    D(1024, ph_gu_dense()); D(2048, ph_plegate(0)); ph_bar();
    D(4096, ph_down_dense()); ph_pleup(0); ph_bar();
    D(512, ph_ln2_dense(0)); ph_bar();
    D(2, ph_in(1)); ph_bar();
    D(4, ph_upq(1)); D(4, ph_upkv(1)); D(8, ph_swa(1)); D(16, ph_gla1(1)); ph_bar();
    D(32, ph_scan()); D(64, ph_mla()); ph_bar();
    D(128, ph_gla3(1)); ph_bar();
    D(256, ph_out(1)); ph_bar();
    ph_ln1_route(1); ph_bar();
    if (moe_overflow()) { ph_gather(); ph_bar(); }
#ifdef PLE_LIGHT
    D(16384, ph_gu_moe()); ph_bar();
    D(32768, ph_down_moe()); ph_ple_light(1); ph_bar();
#else
    D(16384, ph_gu_moe()); D(2048, ph_plegate(1)); ph_bar();
    D(32768, ph_down_moe()); ph_pleup(1); ph_bar();
#endif
    ph_ln2_moe(1);
#endif
}

extern "C" void kernel_launch(void* const* d_in, const int* in_sizes, int n_in, void* d_out, int out_size, void* d_ws, size_t ws_size, hipStream_t stream) {
    static int grid = 0;
    if (grid == 0) {
        if (n_in != 28 || in_sizes[0] != S * DM || out_size != S * DM || ws_size < WS_END) { fprintf(stderr, "kernel_launch: unexpected shapes / workspace (n_in %d, ws %zu, need %zu); nothing launched\n", n_in, ws_size, (size_t)WS_END); grid = -1; return; }
        int dev = 0, cus = 0, per_cu = 0;
        if (hipGetDevice(&dev) != hipSuccess || hipDeviceGetAttribute(&cus, hipDeviceAttributeMultiprocessorCount, dev) != hipSuccess) { grid = -1; return; }
        if (hipFuncSetAttribute((const void*)fwd_kernel, hipFuncAttributeMaxDynamicSharedMemorySize, LDS_BYTES) != hipSuccess) { fprintf(stderr, "kernel_launch: hipFuncSetAttribute failed\n"); grid = -1; return; }
        if (hipOccupancyMaxActiveBlocksPerMultiprocessor(&per_cu, (const void*)fwd_kernel, NWAVES * 64, LDS_BYTES) != hipSuccess || per_cu < 1) { fprintf(stderr, "kernel_launch: occupancy query reports %d workgroups per CU\n", per_cu); (void)hipGetLastError(); grid = -1; return; }
        grid = cus;
    }
    if (grid < 0) return;
    if (hipMemsetAsync((char*)d_ws + WS_CTL, 0, CTL_ZERO_BYTES, stream) != hipSuccess) return;
    Args a{};
    for (int i = 0; i < 28; ++i) a.in[i] = (const float*)d_in[i];
    a.out = (float*)d_out; a.ws = (unsigned char*)d_ws;
    hipLaunchKernelGGL(fwd_kernel, dim3(grid), dim3(NWAVES * 64), LDS_BYTES, stream, a);
}
```

```cpp
#include <hip/hip_runtime.h>
#include <cstdio>
#include <cstdint>
namespace pg8 {
#define PG8_LAS __attribute__((address_space(3)))
typedef unsigned short bf16_t;
typedef short bf16x8 __attribute__((ext_vector_type(8)));
typedef float f32x4 __attribute__((ext_vector_type(4)));
typedef unsigned u32x4 __attribute__((ext_vector_type(4)));
constexpr int BM = 256, BK = 64, HALF = 128, HTB = HALF * BK * 2  , STAGE_BYTES = 8 * HTB, NXCD = 8, WGM = 8;

__host__ __device__ __forceinline__ int lds_byte(int r, int c) { const int st = (r >> 4) * 2 + (c >> 5), rr = r & 15, cc = c & 31, ob = rr * 64 + cc * 2; return st * 1024 + (ob ^ (((ob >> 9) & 1) << 5)); }
__host__ __device__ __forceinline__ void stage_rc(int b, int& R, int& C) { const int st = b / 1024, sb = b % 1024, swz = sb ^ (((sb >> 9) & 1) << 5); R = (st >> 1) * 16 + swz / 64; C = (st & 1) * 32 + (swz % 64) / 2; }
__host__ __device__ __forceinline__ int perm32(int rho) { const int n = rho >> 4, i = rho & 15; return 8 * (i >> 2) + 4 * n + (i & 3); }

struct Unit { int pm, pn, pb, rows; };
struct Gemm { const bf16_t* A; const bf16_t* Bt; int lda, ldb, K; };

struct StaticOrder {
    static constexpr bool PARTIAL = false;
    int nM, nN, nwg, G, c;
    __host__ __device__ void init(int M, int N, int G_, int c_) { nM = M / BM; nN = N / BM; nwg = nM * nN; G = G_; c = c_; }
    __host__ __device__ bool next(int i, Unit& u) const {
        const long L = (long)i * G + c; if (L >= nwg) return false;
        int wgid = (int)L; { const int q = nwg / NXCD, r = nwg % NXCD, xcd = wgid % NXCD, off = wgid / NXCD; wgid = (xcd < r ? xcd * (q + 1) : r * (q + 1) + (xcd - r) * q) + off; }
        const int nig = WGM * nN, gid = wgid / nig, fm = gid * WGM, gsz = (nM - fm) < WGM ? (nM - fm) : WGM;
        u.pm = fm + ((wgid % nig) % gsz); u.pn = (wgid % nig) / gsz; u.pb = u.pn; u.rows = BM; return true;
    }
    __device__ __forceinline__ void a_ready(const Unit&) const {}
    __device__ __forceinline__ void done(const Unit&) const {}
};
#ifndef MOE_PARTIAL
#define MOE_PARTIAL false
#endif
template <int nN> struct MoeOrder {
    static constexpr bool PARTIAL = MOE_PARTIAL;
    const PG8_LAS int* te; const PG8_LAS int* trow; const PG8_LAS int* tval; int ntiles, G, c;
    __device__ __forceinline__ bool next(int i, Unit& u) const {
        const int L = i * G + c; if (L >= ntiles * nN) return false;
        const int idx = L / nN; u.pn = L - idx * nN; u.pm = trow[idx]; u.pb = te[idx] * nN + u.pn; u.rows = tval[idx]; return true;
    }
    __device__ __forceinline__ void a_ready(const Unit&) const {}
    __device__ __forceinline__ void done(const Unit&) const {}
};
typedef float f32x2v __attribute__((ext_vector_type(2))); typedef __bf16 bf16x2v __attribute__((ext_vector_type(2)));
__device__ __forceinline__ unsigned cvt_pk_bf16(float lo, float hi) { const f32x2v v = {lo, hi}; const bf16x2v r = __builtin_convertvector(v, bf16x2v); return __builtin_bit_cast(unsigned, r); }
typedef float f32x2 __attribute__((ext_vector_type(2)));
__device__ __forceinline__ float fast_sigmoid(float v) { return __builtin_amdgcn_rcpf(1.0f + __builtin_amdgcn_exp2f(-1.4426950408889634f * v)); }
__device__ __forceinline__ u32x4 pack8(const f32x4 a, const f32x4 b) { u32x4 w; w.x = cvt_pk_bf16(a[0], a[1]); w.y = cvt_pk_bf16(a[2], a[3]); w.z = cvt_pk_bf16(b[0], b[1]); w.w = cvt_pk_bf16(b[2], b[3]); return w; }
__device__ __forceinline__ void rope8(f32x4& a, f32x4& b, const f32x4 c4, const f32x4 s4) {
    const f32x4 a0 = a, b0 = b;
    a[0] = a0[0] * c4[0] - a0[1] * s4[0]; a[1] = a0[1] * c4[0] + a0[0] * s4[0];
    a[2] = a0[2] * c4[1] - a0[3] * s4[1]; a[3] = a0[3] * c4[1] + a0[2] * s4[1];
    b[0] = b0[0] * c4[2] - b0[1] * s4[2]; b[1] = b0[1] * c4[2] + b0[0] * s4[2];
    b[2] = b0[2] * c4[3] - b0[3] * s4[3]; b[3] = b0[3] * c4[3] + b0[2] * s4[3];
}
struct EpiIn {
    static constexpr bool PERM = true, AFTER_DRAIN = false;
    bf16_t* H; int ldc; float* ssq; const float* cs;
    __device__ __forceinline__ void operator()(const f32x4 (&acc)[2][2][4][2], const Unit& u, int wr, int wc, int fr, int fq) const {
        const int row0 = u.pm * BM + wr * 64 + fr, col0 = u.pn * BM + wc * 32 + 8 * fq;
#pragma unroll
        for (int ai = 0; ai < 2; ++ai)
#pragma unroll
            for (int m = 0; m < 4; ++m) { const int row = row0 + ai * HALF + m * 16; bf16_t* rowp = H + (size_t)row * ldc + col0; float s = 0.f;
#pragma unroll
                for (int bj = 0; bj < 2; ++bj) { f32x4 v0 = acc[ai][bj][m][0], v1 = acc[ai][bj][m][1];
                    if (bj == 0 && u.pn == 3 && wc < 2) { const int p0 = (wc * 32 + 8 * fq) >> 1; const f32x4 c4 = *(const f32x4*)(cs + (size_t)row * 64 + p0), s4 = *(const f32x4*)(cs + (size_t)row * 64 + 32 + p0); rope8(v0, v1, c4, s4); }
                    s += (v0[0] * v0[0] + v0[1] * v0[1]) + (v0[2] * v0[2] + v0[3] * v0[3]) + (v1[0] * v1[0] + v1[1] * v1[1]) + (v1[2] * v1[2] + v1[3] * v1[3]);
                    *(u32x4*)(rowp + bj * HALF) = pack8(v0, v1); }
                if (u.pn < 3) { s += __shfl_xor(s, 16); s += __shfl_xor(s, 32); if (fq == 0) ssq[(size_t)row * 12 + u.pn * 4 + wc] = s; } }
    }
};
template <bool ISQ> struct EpiUp {
    static constexpr bool PERM = true, AFTER_DRAIN = false;
    bf16_t* O; int ldc; const float* ssq; const float* cs;
    __device__ __forceinline__ void operator()(const f32x4 (&acc)[2][2][4][2], const Unit& u, int wr, int wc, int fr, int fq) const {
        const int row0 = u.pm * BM + wr * 64 + fr, col0 = u.pn * BM + wc * 32 + 8 * fq;
#pragma unroll
        for (int ai = 0; ai < 2; ++ai)
#pragma unroll
            for (int m = 0; m < 4; ++m) { const int row = row0 + ai * HALF + m * 16; bf16_t* rowp = O + (size_t)row * ldc + col0;
                const float* sp = ssq + (size_t)row * 12 + (ISQ ? 0 : 8); float r;
                if (ISQ) { const f32x4 a = *(const f32x4*)sp, b = *(const f32x4*)(sp + 4);
                    const float s = ((a[0] + a[1]) + (a[2] + a[3])) + ((b[0] + b[1]) + (b[2] + b[3])); r = 1.0f / sqrtf(s * (1.0f / 512.0f) + 1e-6f); }
                else { const f32x4 a = *(const f32x4*)sp; const float s = (a[0] + a[1]) + (a[2] + a[3]); r = 1.0f / sqrtf(s * (1.0f / 256.0f) + 1e-6f); }
#pragma unroll
                for (int bj = 0; bj < 2; ++bj) { f32x4 v0 = acc[ai][bj][m][0] * r, v1 = acc[ai][bj][m][1] * r;
                    if (ISQ) { const int col = col0 + bj * HALF, hc = col % 192;
                        if (hc >= 128) { const int p0 = (hc - 128) >> 1; const f32x4 c4 = *(const f32x4*)(cs + (size_t)row * 64 + p0), s4 = *(const f32x4*)(cs + (size_t)row * 64 + 32 + p0); rope8(v0, v1, c4, s4); } }
                    *(u32x4*)(rowp + bj * HALF) = pack8(v0, v1); } }
    }
};
struct EpiOutRes {
    static constexpr bool PERM = false, AFTER_DRAIN = false;
    float* C; int ldc; const bf16_t* res; float alpha;
    __device__ __forceinline__ void operator()(const f32x4 (&acc)[2][2][4][2], const Unit& u, int wr, int wc, int fr, int fq) const {
        const int row0 = u.pm * BM + wr * 64 + fr, col0 = u.pn * BM + wc * 32 + 4 * fq;
        typedef unsigned u32x2 __attribute__((ext_vector_type(2)));
#pragma unroll
        for (int ai = 0; ai < 2; ++ai)
#pragma unroll
            for (int m = 0; m < 4; ++m) { const size_t ro = (size_t)(row0 + ai * HALF + m * 16) * ldc + col0;
#pragma unroll
                for (int bj = 0; bj < 2; ++bj)
#pragma unroll
                    for (int n = 0; n < 2; ++n) { f32x4 v = acc[ai][bj][m][n]; const u32x2 r = *(const u32x2*)(res + ro + bj * HALF + n * 16);
                        v[0] += alpha * __builtin_bit_cast(float, r.x << 16); v[1] += alpha * __builtin_bit_cast(float, r.x & 0xffff0000u);
                        v[2] += alpha * __builtin_bit_cast(float, r.y << 16); v[3] += alpha * __builtin_bit_cast(float, r.y & 0xffff0000u);
                        *(f32x4*)(C + ro + bj * HALF + n * 16) = v; } }
    }
};
struct EpiBf16 {
    static constexpr bool PERM = true, AFTER_DRAIN = false;
    bf16_t* O; int ldc;
    __device__ __forceinline__ void operator()(const f32x4 (&acc)[2][2][4][2], const Unit& u, int wr, int wc, int fr, int fq) const {
        const int row0 = u.pm * BM + wr * 64 + fr, col0 = u.pn * BM + wc * 32 + 8 * fq;
#pragma unroll
        for (int ai = 0; ai < 2; ++ai)
#pragma unroll
            for (int m = 0; m < 4; ++m) { bf16_t* rowp = O + (size_t)(row0 + ai * HALF + m * 16) * ldc + col0;
#pragma unroll
                for (int bj = 0; bj < 2; ++bj) *(u32x4*)(rowp + bj * HALF) = pack8(acc[ai][bj][m][0], acc[ai][bj][m][1]); }
    }
};
template <int MODE> struct EpiPle {
    static constexpr bool PERM = true, AFTER_DRAIN = false;
    bf16_t* C; int ldc; const float* bias;
    __device__ __forceinline__ void operator()(const f32x4 (&acc)[2][2][4][2], const Unit& u, int wr, int wc, int fr, int fq) const {
        const int row0 = u.pm * BM + wr * 64 + fr, col0 = u.pn * BM + wc * 32 + 8 * fq;
#pragma unroll
        for (int ai = 0; ai < 2; ++ai)
#pragma unroll
            for (int m = 0; m < 4; ++m) { bf16_t* rowp = C + (size_t)(row0 + ai * HALF + m * 16) * ldc + col0;
#pragma unroll
                for (int bj = 0; bj < 2; ++bj) { f32x4 v0 = acc[ai][bj][m][0], v1 = acc[ai][bj][m][1]; bf16_t* cp = rowp + bj * HALF;
                    if (MODE == 0) { const f32x4 b0 = *(const f32x4*)(bias + col0 + bj * HALF), b1 = *(const f32x4*)(bias + col0 + bj * HALF + 4); v0 = v0 + b0; v1 = v1 + b1;
#pragma unroll
                        for (int e = 0; e < 4; ++e) { v0[e] = fast_sigmoid(v0[e]); v1[e] = fast_sigmoid(v1[e]); } }
                    else { const u32x4 s = *(const u32x4*)cp;
                        v0[0] *= __builtin_bit_cast(float, s.x << 16); v0[1] *= __builtin_bit_cast(float, s.x & 0xffff0000u); v0[2] *= __builtin_bit_cast(float, s.y << 16); v0[3] *= __builtin_bit_cast(float, s.y & 0xffff0000u);
                        v1[0] *= __builtin_bit_cast(float, s.z << 16); v1[1] *= __builtin_bit_cast(float, s.z & 0xffff0000u); v1[2] *= __builtin_bit_cast(float, s.w << 16); v1[3] *= __builtin_bit_cast(float, s.w & 0xffff0000u); }
                    *(u32x4*)cp = pack8(v0, v1); } }
    }
};
struct EpiSwiGLU {
    static constexpr bool PERM = true, AFTER_DRAIN = false;
    bf16_t* O; int ldc;
    __device__ __forceinline__ void operator()(const f32x4 (&acc)[2][2][4][2], const Unit& u, int wr, int wc, int fr, int fq) const {
        const int row0 = u.pm * BM + wr * 64 + fr, col0 = u.pn * HALF + wc * 32 + 8 * fq;
#pragma unroll
        for (int ai = 0; ai < 2; ++ai)
#pragma unroll
            for (int m = 0; m < 4; ++m) { bf16_t* rowp = O + (size_t)(row0 + ai * HALF + m * 16) * ldc + col0;
                f32x4 o[2];
#pragma unroll
                for (int n = 0; n < 2; ++n) { const f32x4 g = acc[ai][0][m][n], up = acc[ai][1][m][n];
#pragma unroll
                    for (int e = 0; e < 4; ++e) o[n][e] = g[e] * fast_sigmoid(g[e]) * up[e]; }
                *(u32x4*)rowp = pack8(o[0], o[1]); }
    }
};
template <class Epi, class Sched, bool ALIGN_EPI = false, bool SP2 = false>
__device__ __forceinline__ void gemm_phase(PG8_LAS unsigned char* lds, const Gemm g, const Sched& S, const Epi& E, const int tid) {
    const int wid = __builtin_amdgcn_readfirstlane(tid >> 6), lane = tid & 63, wr = wid >> 2, wc = wid & 3, fr = lane & 15, fq = lane >> 4;
    const int K = g.K, nt = K / BK;
    unsigned voffA[2], voffB[2];
#pragma unroll
    for (int i = 0; i < 2; ++i) { int R, C; stage_rc(tid * 16 + i * 8192, R, C); const int Rb = Epi::PERM ? ((R & ~31) + perm32(R & 31)) : R;
        voffA[i] = (unsigned)(R * g.lda + C) * 2u; voffB[i] = (unsigned)(Rb * g.ldb + C) * 2u; }
    const size_t kstep = (size_t)(BK * 2);
    const size_t hstepA = (size_t)HALF * g.lda * 2, hstepB = (size_t)HALF * g.ldb * 2;
    const size_t tstepA = 2 * hstepA, tstepB = 2 * hstepB;
    const unsigned ldsw = (unsigned)wid * 1024u;
    const int aoff = lds_byte(wr * 64 + fr, fq * 8), boff = lds_byte(wc * 32 + fr, fq * 8);
#define PG8_SA(b, h) (((b) * 2 + (h)) * HTB)
#define PG8_SB(b, h) ((4 + (b) * 2 + (h)) * HTB)
#define PG8_STAGE(bufoff, gbase, voff) do { _Pragma("unroll") for (int _i = 0; _i < 2; ++_i) \
        __builtin_amdgcn_global_load_lds((const unsigned*)((const char*)(gbase) + (voff)[_i]), (PG8_LAS unsigned*)(lds + (bufoff) + ldsw + _i * 8192), 16, 0, 0); } while (0)
#define PG8_LDA(dst, b, h) do { _Pragma("unroll") for (int m = 0; m < 4; ++m) _Pragma("unroll") for (int k = 0; k < 2; ++k) dst[m][k] = *(const PG8_LAS bf16x8*)(lds + PG8_SA(b, h) + aoff + m * 2048 + k * 1024); } while (0)
#define PG8_LDB(dst, b, h) do { _Pragma("unroll") for (int n = 0; n < 2; ++n) _Pragma("unroll") for (int k = 0; k < 2; ++k) dst[n][k] = *(const PG8_LAS bf16x8*)(lds + PG8_SB(b, h) + boff + n * 2048 + k * 1024); } while (0)
#define PG8_MMA(ai, bj, At, Bt) do { __builtin_amdgcn_s_setprio(1); _Pragma("unroll") for (int m = 0; m < 4; ++m) _Pragma("unroll") for (int n = 0; n < 2; ++n) _Pragma("unroll") for (int k = 0; k < 2; ++k) \
        acc[ai][bj][m][n] = __builtin_amdgcn_mfma_f32_16x16x32_bf16(Bt[n][k], At[m][k], acc[ai][bj][m][n], 0, 0, 0); __builtin_amdgcn_s_setprio(0); } while (0)
#define PG8_MMAG(ai, bj, At, Bt) do { if (Sched::PARTIAL && !((ai) == 0 ? on0 : on1)) break; __builtin_amdgcn_s_setprio(1); _Pragma("unroll") for (int m = 0; m < 4; ++m) _Pragma("unroll") for (int n = 0; n < 2; ++n) _Pragma("unroll") for (int k = 0; k < 2; ++k) \
        acc[ai][bj][m][n] = __builtin_amdgcn_mfma_f32_16x16x32_bf16(Bt[n][k], At[m][k], acc[ai][bj][m][n], 0, 0, 0); __builtin_amdgcn_s_setprio(0); } while (0)
#define PG8_WAIT_V(n) asm volatile("s_waitcnt vmcnt(" #n ")" ::: "memory")
#define PG8_WAIT_L(n) asm volatile("s_waitcnt lgkmcnt(" #n ")" ::: "memory")
#define PG8_BAR __builtin_amdgcn_s_barrier()
#define PG8_SCHED __builtin_amdgcn_sched_barrier(0)
    Unit cur, nxt; int ui = 0;
    if (!S.next(0, cur)) return;
    bool on0 = true, on1 = true;
    if constexpr (Sched::PARTIAL) { on0 = cur.rows > wr * 64; on1 = cur.rows > HALF + wr * 64; }
    f32x4 acc[2][2][4][2];
#pragma unroll
    for (int a = 0; a < 2; ++a)
#pragma unroll
        for (int b = 0; b < 2; ++b)
#pragma unroll
            for (int m = 0; m < 4; ++m)
#pragma unroll
                for (int n = 0; n < 2; ++n) acc[a][b][m][n] = (f32x4){0.f, 0.f, 0.f, 0.f};
    bf16x8 At[4][2], B0[2][2], B1[2][2];
    const char* cA = (const char*)g.A + (size_t)cur.pm * tstepA; const char* cB = (const char*)g.Bt + (size_t)cur.pb * tstepB;
    S.a_ready(cur);
    if constexpr (SP2) {
        PG8_STAGE(PG8_SB(0, 0), cB, voffB); PG8_STAGE(PG8_SB(0, 1), cB + hstepB, voffB); PG8_STAGE(PG8_SA(0, 0), cA, voffA); PG8_STAGE(PG8_SA(0, 1), cA + hstepA, voffA);
        if (wr == 1) PG8_BAR;
        PG8_WAIT_V(2); PG8_BAR;
        PG8_STAGE(PG8_SB(1, 0), cB + kstep, voffB); PG8_STAGE(PG8_SA(1, 0), cA + kstep, voffA); PG8_STAGE(PG8_SB(1, 1), cB + hstepB + kstep, voffB);
        PG8_WAIT_V(6); PG8_BAR;
    } else {
        PG8_STAGE(PG8_SB(0, 0), cB, voffB); PG8_STAGE(PG8_SA(0, 0), cA, voffA); PG8_STAGE(PG8_SB(0, 1), cB + hstepB, voffB); PG8_STAGE(PG8_SA(0, 1), cA + hstepA, voffA);
        if (wr == 1) PG8_BAR;
        PG8_WAIT_V(4); PG8_BAR;
        PG8_STAGE(PG8_SB(1, 0), cB + kstep, voffB); PG8_STAGE(PG8_SA(1, 0), cA + kstep, voffA); PG8_STAGE(PG8_SB(1, 1), cB + hstepB + kstep, voffB);
        PG8_WAIT_V(6); PG8_BAR;
    }
    for (;;) {
        const bool has_next = S.next(ui + 1, nxt);
        const char* nA = has_next ? (const char*)g.A + (size_t)nxt.pm * tstepA : cA; const char* nB = has_next ? (const char*)g.Bt + (size_t)nxt.pb * tstepB : cB;
        if (Sched::PARTIAL && !(on0 && on1)) {
        for (int t = 0; t < nt; t += 2) {
            const bool last = (t == nt - 2);
            const char* a1 = cA + (size_t)(t + 1) * kstep;
            const char* a2 = last ? nA : cA + (size_t)(t + 2) * kstep; const char* b2 = last ? nB : cB + (size_t)(t + 2) * kstep;
            const char* a3 = a2 + kstep; const char* b3 = b2 + kstep;
            if (last && has_next) S.a_ready(nxt);
            if constexpr (SP2) {
            PG8_LDB(B0, 0, 0); PG8_LDB(B1, 0, 1); PG8_SCHED; PG8_LDA(At, 0, 0); PG8_STAGE(PG8_SA(1, 1), a1 + hstepA, voffA);
            PG8_WAIT_V(8); PG8_WAIT_L(0); PG8_BAR; PG8_MMAG(0, 0, At, B0); PG8_MMAG(0, 1, At, B1); PG8_BAR; PG8_SCHED;
            PG8_LDA(At, 0, 1); PG8_STAGE(PG8_SB(0, 0), b2, voffB); PG8_STAGE(PG8_SB(0, 1), b2 + hstepB, voffB); PG8_STAGE(PG8_SA(0, 0), a2, voffA);
            PG8_WAIT_V(8); PG8_WAIT_L(0); PG8_BAR; PG8_MMAG(1, 0, At, B0); PG8_MMAG(1, 1, At, B1); PG8_BAR; PG8_SCHED;
            PG8_LDB(B0, 1, 0); PG8_LDB(B1, 1, 1); PG8_SCHED; PG8_LDA(At, 1, 0); PG8_STAGE(PG8_SA(0, 1), a2 + hstepA, voffA);
            PG8_WAIT_V(8); PG8_WAIT_L(0); PG8_BAR; PG8_MMAG(0, 0, At, B0); PG8_MMAG(0, 1, At, B1); PG8_BAR; PG8_SCHED;
            PG8_LDA(At, 1, 1); PG8_STAGE(PG8_SB(1, 0), b3, voffB); PG8_STAGE(PG8_SB(1, 1), b3 + hstepB, voffB); PG8_STAGE(PG8_SA(1, 0), a3, voffA);
            PG8_WAIT_V(8); PG8_WAIT_L(0); PG8_BAR; PG8_MMAG(1, 0, At, B0); PG8_MMAG(1, 1, At, B1); PG8_BAR; PG8_SCHED;
            } else {
            PG8_LDB(B0, 0, 0); PG8_SCHED; PG8_LDA(At, 0, 0); PG8_STAGE(PG8_SA(1, 1), a1 + hstepA, voffA);
            PG8_WAIT_L(8); PG8_BAR; PG8_WAIT_L(0); PG8_MMAG(0, 0, At, B0); PG8_BAR; PG8_SCHED;
            PG8_LDB(B1, 0, 1); PG8_STAGE(PG8_SB(0, 0), b2, voffB);
            PG8_BAR; PG8_WAIT_L(0); PG8_MMAG(0, 1, At, B1); PG8_BAR;
            PG8_LDA(At, 0, 1); PG8_STAGE(PG8_SA(0, 0), a2, voffA);
            PG8_BAR; PG8_WAIT_L(0); PG8_MMAG(1, 0, At, B0); PG8_BAR; PG8_SCHED;
            PG8_STAGE(PG8_SB(0, 1), b2 + hstepB, voffB);
            PG8_WAIT_V(6); PG8_BAR; PG8_MMAG(1, 1, At, B1); PG8_BAR;
            PG8_LDB(B0, 1, 0); PG8_SCHED; PG8_LDA(At, 1, 0); PG8_STAGE(PG8_SA(0, 1), a2 + hstepA, voffA);
            PG8_WAIT_L(8); PG8_BAR; PG8_WAIT_L(0); PG8_MMAG(0, 0, At, B0); PG8_BAR; PG8_SCHED;
            PG8_LDB(B1, 1, 1); PG8_STAGE(PG8_SB(1, 0), b3, voffB);
            PG8_BAR; PG8_WAIT_L(0); PG8_MMAG(0, 1, At, B1); PG8_BAR;
            PG8_LDA(At, 1, 1); PG8_STAGE(PG8_SA(1, 0), a3, voffA);
            PG8_BAR; PG8_WAIT_L(0); PG8_MMAG(1, 0, At, B0); PG8_BAR; PG8_SCHED;
            PG8_STAGE(PG8_SB(1, 1), b3 + hstepB, voffB);
            PG8_WAIT_V(6); PG8_BAR; PG8_MMAG(1, 1, At, B1); PG8_BAR;
            }
        }
        } else {
        for (int t = 0; t < nt; t += 2) {
            const bool last = (t == nt - 2);
            const char* a1 = cA + (size_t)(t + 1) * kstep;
            const char* a2 = last ? nA : cA + (size_t)(t + 2) * kstep; const char* b2 = last ? nB : cB + (size_t)(t + 2) * kstep;
            const char* a3 = a2 + kstep; const char* b3 = b2 + kstep;
            if (last && has_next) S.a_ready(nxt);
            if constexpr (SP2) {
            PG8_LDB(B0, 0, 0); PG8_LDB(B1, 0, 1); PG8_SCHED; PG8_LDA(At, 0, 0); PG8_STAGE(PG8_SA(1, 1), a1 + hstepA, voffA);
            PG8_WAIT_V(8); PG8_WAIT_L(0); PG8_BAR; PG8_MMA(0, 0, At, B0); PG8_MMA(0, 1, At, B1); PG8_BAR; PG8_SCHED;
            PG8_LDA(At, 0, 1); PG8_STAGE(PG8_SB(0, 0), b2, voffB); PG8_STAGE(PG8_SB(0, 1), b2 + hstepB, voffB); PG8_STAGE(PG8_SA(0, 0), a2, voffA);
            PG8_WAIT_V(8); PG8_WAIT_L(0); PG8_BAR; PG8_MMA(1, 0, At, B0); PG8_MMA(1, 1, At, B1); PG8_BAR; PG8_SCHED;
            PG8_LDB(B0, 1, 0); PG8_LDB(B1, 1, 1); PG8_SCHED; PG8_LDA(At, 1, 0); PG8_STAGE(PG8_SA(0, 1), a2 + hstepA, voffA);
            PG8_WAIT_V(8); PG8_WAIT_L(0); PG8_BAR; PG8_MMA(0, 0, At, B0); PG8_MMA(0, 1, At, B1); PG8_BAR; PG8_SCHED;
            PG8_LDA(At, 1, 1); PG8_STAGE(PG8_SB(1, 0), b3, voffB); PG8_STAGE(PG8_SB(1, 1), b3 + hstepB, voffB); PG8_STAGE(PG8_SA(1, 0), a3, voffA);
            PG8_WAIT_V(8); PG8_WAIT_L(0); PG8_BAR; PG8_MMA(1, 0, At, B0); PG8_MMA(1, 1, At, B1); PG8_BAR; PG8_SCHED;
            } else {
            PG8_LDB(B0, 0, 0); PG8_SCHED; PG8_LDA(At, 0, 0); PG8_STAGE(PG8_SA(1, 1), a1 + hstepA, voffA);
            PG8_WAIT_L(8); PG8_BAR; PG8_WAIT_L(0); PG8_MMA(0, 0, At, B0); PG8_BAR; PG8_SCHED;
            PG8_LDB(B1, 0, 1); PG8_STAGE(PG8_SB(0, 0), b2, voffB);
            PG8_BAR; PG8_WAIT_L(0); PG8_MMA(0, 1, At, B1); PG8_BAR;
            PG8_LDA(At, 0, 1); PG8_STAGE(PG8_SA(0, 0), a2, voffA);
            PG8_BAR; PG8_WAIT_L(0); PG8_MMA(1, 0, At, B0); PG8_BAR; PG8_SCHED;
            PG8_STAGE(PG8_SB(0, 1), b2 + hstepB, voffB);
            PG8_WAIT_V(6); PG8_BAR; PG8_MMA(1, 1, At, B1); PG8_BAR;
            PG8_LDB(B0, 1, 0); PG8_SCHED; PG8_LDA(At, 1, 0); PG8_STAGE(PG8_SA(0, 1), a2 + hstepA, voffA);
            PG8_WAIT_L(8); PG8_BAR; PG8_WAIT_L(0); PG8_MMA(0, 0, At, B0); PG8_BAR; PG8_SCHED;
            PG8_LDB(B1, 1, 1); PG8_STAGE(PG8_SB(1, 0), b3, voffB);
            PG8_BAR; PG8_WAIT_L(0); PG8_MMA(0, 1, At, B1); PG8_BAR;
            PG8_LDA(At, 1, 1); PG8_STAGE(PG8_SA(1, 0), a3, voffA);
            PG8_BAR; PG8_WAIT_L(0); PG8_MMA(1, 0, At, B0); PG8_BAR; PG8_SCHED;
            PG8_STAGE(PG8_SB(1, 1), b3 + hstepB, voffB);
            PG8_WAIT_V(6); PG8_BAR; PG8_MMA(1, 1, At, B1); PG8_BAR;
            }
        }
        }
        if constexpr (ALIGN_EPI) { if (wr == 0) PG8_BAR; }
        if constexpr (!Epi::AFTER_DRAIN) { E(acc, cur, wr, wc, fr, fq); S.done(cur); }
        if (!has_next) break;
#pragma unroll
        for (int a = 0; a < 2; ++a)
#pragma unroll
            for (int b = 0; b < 2; ++b)
#pragma unroll
                for (int m = 0; m < 4; ++m)
#pragma unroll
                    for (int n = 0; n < 2; ++n) acc[a][b][m][n] = (f32x4){0.f, 0.f, 0.f, 0.f};
        cur = nxt; cA = nA; cB = nB; ++ui;
        if constexpr (Sched::PARTIAL) { on0 = cur.rows > wr * 64; on1 = cur.rows > HALF + wr * 64; }
        if constexpr (ALIGN_EPI) { if (wr == 1) PG8_BAR; }
    }
    PG8_WAIT_V(0);
    if constexpr (!ALIGN_EPI) { if (wr == 0) PG8_BAR; }
    PG8_BAR;
    if constexpr (Epi::AFTER_DRAIN) { E.fused(acc, cur, wr, wc, fr, fq, lds, wid, lane); S.done(cur); }
#undef PG8_SA
#undef PG8_SB
#undef PG8_STAGE
#undef PG8_LDA
#undef PG8_LDB
#undef PG8_MMA
#undef PG8_MMAG
#undef PG8_WAIT_V
#undef PG8_WAIT_L
#undef PG8_BAR
#undef PG8_SCHED
}
}
#ifndef PLE_LIGHT
#define PLE_LIGHT 1
#endif
constexpr int NWAVES = 8;
constexpr int S = 8192, DM = 2048, DEPTH = 2;
constexpr int IN_COLS = 3152, LDH = 3328;
constexpr int QW = 1536, KVW = 2048;
constexpr int DFF = 5632, NGU = 2 * DFF, NE = 8, PLE = 256;
constexpr int MAXTILES = 72, XG_ROWS = MAXTILES * 256;
constexpr int H_QA = 0, H_KVA = 512, H_KPE = 768, H_GQ = 832, H_GK = 1088, H_GV = 1344, H_GR = 1856, H_SQ = 2368, H_SK = 2880, H_SV = 3008, H_GLR = 3136;
constexpr float LN_EPS = 1e-5f, RMS_EPS = 1e-6f, ALPHA = 1.4142135623730951f;
constexpr float QSCALE = 0.07216878364870322f * 1.4426950408889634f;

constexpr size_t MiB = 1u << 20;
constexpr size_t WS_CTL = 0, CTL_ZERO_BYTES = 1 * MiB;
constexpr size_t WS_CS = 1 * MiB, WS_SSQ = 3 * MiB, WS_ROUTE = 4 * MiB, WS_GDEC = 5 * MiB, WS_PB = 6 * MiB, WS_XB = 14 * MiB;
constexpr size_t WS_WIN = 46 * MiB, WS_WQB = 72 * MiB, WS_WKVB = 75 * MiB, WS_WOUT = 77 * MiB, WS_WPU = 93 * MiB, WS_WPG = 95 * MiB;
constexpr size_t WS_FGU = 111 * MiB, WS_FD = 155 * MiB, WS_MGU = 177 * MiB, WS_MD = 529 * MiB;
constexpr size_t WS_R1 = 705 * MiB;
constexpr size_t WS_HB = WS_R1, WS_QB = WS_R1 + 52 * MiB, WS_KVB = WS_R1 + 76 * MiB, WS_MIX = WS_R1 + 108 * MiB, WS_GUT = WS_R1 + 140 * MiB, WS_GSP = WS_R1 + 156 * MiB, WS_HMID = WS_R1;
constexpr size_t WS_R2 = 905 * MiB;
constexpr size_t WS_X1F = 1049 * MiB, WS_X1B = 1113 * MiB, WS_PLE = 1145 * MiB, WS_XG = 1209 * MiB, WS_XF = 1281 * MiB, WS_END = 1345 * MiB;
static_assert((size_t)DEPTH * LDH * DM * 2 <= 26 * MiB && (size_t)S * LDH * 2 <= 52 * MiB && (size_t)XG_ROWS * DFF * 2 <= 200 * MiB && (size_t)XG_ROWS * DM * 4 <= 144 * MiB && (size_t)XG_ROWS * DM * 2 <= 72 * MiB, "ws map");
constexpr int CW_TMO = 0, CW_CODE = 1;
constexpr int CW_ECNT = 64;
constexpr int CW_BAR = 4096;
constexpr size_t RT_E = 0, RT_POS = 64 * 1024, RT_W = 128 * 1024, RT_SLOT = 192 * 1024;

constexpr int RING_OFF = 0, RING_BYTES = 131072;
constexpr int TBL = MAXTILES + 24;
constexpr int LDSCTL_OFF = RING_BYTES, MISC_OFF = LDSCTL_OFF + 320, TE_OFF = MISC_OFF + 128;
constexpr int LDS_BYTES = 147456;
static_assert(TE_OFF + 3 * TBL * 4 <= LDS_BYTES, "LDS map");

#define GAS __attribute__((address_space(1)))
#define LAS __attribute__((address_space(3)))
typedef unsigned short bf16;
typedef unsigned v4u __attribute__((ext_vector_type(4)));
typedef unsigned v2u __attribute__((ext_vector_type(2)));
typedef float f32x4 __attribute__((ext_vector_type(4)));
typedef float f32x16 __attribute__((ext_vector_type(16)));
typedef short bf16x8 __attribute__((ext_vector_type(8)));
typedef short s16x4 __attribute__((ext_vector_type(4)));
typedef GAS unsigned gu32;
typedef GAS unsigned long long gu64;
#define RLX_AGENT __ATOMIC_RELAXED, __HIP_MEMORY_SCOPE_AGENT
#define LDS_WAIT() asm volatile("s_waitcnt lgkmcnt(0)" ::: "memory")
#define VM_WAIT() asm volatile("s_waitcnt vmcnt(0)" ::: "memory")
__device__ __forceinline__ float bf2f(unsigned h) { return __builtin_bit_cast(float, h << 16); }
__device__ __forceinline__ unsigned f2bf(float f) { unsigned u = __builtin_bit_cast(unsigned, f); return (u + 0x7fffu + ((u >> 16) & 1u)) >> 16; }
__device__ __forceinline__ unsigned pk2(float lo, float hi) { return f2bf(lo) | (f2bf(hi) << 16); }

#define XB_TMO      128
#define XB_XCNT(j)  (256  + 64 * (j))
#define XB_XSUB(j)  (1280 + 64 * (j))
#define XB_XGEN(j)  (2304 + 64 * (j))
#define XB_TOP      3328
#define XB_TOPGEN   3392
#define XCD_BAR_WORDS 3456
#define XB_SPIN_CAP (1u << 18)

__device__ __forceinline__ unsigned xb_ld(unsigned* p)              { return __hip_atomic_load(p, __ATOMIC_RELAXED, __HIP_MEMORY_SCOPE_AGENT); }
__device__ __forceinline__ unsigned xb_add(unsigned* p, unsigned v) { return __hip_atomic_fetch_add(p, v, __ATOMIC_RELAXED, __HIP_MEMORY_SCOPE_AGENT); }
__device__ __forceinline__ unsigned xb_xcc_id() { return (unsigned)__builtin_amdgcn_s_getreg((3 << 11) | 20) & 0xFu; }
#define XB_SPIN(cond, bar) do { unsigned _sp = 0; while (cond) { __builtin_amdgcn_s_sleep(1); \
    if ((++_sp & 255u) == 0u) { if (xb_ld(&(bar)[XB_TMO])) break; if (_sp > XB_SPIN_CAP) { atomicAdd(&(bar)[XB_TMO], 1u); break; } } } } while (0)

struct XcdBarrier {
    unsigned* bar; unsigned x;
    volatile LAS unsigned* st;
};

__device__ __forceinline__ XcdBarrier xcd_barrier_post(unsigned* bar, volatile LAS unsigned* st) {
    XcdBarrier b; b.bar = bar; b.x = xb_xcc_id(); b.st = st;
    if (threadIdx.x == 0) (void)xb_add(&bar[XB_XCNT(b.x)], 1u);
    return b;
}
__device__ __forceinline__ void xcd_barrier_complete(unsigned* bar, unsigned x, unsigned& nloc, unsigned& nx) {
    const unsigned G = gridDim.x * gridDim.y * gridDim.z;
    unsigned sum, cnt, mine, sp = 0u;
    for (;;) {
        sum = 0u; cnt = 0u; mine = 0u;
#pragma unroll
        for (unsigned j = 0; j < 16; ++j) { const unsigned c = xb_ld(&bar[XB_XCNT(j)]); sum += c; cnt += (c > 0u) ? 1u : 0u; mine = (j == x) ? c : mine; }
        if (sum == G) break;
        __builtin_amdgcn_s_sleep(1);
        if ((++sp & 255u) == 0u) { if (xb_ld(&bar[XB_TMO])) break; if (sp > XB_SPIN_CAP) { atomicAdd(&bar[XB_TMO], 1u); break; } }
    }
    nloc = mine > 0u ? mine : 1u; nx = cnt > 0u ? cnt : 1u;
}

__device__ __forceinline__ void xcd_barrier(const XcdBarrier& b) {
    asm volatile("s_waitcnt vmcnt(0)" ::: "memory");
    __syncthreads();
    if (threadIdx.x == 0) {
        unsigned* bar = b.bar;
        __builtin_amdgcn_s_waitcnt(0);
        unsigned nloc = b.st[0], nx = b.st[1];
        if (nloc == 0u) { xcd_barrier_complete(bar, b.x, nloc, nx); b.st[0] = nloc; b.st[1] = nx; }
        const unsigned old = xb_add(&bar[XB_XSUB(b.x)], 1u);
        const unsigned gen = old / nloc;
        if (old + 1u == (gen + 1u) * nloc) {
            __builtin_amdgcn_fence(__ATOMIC_RELEASE, "agent");
            asm volatile("s_waitcnt vmcnt(0)" ::: "memory");
            const unsigned og = xb_add(&bar[XB_TOP], 1u);
            const unsigned tg = og / nx;
            if (og + 1u == (tg + 1u) * nx) xb_add(&bar[XB_TOPGEN], 1u);
            else XB_SPIN(xb_ld(&bar[XB_TOPGEN]) == tg, bar);
            __builtin_amdgcn_fence(__ATOMIC_ACQUIRE, "agent");
            xb_add(&bar[XB_XGEN(b.x)], 1u);
            asm volatile("s_waitcnt vmcnt(0)" ::: "memory");
        } else {
            XB_SPIN(xb_ld(&bar[XB_XGEN(b.x)]) == gen, bar);
            __builtin_amdgcn_fence(__ATOMIC_ACQUIRE, "agent");
            asm volatile("s_waitcnt vmcnt(0)" ::: "memory");
        }
    }
    __syncthreads();
}

struct Frame {
    LAS unsigned char* lds;
    volatile LAS unsigned* MISC;
    gu32* ctl;
    unsigned char* ws;
    int tid, lane, wave;
    int G, c;
};
__device__ __forceinline__ float wave_sum(float v) {
#pragma unroll
    for (int o = 1; o < 64; o <<= 1) v += __shfl_xor(v, o);
    return v;
}
__device__ __forceinline__ unsigned pk2h(float lo, float hi) { return pg8::cvt_pk_bf16(lo, hi); }

template <int MAP> __device__ __forceinline__ int rowmap(int n) {
    if (MAP == 1) { if (n < 768) return n; if (n < 832) { const int j = n - 768; return 768 + ((j & 31) << 1) + (j >> 5); } if (n < 1856) return n; if (n < 1872) return H_GLR + (n - 1856); return n - 16; }
    if (MAP == 2) { const int hd = n / 192; int j = n - hd * 192; if (j >= 128) { const int jj = j - 128; j = 128 + ((jj & 31) << 1) + (jj >> 5); } return hd * 192 + j; }
    if (MAP == 3) return ((n >> 7) << 8) + (n & 127);
    if (MAP == 4) return ((n >> 7) << 8) + 128 + (n & 127);
    return n;
}
constexpr int P0_PD = 33;
template <int MAP> __device__ __forceinline__ void p0_item(const float* W, int K, int N, bf16* WT, const float* gain, float sc, LAS unsigned* scr, int item, int lane) {
    const int nblk = (N + 127) >> 7, kb = item / nblk, nb = item - kb * nblk, k0 = 64 * kb, n0 = 128 * nb;
    const int g = lane >> 4, n4 = lane & 15;
    f32x4 v[2][16];
#pragma unroll
    for (int hf = 0; hf < 2; ++hf) { const bool nok = (n0 + 64 * hf + 4 * n4) < N;
#pragma unroll
        for (int i = 0; i < 16; ++i) { const int k = 8 * (i >> 1) + 2 * g + (i & 1); v[hf][i] = nok ? __builtin_nontemporal_load((const GAS f32x4*)(W + (size_t)(k0 + k) * N + n0 + 64 * hf + 4 * n4)) : (f32x4){0.f, 0.f, 0.f, 0.f}; } }
    const int c = lane & 7;
#pragma unroll
    for (int hf = 0; hf < 2; ++hf) {
#pragma unroll
        for (int j = 0; j < 8; ++j) { const int k = 8 * j + 2 * g; float s0 = sc, s1 = sc; if (gain) { s0 *= gain[k0 + k]; s1 *= gain[k0 + k + 1]; }
#pragma unroll
            for (int e = 0; e < 4; ++e) scr[(4 * n4 + e) * P0_PD + 4 * j + g] = pk2h(v[hf][2 * j][e] * s0, v[hf][2 * j + 1][e] * s1); }
        LDS_WAIT(); asm volatile("" ::: "memory");
#pragma unroll
        for (int s = 0; s < 8; ++s) { const int nl = 8 * s + (lane >> 3); const LAS unsigned* p = scr + nl * P0_PD + 4 * c;
            v4u o; o.x = p[0]; o.y = p[1]; o.z = p[2]; o.w = p[3];
            if (n0 + 64 * hf + nl < N) *(GAS v4u*)(WT + (size_t)rowmap<MAP>(n0 + 64 * hf + nl) * K + k0 + 8 * c) = o; }
        LDS_WAIT(); asm volatile("" ::: "memory"); }
}
struct In {
    const float *x, *p; const int* pos; const float *w_in, *q_gain, *w_qb, *kv_gain, *w_kvb, *gla_wg, *gla_bg, *gla_ng, *sinks, *relb, *w_out, *ln1g, *ln1b,
        *f_wg, *f_wu, *f_wd, *router, *m_wg, *m_wu, *m_wd, *p_wu, *p_wg, *p_bg, *ln2g, *ln2b;
};
constexpr int I_IN = (DM / 64) * ((IN_COLS + 127) / 128), I_QB = (512 / 64) * (QW / 128), I_KVB = (256 / 64) * (KVW / 128), I_OUT = (DM / 64) * (DM / 128), I_PU = (PLE / 64) * (DM / 128), I_PG = I_OUT;
constexpr int I_GU = (DM / 64) * (DFF / 128), I_D = (DFF / 64) * (DM / 128);
constexpr int I_LAYER = I_IN + I_QB + I_KVB + I_OUT + I_PU + I_PG;
constexpr int NITEMS = DEPTH * I_LAYER + 3 * I_GU + 24 * I_GU;
static_assert(I_D == I_GU, "item counts");
#ifndef BGQ1
#define BGQ1 5
#endif
#ifndef BGQ2
#define BGQ2 5
#endif
#ifndef BGQ3
#define BGQ3 5
#endif
constexpr int HOLE1_WG = 96, HOLE2_WG = 128, HOLE3_WG = 96;
constexpr int HOLE1_N = HOLE1_WG * BGQ1 * 8, HOLE2_N = HOLE2_WG * BGQ2 * 8, HOLE3_N = HOLE3_WG * BGQ3 * 8;
constexpr int N_PRO256 = NITEMS - HOLE1_N - HOLE2_N - HOLE3_N;
static_assert(N_PRO256 >= DEPTH * I_LAYER + 3 * I_GU, "only MoE items may be deferred");
__device__ __forceinline__ void p0_dispatch(const In& I, unsigned char* ws, LAS unsigned* scr, int it, int lane) {
        int r = it;
        if (r < DEPTH * I_LAYER) {
            const int l = r / I_LAYER; r -= l * I_LAYER;
            if (r < I_IN) { p0_item<1>(I.w_in + (size_t)l * DM * IN_COLS, DM, IN_COLS, (bf16*)(ws + WS_WIN) + (size_t)l * LDH * DM, nullptr, 1.f, scr, r, lane); return; } r -= I_IN;
            if (r < I_QB) { p0_item<2>(I.w_qb + (size_t)l * 512 * QW, 512, QW, (bf16*)(ws + WS_WQB) + (size_t)l * QW * 512, I.q_gain + l * 512, QSCALE, scr, r, lane); return; } r -= I_QB;
            if (r < I_KVB) { p0_item<0>(I.w_kvb + (size_t)l * 256 * KVW, 256, KVW, (bf16*)(ws + WS_WKVB) + (size_t)l * KVW * 256, I.kv_gain + l * 256, 1.f, scr, r, lane); return; } r -= I_KVB;
            if (r < I_OUT) { p0_item<0>(I.w_out + (size_t)l * DM * DM, DM, DM, (bf16*)(ws + WS_WOUT) + (size_t)l * DM * DM, nullptr, 1.f, scr, r, lane); return; } r -= I_OUT;
            if (r < I_PU) { p0_item<0>(I.p_wu + (size_t)l * PLE * DM, PLE, DM, (bf16*)(ws + WS_WPU) + (size_t)l * DM * PLE, nullptr, 1.f, scr, r, lane); return; } r -= I_PU;
            p0_item<0>(I.p_wg + (size_t)l * DM * DM, DM, DM, (bf16*)(ws + WS_WPG) + (size_t)l * DM * DM, nullptr, 1.f, scr, r, lane); return;
        }
        r -= DEPTH * I_LAYER;
        if (r < I_GU) { p0_item<3>(I.f_wg, DM, DFF, (bf16*)(ws + WS_FGU), nullptr, 1.f, scr, r, lane); return; } r -= I_GU;
        if (r < I_GU) { p0_item<4>(I.f_wu, DM, DFF, (bf16*)(ws + WS_FGU), nullptr, 1.f, scr, r, lane); return; } r -= I_GU;
        if (r < I_D) { p0_item<0>(I.f_wd, DFF, DM, (bf16*)(ws + WS_FD), nullptr, 1.f, scr, r, lane); return; } r -= I_D;
        { const int e = r / (3 * I_GU); r -= e * 3 * I_GU;
          if (r < I_GU) { p0_item<3>(I.m_wg + (size_t)e * DM * DFF, DM, DFF, (bf16*)(ws + WS_MGU) + (size_t)e * NGU * DM, nullptr, 1.f, scr, r, lane); return; } r -= I_GU;
          if (r < I_GU) { p0_item<4>(I.m_wu + (size_t)e * DM * DFF, DM, DFF, (bf16*)(ws + WS_MGU) + (size_t)e * NGU * DM, nullptr, 1.f, scr, r, lane); return; } r -= I_GU;
          p0_item<0>(I.m_wd + (size_t)e * DFF * DM, DFF, DM, (bf16*)(ws + WS_MD) + (size_t)e * DM * DFF, nullptr, 1.f, scr, r, lane); }
}
__device__ __forceinline__ void bg_convert(Frame& F, const In& I, int first, int rank, int nw, int q) {
    LAS unsigned* scr = (LAS unsigned*)(F.lds + RING_OFF + F.wave * 16384);
    for (int b = 0; b < q; ++b) { const int it = first + (b * nw + rank) * 8 + F.wave; if (it < NITEMS) p0_dispatch(I, F.ws, scr, it, F.lane); }
    __syncthreads();
}
__device__ __forceinline__ void p0_prologue(Frame& F, const In& I) {
    LAS unsigned* scr = (LAS unsigned*)(F.lds + RING_OFF + F.wave * 16384);
    const int gw = F.c * NWAVES + F.wave, NGW = F.G * NWAVES;
    unsigned char* ws = F.ws;
    const int npro = (F.G == 256) ? N_PRO256 : NITEMS;
    for (int it = gw; it < npro; it += NGW) p0_dispatch(I, ws, scr, it, F.lane);
    const int gt = F.c * (NWAVES * 64) + F.tid, NGT = F.G * NWAVES * 64;
    { const GAS f32x4* xs = (const GAS f32x4*)I.x; GAS v4u* xd = (GAS v4u*)(ws + WS_XB);
      for (int i = gt; i < S * DM / 8; i += NGT) { const f32x4 a = __builtin_nontemporal_load(xs + 2 * i), b = __builtin_nontemporal_load(xs + 2 * i + 1); v4u o; o.x = pk2h(a[0], a[1]); o.y = pk2h(a[2], a[3]); o.z = pk2h(b[0], b[1]); o.w = pk2h(b[2], b[3]); xd[i] = o; }
      const GAS f32x4* ps = (const GAS f32x4*)I.p; GAS v4u* pd = (GAS v4u*)(ws + WS_PB);
      for (int i = gt; i < DEPTH * S * PLE / 8; i += NGT) { const f32x4 a = __builtin_nontemporal_load(ps + 2 * i), b = __builtin_nontemporal_load(ps + 2 * i + 1); v4u o; o.x = pk2h(a[0], a[1]); o.y = pk2h(a[2], a[3]); o.z = pk2h(b[0], b[1]); o.w = pk2h(b[2], b[3]); pd[i] = o; } }
    { float* cs = (float*)(ws + WS_CS);
      for (int i = gt; i < S * 32; i += NGT) { const int t = i >> 5, j = i & 31;
          const float inv = (float)exp2(-(double)j * (13.287712379549449 / 32.0));
          const float ang = (float)I.pos[t] * inv;
          double sn, cn; sincos((double)ang, &sn, &cn);
          cs[(size_t)t * 64 + j] = (float)cn; cs[(size_t)t * 64 + 32 + j] = (float)sn; } }
}

__device__ __forceinline__ f32x4 mfma16(bf16x8 a, bf16x8 b, f32x4 c) { return __builtin_amdgcn_mfma_f32_16x16x32_bf16(a, b, c, 0, 0, 0); }
__device__ __forceinline__ f32x16 mfma32(bf16x8 a, bf16x8 b, f32x16 c) { return __builtin_amdgcn_mfma_f32_32x32x16_bf16(a, b, c, 0, 0, 0); }
__device__ __forceinline__ s16x4 tr_read(const LAS bf16* p) { return __builtin_bit_cast(s16x4, __builtin_amdgcn_ds_read_tr16_b64_v4i16((LAS s16x4*)p)); }
__device__ __forceinline__ int crow(int r, int hi) { return (r & 3) + 8 * (r >> 2) + 4 * hi; }
__device__ __forceinline__ bf16x8 pack8f(float a0, float a1, float a2, float a3, float a4, float a5, float a6, float a7) {
    v4u w; w.x = pk2h(a0, a1); w.y = pk2h(a2, a3); w.z = pk2h(a4, a5); w.w = pk2h(a6, a7); return __builtin_bit_cast(bf16x8, w); }

constexpr int SW_KP = 72, SW_VP = 80;
__device__ __forceinline__ void swa_unit(Frame& F, int n, int hq, const bf16* HB, bf16* MIX, const float* sinks, const float* relb) {
    LAS bf16* Ks = (LAS bf16*)(F.lds + RING_OFF); LAS bf16* Vs = Ks + 256 * SW_KP; LAS float* bias = (LAS float*)(Vs + 256 * SW_VP);
    const int tid = F.tid, lane = F.lane, w = F.wave, hk = hq >> 2;
    const int q = lane & 15, kq = lane >> 4, qi = 16 * w + q; const size_t tq = (size_t)n * 128 + qi;
    bf16x8 qf[2];
#pragma unroll
    for (int ks = 0; ks < 2; ++ks) qf[ks] = *(const GAS bf16x8*)(HB + tq * LDH + H_SQ + hq * 64 + 32 * ks + 8 * kq);
#pragma unroll
    for (int i = 0; i < 4; ++i) { const int c = tid + 512 * i, row = c >> 3, ch = c & 7, tk = (n - 1) * 128 + row;
        v4u kv = (v4u){0u, 0u, 0u, 0u}, vv = (v4u){0u, 0u, 0u, 0u};
        if (tk >= 0) { kv = *(const GAS v4u*)(HB + (size_t)tk * LDH + H_SK + hk * 64 + ch * 8); vv = *(const GAS v4u*)(HB + (size_t)tk * LDH + H_SV + hk * 64 + ch * 8); }
        *(LAS v4u*)(Ks + row * SW_KP + ch * 8) = kv; *(LAS v4u*)(Vs + row * SW_VP + ch * 8) = vv; }
    if (tid < 128) { const int d = tid; int b;
        if (d < 16) b = d; else { const float lg = logf((float)d / 16.0f) / 2.0794415416798357f * 16.0f; b = 16 + (int)lg; if (b > 31) b = 31; }
        bias[d] = relb[b * 8 + hq]; }
    __syncthreads();
    f32x4 s[16];
#pragma unroll
    for (int blk = 0; blk < 16; ++blk) { f32x4 a = (f32x4){0.f, 0.f, 0.f, 0.f};
#pragma unroll
        for (int ks = 0; ks < 2; ++ks) { const bf16x8 kf = *(const LAS bf16x8*)(Ks + (16 * blk + q) * SW_KP + 32 * ks + 8 * kq); a = mfma16(kf, qf[ks], a); }
        s[blk] = a; }
    const float sink = sinks[hq]; float mx = sink;
#pragma unroll
    for (int blk = 0; blk < 16; ++blk)
#pragma unroll
        for (int i = 0; i < 4; ++i) { const int kj = 16 * blk + 4 * kq + i, dist = qi + 128 - kj; const bool valid = (dist >= 0) && (dist < 128) && (n > 0 || kj >= 128);
            const float v = valid ? s[blk][i] * 0.125f + bias[dist & 127] : -1e30f; s[blk][i] = v; mx = fmaxf(mx, v); }
    mx = fmaxf(mx, __shfl_xor(mx, 16)); mx = fmaxf(mx, __shfl_xor(mx, 32));
    float sum = 0.f;
#pragma unroll
    for (int blk = 0; blk < 16; ++blk)
#pragma unroll
        for (int i = 0; i < 4; ++i) { const float p = (s[blk][i] > -1e29f) ? __expf(s[blk][i] - mx) : 0.f; s[blk][i] = p; sum += p; }
    sum += __shfl_xor(sum, 16); sum += __shfl_xor(sum, 32);
    const float inv = 1.0f / (sum + __expf(sink - mx));
    f32x4 o[4];
#pragma unroll
    for (int db = 0; db < 4; ++db) o[db] = (f32x4){0.f, 0.f, 0.f, 0.f};
#pragma unroll
    for (int kk = 0; kk < 8; ++kk) {
        const bf16x8 pf = pack8f(s[2 * kk][0] * inv, s[2 * kk][1] * inv, s[2 * kk][2] * inv, s[2 * kk][3] * inv, s[2 * kk + 1][0] * inv, s[2 * kk + 1][1] * inv, s[2 * kk + 1][2] * inv, s[2 * kk + 1][3] * inv);
#pragma unroll
        for (int db = 0; db < 4; ++db) { const LAS bf16* vp = Vs + (32 * kk + 4 * kq + (q >> 2)) * SW_VP + 16 * db + 4 * (q & 3);
            const s16x4 lo = tr_read(vp), hh = tr_read(vp + 16 * SW_VP);
            o[db] = mfma16((bf16x8){lo[0], lo[1], lo[2], lo[3], hh[0], hh[1], hh[2], hh[3]}, pf, o[db]); } }
#pragma unroll
    for (int db = 0; db < 4; ++db) { v2u ov; ov.x = pk2h(o[db][0], o[db][1]); ov.y = pk2h(o[db][2], o[db][3]);
        *(GAS v2u*)(MIX + tq * DM + 1536 + hq * 64 + 16 * db + 4 * kq) = ov; }
    __syncthreads();
}

constexpr int GP = 72;
constexpr int GVP = 144, GKP = 80;
__device__ __forceinline__ bf16x8 gla_trfrag(const LAS bf16* base, int pitch, int j0, int c0, int fr) {
    const LAS bf16* p = base + (j0 + (fr >> 2)) * pitch + c0 + 4 * (fr & 3); const s16x4 lo = tr_read(p), hh = tr_read(p + 4 * pitch);
    return (bf16x8){lo[0], lo[1], lo[2], lo[3], hh[0], hh[1], hh[2], hh[3]}; }
constexpr int GL_GLR = 0, GL_WG = 4096, GL_BG = 8192, GL_B = 8704, GL_QT = 25344, GL_KT = 34560, GL_KDT = 43776, GL_VT = 52992, GL_SPT = 71424, GL_PP = 89856, GL_END = 99072, GL_OO = 0;
template <int STAGE> __device__ __forceinline__ void gla_unit(Frame& F, int c, int h, const bf16* HB, const float* wg, const float* bg, float* UT, float* DEC, const bf16* SPT, const float* ng, bf16* MIX) {
    LAS unsigned char* L = F.lds + RING_OFF;
    LAS float* glr = (LAS float*)(L + GL_GLR); LAS float* Wg = (LAS float*)(L + GL_WG); LAS float* Bg = (LAS float*)(L + GL_BG); LAS float* B = (LAS float*)(L + GL_B);
    LAS bf16* QT = (LAS bf16*)(L + GL_QT); LAS bf16* KT = (LAS bf16*)(L + GL_KT); LAS bf16* KD = (LAS bf16*)(L + GL_QT)  ; LAS bf16* VR = (LAS bf16*)(L + GL_VT);
    LAS bf16* SP = (LAS bf16*)(L + GL_SPT); LAS bf16* PP = (LAS bf16*)(L + GL_PP); LAS float* OO = (LAS float*)(L + GL_OO);
    const int tid = F.tid, lane = F.lane, w = F.wave; const size_t t0 = (size_t)c * 64;
    const v4u kraw = *(const GAS v4u*)(HB + (t0 + (tid >> 3)) * LDH + H_GK + h * 64 + (tid & 7) * 8);
    v4u qraw = (v4u){0u, 0u, 0u, 0u}; if (STAGE == 3) qraw = *(const GAS v4u*)(HB + (t0 + (tid >> 3)) * LDH + H_GQ + h * 64 + (tid & 7) * 8);
    for (int i = tid; i < 1024; i += 512) { const int r = i >> 4, k = i & 15; glr[i] = bf2f(HB[(t0 + r) * LDH + H_GLR + k]); }
    for (int i = tid; i < 1024; i += 512) { const int r = i >> 6, d = i & 63; Wg[i] = wg[r * 256 + h * 64 + d]; }
    if (tid < 64) Bg[tid] = bg[h * 64 + tid];
#pragma unroll
    for (int i = 0; i < 2; ++i) { const int cc = tid + 512 * i, row = cc >> 4, ch = cc & 15; const v4u vv = *(const GAS v4u*)(HB + (t0 + row) * LDH + H_GV + h * 128 + ch * 8);
        *(LAS v4u*)(VR + row * GVP + ch * 8) = vv; }
    if (STAGE == 3) {
#pragma unroll
        for (int i = 0; i < 2; ++i) { const int cc = tid + 512 * i, row = cc >> 3, ch = cc & 7; *(LAS v4u*)(SP + row * GP + ch * 8) = *(const GAS v4u*)(SPT + ((size_t)(c * 4 + h) * 128 + row) * 64 + ch * 8); } }
    __syncthreads();
#pragma unroll
    for (int i = 0; i < 8; ++i) { const int idx = tid + 512 * i, r = idx >> 6, d = idx & 63; float z = Bg[d];
#pragma unroll
        for (int k = 0; k < 16; ++k) z += glr[r * 16 + k] * Wg[k * 64 + d];
        const float ls = fminf(z, 0.f) - 0.6931471805599453f * __builtin_amdgcn_logf(1.0f + __builtin_amdgcn_exp2f(-1.4426950408889634f * fabsf(z))); B[r * 65 + d] = ls * (1.0f / 16.0f); }
    __syncthreads();
    { const int col = tid & 63, seg = tid >> 6; LAS float* SEG = glr;
      float v[8]; float a = 0.f;
#pragma unroll
      for (int k = 0; k < 8; ++k) { a += B[(8 * seg + k) * 65 + col]; v[k] = a; }
      SEG[seg * 64 + col] = a;
      __syncthreads();
      float off = 0.f;
#pragma unroll
      for (int q = 0; q < 7; ++q) off += (q < seg) ? SEG[q * 64 + col] : 0.f;
#pragma unroll
      for (int k = 0; k < 8; ++k) B[(8 * seg + k) * 65 + col] = v[k] + off; }
    __syncthreads();
    { const int i = tid >> 3, d0 = (tid & 7) * 8;
      if (STAGE == 1) {
          float kd[8];
#pragma unroll
          for (int e = 0; e < 8; ++e) { const float kv = bf2f((kraw[e >> 1] >> (16 * (e & 1))) & 0xffffu); kd[e] = kv * __expf(B[63 * 65 + d0 + e] - B[i * 65 + d0 + e]); }
          *(LAS bf16x8*)(KD + i * GKP + d0) = pack8f(kd[0], kd[1], kd[2], kd[3], kd[4], kd[5], kd[6], kd[7]);
          if (i == 63) {
#pragma unroll
              for (int e = 0; e < 8; ++e) DEC[(size_t)(c * 4 + h) * 64 + d0 + e] = __expf(B[63 * 65 + d0 + e]); }
      } else {
          float qv[8], kv[8];
#pragma unroll
          for (int e = 0; e < 8; ++e) { const float b = B[i * 65 + d0 + e]; qv[e] = bf2f((qraw[e >> 1] >> (16 * (e & 1))) & 0xffffu) * 0.125f * __expf(b); kv[e] = bf2f((kraw[e >> 1] >> (16 * (e & 1))) & 0xffffu) * __expf(-b); }
          *(LAS bf16x8*)(QT + i * GP + d0) = pack8f(qv[0], qv[1], qv[2], qv[3], qv[4], qv[5], qv[6], qv[7]);
          *(LAS bf16x8*)(KT + i * GP + d0) = pack8f(kv[0], kv[1], kv[2], kv[3], kv[4], kv[5], kv[6], kv[7]); } }
    __syncthreads();
    const int fr = lane & 15, fq = lane >> 4, rb = w & 3, cb = w >> 2;
    if (STAGE == 1) {
        bf16x8 af[2];
#pragma unroll
        for (int ks = 0; ks < 2; ++ks) af[ks] = gla_trfrag(KD, GKP, 32 * ks + 8 * fq, 16 * rb, fr);
#pragma unroll
        for (int eb = 0; eb < 4; ++eb) { f32x4 a = (f32x4){0.f, 0.f, 0.f, 0.f}; const int e0 = 16 * (4 * cb + eb);
#pragma unroll
            for (int ks = 0; ks < 2; ++ks) { const bf16x8 bfr = gla_trfrag(VR, GVP, 32 * ks + 8 * fq, e0, fr); a = mfma16(af[ks], bfr, a); }
            *(GAS f32x4*)(UT + ((size_t)(c * 4 + h) * 128 + e0 + fr) * 64 + 16 * rb + 4 * fq) = a; }
        __syncthreads();
    } else {
        { bf16x8 af[2];
#pragma unroll
          for (int ks = 0; ks < 2; ++ks) af[ks] = *(const LAS bf16x8*)(QT + (16 * rb + fr) * GP + 32 * ks + 8 * fq);
#pragma unroll
          for (int jb = 0; jb < 2; ++jb) { f32x4 a = (f32x4){0.f, 0.f, 0.f, 0.f}; const int j0 = 16 * (2 * cb + jb);
#pragma unroll
              for (int ks = 0; ks < 2; ++ks) { const bf16x8 bfr = *(const LAS bf16x8*)(KT + (j0 + fr) * GP + 32 * ks + 8 * fq); a = mfma16(af[ks], bfr, a); }
#pragma unroll
              for (int i = 0; i < 4; ++i) { const int ii = 16 * rb + 4 * fq + i, jj = j0 + fr; PP[ii * GP + jj] = (bf16)(pk2h(jj <= ii ? a[i] : 0.f, 0.f) & 0xffffu); } } }
        __syncthreads();
        f32x4 o[4];
        { bf16x8 pf[2], qf[2];
#pragma unroll
          for (int ks = 0; ks < 2; ++ks) { pf[ks] = *(const LAS bf16x8*)(PP + (16 * rb + fr) * GP + 32 * ks + 8 * fq); qf[ks] = *(const LAS bf16x8*)(QT + (16 * rb + fr) * GP + 32 * ks + 8 * fq); }
#pragma unroll
          for (int eb = 0; eb < 4; ++eb) { f32x4 a = (f32x4){0.f, 0.f, 0.f, 0.f}; const int e0 = 16 * (4 * cb + eb);
#pragma unroll
              for (int ks = 0; ks < 2; ++ks) { const bf16x8 vb = gla_trfrag(VR, GVP, 32 * ks + 8 * fq, e0, fr); a = mfma16(pf[ks], vb, a);
                  const bf16x8 sb = *(const LAS bf16x8*)(SP + (e0 + fr) * GP + 32 * ks + 8 * fq); a = mfma16(qf[ks], sb, a); }
              o[eb] = a; } }
        __syncthreads();
#pragma unroll
        for (int eb = 0; eb < 4; ++eb)
#pragma unroll
            for (int i = 0; i < 4; ++i) OO[(16 * rb + 4 * fq + i) * 132 + 16 * (4 * cb + eb) + fr] = o[eb][i];
        __syncthreads();
        { const int i = tid >> 3, e0 = (tid & 7) * 16; float v[16]; float ss = 0.f;
#pragma unroll
          for (int e = 0; e < 16; ++e) { v[e] = OO[i * 132 + e0 + e]; ss += v[e] * v[e]; }
          ss += __shfl_xor(ss, 1); ss += __shfl_xor(ss, 2); ss += __shfl_xor(ss, 4);
          const float rinv = 1.0f / sqrtf(ss * (1.0f / 128.0f) + RMS_EPS);
          const bf16* rp = HB + (t0 + i) * LDH + H_GR + h * 128 + e0; const float* gp = ng + h * 128 + e0;
          const v4u r0 = *(const GAS v4u*)rp, r1 = *(const GAS v4u*)(rp + 8);
          float ov[16];
#pragma unroll
          for (int e = 0; e < 16; ++e) { const unsigned rw = (e < 8 ? r0[e >> 1] : r1[(e - 8) >> 1]); const float rv = bf2f((rw >> (16 * (e & 1))) & 0xffffu);
              ov[e] = v[e] * rinv * gp[e] * (rv * pg8::fast_sigmoid(rv)); }
          bf16* op = MIX + (t0 + i) * DM + 1024 + h * 128 + e0;
          *(GAS bf16x8*)op = pack8f(ov[0], ov[1], ov[2], ov[3], ov[4], ov[5], ov[6], ov[7]);
          *(GAS bf16x8*)(op + 8) = pack8f(ov[8], ov[9], ov[10], ov[11], ov[12], ov[13], ov[14], ov[15]); }
        __syncthreads();
    }
}
__device__ __forceinline__ void gla_scan(Frame& F, const float* UT, const float* DEC, bf16* SPT) {
    const int gt = F.c * (NWAVES * 64) + F.tid; if (gt >= 4 * 128 * 64) return;
    const int d = gt & 63, he = gt >> 6, h = he >> 7;
    float s = 0.f;
#pragma unroll 8
    for (int c = 0; c < 128; ++c) { const size_t o = ((size_t)c * 512 + he) * 64 + d; SPT[o] = (bf16)(pk2h(s, 0.f) & 0xffffu); s = DEC[(size_t)(c * 4 + h) * 64 + d] * s + UT[o]; }
}

constexpr int ML_KP = 200, ML_VP = 160;
constexpr int ML_KB = 64 * ML_KP * 2, ML_VB = 64 * ML_VP * 2, ML_STAGE = ML_KB + ML_VB;
static_assert(2 * ML_STAGE <= RING_BYTES && 4 * 64 * 64 * 4 + 4 * 2 * 64 * 4 <= 2 * ML_STAGE, "MLA LDS");
__device__ __forceinline__ void mla_unit(Frame& F, int h, int qb, const bf16* QB, const bf16* KVB, const bf16* HB, bf16* MIX) {
    LAS unsigned char* L = F.lds + RING_OFF;
    int tid_ = F.tid; asm volatile("" : "+v"(tid_));
    const int tid = tid_, lane = tid & 63, w = F.wave, rg = w & 3, kh = w >> 2, r32 = lane & 31, hi = lane >> 5;
    const int q0 = 128 * qb, NT = 2 * qb + 2, qabs = q0 + 32 * rg + r32;
    bf16x8 qf[12];
    { const bf16* qp = QB + (size_t)qabs * QW + h * 192 + 8 * hi;
#pragma unroll
      for (int ks = 0; ks < 12; ++ks) qf[ks] = *(const GAS bf16x8*)(qp + 16 * ks); }
    unsigned doff[6]; bool dpe[6];
#pragma unroll
    for (int i = 0; i < 6; ++i) { const int jn = w + 8 * i;
        if (jn < 25) { const int c = 64 * jn + lane, row = c / 25, ch = c - 25 * row;
            dpe[i] = (ch >= 16 && ch < 24);
            doff[i] = dpe[i] ? (unsigned)(row * LDH + H_KPE + (ch - 16) * 8) * 2u : (unsigned)(row * KVW + h * 256 + (ch < 16 ? ch : 0) * 8) * 2u; }
        else { const int c = 64 * (jn - 25) + lane, row = c / 20, ch = c - 20 * row;
            dpe[i] = false; doff[i] = (unsigned)(row * KVW + h * 256 + 128 + (ch < 16 ? ch : 0) * 8) * 2u; } }
#define ML_DMA(t, b) do { const char* kb_ = (const char*)KVB + (size_t)(t) * (64 * KVW * 2); const char* pb_ = (const char*)HB + (size_t)(t) * (64 * LDH * 2); \
        _Pragma("unroll") for (int i_ = 0; i_ < 6; ++i_) { const int jn_ = w + 8 * i_; if (jn_ < 45) { const char* g_ = (dpe[i_] ? pb_ : kb_) + doff[i_]; \
            __builtin_amdgcn_global_load_lds((const unsigned*)g_, (LAS unsigned*)(L + (b) * ML_STAGE + jn_ * 1024), 16, 0, 0); } } } while (0)
    ML_DMA(0, 0);
    asm volatile("s_waitcnt vmcnt(0)" ::: "memory");
    __syncthreads();
    float m = -60000.f, l = 0.f; f32x16 o[4];
#pragma unroll
    for (int db = 0; db < 4; ++db)
#pragma unroll
        for (int r = 0; r < 16; ++r) o[db][r] = 0.f;
    const int li = lane & 15, trow = li >> 2, tcol = 16 * ((lane >> 4) & 1) + 4 * (li & 3);
    for (int t = 0; t < NT; ++t) {
        const bool more = (t + 1 < NT);
        const LAS bf16* Kb = (const LAS bf16*)(L + (t & 1) * ML_STAGE); const LAS bf16* Vb = (const LAS bf16*)(L + (t & 1) * ML_STAGE + ML_KB);
        f32x16 p;
#pragma unroll
        for (int r = 0; r < 16; ++r) p[r] = 0.f;
        s16x4 vlo[2][4], vhh[2][4];
        { const LAS bf16* kp = Kb + (32 * kh + r32) * ML_KP + 8 * hi; bf16x8 kf[12];
          const LAS bf16* vp = Vb + (32 * kh + 4 * hi + trow) * ML_VP + tcol;
#pragma unroll
          for (int ks = 0; ks < 12; ++ks) kf[ks] = *(const LAS bf16x8*)(kp + 16 * ks);
          __builtin_amdgcn_sched_barrier(0);
#pragma unroll
          for (int ks = 0; ks < 12; ++ks) { p = mfma32(kf[ks], qf[ks], p);
              if (ks < 8) { const int s = ks >> 2, db = ks & 3; vlo[s][db] = tr_read(vp + 16 * s * ML_VP + 32 * db); vhh[s][db] = tr_read(vp + (16 * s + 8) * ML_VP + 32 * db); __builtin_amdgcn_sched_barrier(0); } } }
        if (more) ML_DMA(t + 1, (t + 1) & 1);
        if (t >= NT - 2) { const int kb = 64 * t + 32 * kh;
#pragma unroll
            for (int r = 0; r < 16; ++r) if (kb + crow(r, hi) > qabs) p[r] = -1e30f; }
        float tm = p[0];
#pragma unroll
        for (int r = 1; r < 16; ++r) tm = fmaxf(tm, p[r]);
        { float sa = tm, sb = tm;
          asm volatile("s_nop 1\n\tv_permlane32_swap_b32_e32 %0, %1\n\ts_nop 1\n\tv_max_f32_e32 %0, %0, %1\n\ts_nop 0" : "+v"(sa), "+v"(sb));
          tm = sa; }
        const float mn = fmaxf(m, tm), alpha = __builtin_amdgcn_exp2f(m - mn);
        float rs = 0.f;
#pragma unroll
        for (int r = 0; r < 16; ++r) { const float e = __builtin_amdgcn_exp2f(p[r] - mn); p[r] = e; rs += e; }
        { float sa = rs, sb = rs;
          asm volatile("s_nop 1\n\tv_permlane32_swap_b32_e32 %0, %1\n\ts_nop 1\n\tv_add_f32_e32 %0, %0, %1\n\ts_nop 0" : "+v"(sa), "+v"(sb));
          rs = sa; }
        l = l * alpha + rs; m = mn;
        if (__any(alpha != 1.0f)) {
#pragma unroll
            for (int db = 0; db < 4; ++db)
#pragma unroll
                for (int r = 0; r < 16; ++r) o[db][r] *= alpha; }
        bf16x8 pf[2];
        pf[0] = pack8f(p[0], p[1], p[2], p[3], p[4], p[5], p[6], p[7]); pf[1] = pack8f(p[8], p[9], p[10], p[11], p[12], p[13], p[14], p[15]);
        {
#pragma unroll
          for (int s = 0; s < 2; ++s)
#pragma unroll
              for (int db = 0; db < 4; ++db) { const bf16x8 vf = (bf16x8){vlo[s][db][0], vlo[s][db][1], vlo[s][db][2], vlo[s][db][3], vhh[s][db][0], vhh[s][db][1], vhh[s][db][2], vhh[s][db][3]};
                  o[db] = mfma32(vf, pf[s], o[db]); } }
        asm volatile("s_waitcnt vmcnt(0)" ::: "memory");
        __syncthreads();
    }
#undef ML_DMA
    LAS float* MS = (LAS float*)L; LAS float* ML = (LAS float*)(L + 4 * 64 * 64 * 4);
    if (kh == 1) {
#pragma unroll
        for (int db = 0; db < 4; ++db)
#pragma unroll
            for (int r = 0; r < 16; ++r) MS[(rg * 64 + db * 16 + r) * 64 + lane] = o[db][r];
        ML[(rg * 2 + 0) * 64 + lane] = m; ML[(rg * 2 + 1) * 64 + lane] = l; }
    __syncthreads();
    if (kh == 0) {
        const float m1 = ML[(rg * 2 + 0) * 64 + lane], l1 = ML[(rg * 2 + 1) * 64 + lane];
        const float mt = fmaxf(m, m1), a0 = __builtin_amdgcn_exp2f(m - mt), a1 = __builtin_amdgcn_exp2f(m1 - mt);
        const float inv = 1.0f / (l * a0 + l1 * a1), w0 = a0 * inv, w1 = a1 * inv;
        bf16* op = MIX + (size_t)qabs * DM + h * 128 + 4 * hi;
#pragma unroll
        for (int db = 0; db < 4; ++db)
#pragma unroll
            for (int g = 0; g < 4; ++g) { float v[4];
#pragma unroll
                for (int e = 0; e < 4; ++e) { const int r = 4 * g + e; v[e] = o[db][r] * w0 + MS[(rg * 64 + db * 16 + r) * 64 + lane] * w1; }
                v2u ov; ov.x = pk2h(v[0], v[1]); ov.y = pk2h(v[2], v[3]); *(GAS v2u*)(op + 32 * db + 8 * g) = ov; } }
    __syncthreads();
}

__device__ __forceinline__ f32x4 ld4bf(const bf16* p) { const v2u r = __builtin_nontemporal_load((const GAS v2u*)p);     return (f32x4){__builtin_bit_cast(float, r.x << 16), __builtin_bit_cast(float, r.x & 0xffff0000u), __builtin_bit_cast(float, r.y << 16), __builtin_bit_cast(float, r.y & 0xffff0000u)}; }
template <int MODE, bool ROUTE> __device__ __forceinline__ void ln_phase(Frame& F, const void* Yv, const bf16* X1, const bf16* PLEB, const float* gam, const float* bet, float* OF, bf16* OB, const float* router) {
    unsigned char* ws = F.ws;
    LAS float* Wr = (LAS float*)(F.lds + RING_OFF);
    if (ROUTE) { for (int i = F.tid; i < DM * 8 / 4; i += NWAVES * 64) ((LAS f32x4*)Wr)[i] = ((const GAS f32x4*)router)[i]; __syncthreads(); }
    const int gw = F.c * NWAVES + F.wave, NGW = F.G * NWAVES, lane = F.lane;
    for (int row = gw; row < S; row += NGW) {
        f32x4 v[8]; float s = 0.f;
        if (MODE == 0) { const GAS f32x4* yp = (const GAS f32x4*)((const float*)Yv + (size_t)row * DM) + lane;
#pragma unroll
            for (int j = 0; j < 8; ++j) v[j] = __builtin_nontemporal_load(yp + 64 * j);
        } else {
            const bf16* xp = X1 + (size_t)row * DM + 4 * lane; const bf16* pp = PLEB + (size_t)row * DM + 4 * lane; const bf16* Y = (const bf16*)Yv;
            if (MODE == 1) { const bf16* yp = Y + (size_t)row * DM + 4 * lane;
#pragma unroll
                for (int j = 0; j < 8; ++j) v[j] = ALPHA * ld4bf(xp + 256 * j) + ld4bf(yp + 256 * j) + ld4bf(pp + 256 * j);
            } else {
                const int* slot = (const int*)(ws + WS_ROUTE + RT_SLOT) + 2 * row; const float* tw = (const float*)(ws + WS_ROUTE + RT_W) + 2 * row;
                const int s0 = slot[0], s1 = slot[1]; const float w0 = tw[0], w1 = tw[1];
                const bf16* y0 = Y + (size_t)s0 * DM + 4 * lane; const bf16* y1 = Y + (size_t)s1 * DM + 4 * lane;
#pragma unroll
                for (int j = 0; j < 8; ++j) v[j] = ALPHA * ld4bf(xp + 256 * j) + (w0 * ld4bf(y0 + 256 * j) + w1 * ld4bf(y1 + 256 * j)) + ld4bf(pp + 256 * j);
            }
        }
#pragma unroll
        for (int j = 0; j < 8; ++j) s += (v[j][0] + v[j][1]) + (v[j][2] + v[j][3]);
        const float mean = wave_sum(s) * (1.0f / DM); float s2 = 0.f;
#pragma unroll
        for (int j = 0; j < 8; ++j) { v[j] = v[j] - mean; s2 += (v[j][0] * v[j][0] + v[j][1] * v[j][1]) + (v[j][2] * v[j][2] + v[j][3] * v[j][3]); }
        const float rstd = 1.0f / sqrtf(wave_sum(s2) * (1.0f / DM) + LN_EPS);
#pragma unroll
        for (int j = 0; j < 8; ++j) { const f32x4 g = ((const GAS f32x4*)gam)[lane + 64 * j], b = ((const GAS f32x4*)bet)[lane + 64 * j]; v[j] = v[j] * rstd * g + b; }
        if (OF) { GAS f32x4* of = (GAS f32x4*)(OF + (size_t)row * DM) + lane;
#pragma unroll
            for (int j = 0; j < 8; ++j) of[64 * j] = v[j]; }
        if (OB) { GAS v2u* ob = (GAS v2u*)(OB + (size_t)row * DM) + lane;
#pragma unroll
            for (int j = 0; j < 8; ++j) { v2u o; o.x = pk2h(v[j][0], v[j][1]); o.y = pk2h(v[j][2], v[j][3]); ob[64 * j] = o; } }
        if (ROUTE) {
            float lg[8];
#pragma unroll
            for (int e = 0; e < 8; ++e) lg[e] = 0.f;
#pragma unroll
            for (int j = 0; j < 8; ++j) { __builtin_amdgcn_sched_barrier(0);
#pragma unroll
                for (int k = 0; k < 4; ++k) { const int col = 4 * (lane + 64 * j) + k; const f32x4 wa = *(const LAS f32x4*)(Wr + col * 8), wb = *(const LAS f32x4*)(Wr + col * 8 + 4); const float xv = v[j][k];
                    lg[0] += xv * wa[0]; lg[1] += xv * wa[1]; lg[2] += xv * wa[2]; lg[3] += xv * wa[3]; lg[4] += xv * wb[0]; lg[5] += xv * wb[1]; lg[6] += xv * wb[2]; lg[7] += xv * wb[3]; } }
#pragma unroll
            for (int e = 0; e < 8; ++e) lg[e] = wave_sum(lg[e]);
            int i0 = 0; float v0 = lg[0];
#pragma unroll
            for (int e = 1; e < 8; ++e) if (lg[e] > v0) { v0 = lg[e]; i0 = e; }
            int i1 = -1; float v1 = -3.0e38f;
#pragma unroll
            for (int e = 0; e < 8; ++e) if (e != i0 && lg[e] > v1) { v1 = lg[e]; i1 = e; }
            if (lane == 0) { const float w0 = 1.0f / (1.0f + __expf(v1 - v0));
                const int p0 = (int)__hip_atomic_fetch_add(F.ctl + CW_ECNT + i0, 1u, RLX_AGENT), p1 = (int)__hip_atomic_fetch_add(F.ctl + CW_ECNT + i1, 1u, RLX_AGENT);
                int* te = (int*)(ws + WS_ROUTE + RT_E) + 2 * row; int* tp = (int*)(ws + WS_ROUTE + RT_POS) + 2 * row; float* tw = (float*)(ws + WS_ROUTE + RT_W) + 2 * row;
                te[0] = i0; te[1] = i1; tp[0] = p0; tp[1] = p1; tw[0] = w0; tw[1] = 1.0f - w0; }
        }
    }
    if (ROUTE) __syncthreads();
}
__device__ __forceinline__ void moe_tables(Frame& F) {
    LAS int* TE = (LAS int*)(F.lds + TE_OFF); LAS int* TR = TE + TBL; LAS int* TV = TR + TBL; LAS int* CN = TE + MAXTILES + 8;
    if (F.tid < NE) CN[F.tid] = (int)__hip_atomic_load(F.ctl + CW_ECNT + F.tid, RLX_AGENT);
    __syncthreads();
    if (F.tid == 0) { int t = 0;
        for (int pass = 0; pass < 2; ++pass) { int ptile = 0;
            for (int e = 0; e < NE; ++e) { const int cnt = CN[e], nt = (cnt + 255) >> 8;
                for (int k = 0; k < nt; ++k, ++ptile) { const int rows = (cnt - 256 * k) < 256 ? (cnt - 256 * k) : 256;
                    if ((MOE_PARTIAL ? ((rows < 256) == (pass == 0)) : (pass == 0)) && t < MAXTILES) { TE[t] = e; TR[t] = ptile; TV[t] = rows; ++t; } } } }
        TE[MAXTILES] = t; }
    __syncthreads();
}
__device__ __forceinline__ void moe_gather(Frame& F, const bf16* X1B, bf16* XG) {
    unsigned char* ws = F.ws;
    int base[NE]; { int acc = 0;
#pragma unroll
        for (int e = 0; e < NE; ++e) { base[e] = acc; const int cnt = (int)__hip_atomic_load(F.ctl + CW_ECNT + e, RLX_AGENT); acc += ((cnt + 255) >> 8) << 8; } }
    const int gw = F.c * NWAVES + F.wave, NGW = F.G * NWAVES, lane = F.lane;
    for (int it = gw; it < 2 * S; it += NGW) { const int row = it >> 1, k = it & 1;
        const int e = ((const int*)(ws + WS_ROUTE + RT_E))[it], pos = ((const int*)(ws + WS_ROUTE + RT_POS))[it];
        int b = 0;
#pragma unroll
        for (int j = 0; j < NE; ++j) b = (e == j) ? base[j] : b;
        const int slot = b + pos;
        if (lane == 0) ((int*)(ws + WS_ROUTE + RT_SLOT))[it] = slot;
        const GAS v4u* src = (const GAS v4u*)(X1B + (size_t)row * DM) + lane; GAS v4u* dst = (GAS v4u*)(XG + (size_t)slot * DM) + lane;
#pragma unroll
        for (int j = 0; j < 4; ++j) dst[64 * j] = src[64 * j]; (void)k; }
}

#ifndef PG8_SP2
#define PG8_SP2 true
#endif
constexpr int PT_OFF = TE_OFF + 3 * TBL * 4;
static_assert(PT_OFF % 8 == 0 && PT_OFF + 32 * 8 <= LDS_BYTES, "LDS map");
extern __shared__ __attribute__((aligned(16))) unsigned char lds_dyn[];
__device__ __forceinline__ const float* ptr_in(int i) { const unsigned long long v = ((const LAS unsigned long long*)((LAS unsigned char*)lds_dyn + PT_OFF))[i];
    const unsigned lo = __builtin_amdgcn_readfirstlane((unsigned)v), hi = __builtin_amdgcn_readfirstlane((unsigned)(v >> 32)); return (const float*)(const GAS float*)(((unsigned long long)hi << 32) | lo); }
__device__ __forceinline__ void make_frame(Frame& F) {
    F.lds = (LAS unsigned char*)lds_dyn; F.MISC = (volatile LAS unsigned*)(F.lds + MISC_OFF);
    { int t = threadIdx.x; asm volatile("" : "+v"(t)); F.tid = t; } F.lane = F.tid & 63; F.wave = __builtin_amdgcn_readfirstlane(F.tid >> 6);
    { int gg = gridDim.x, cc = blockIdx.x; asm volatile("" : "+s"(gg), "+s"(cc)); F.G = gg; F.c = cc; } F.ws = (unsigned char*)ptr_in(29); F.ctl = (gu32*)(F.ws + WS_CTL);
}
__device__ __forceinline__ void load_in(In& I) {
    I.x = ptr_in(0); I.p = ptr_in(1); I.pos = (const int*)ptr_in(2); I.w_in = ptr_in(3); I.q_gain = ptr_in(4); I.w_qb = ptr_in(5); I.kv_gain = ptr_in(6); I.w_kvb = ptr_in(7);
    I.gla_wg = ptr_in(8); I.gla_bg = ptr_in(9); I.gla_ng = ptr_in(10); I.sinks = ptr_in(11); I.relb = ptr_in(12); I.w_out = ptr_in(13); I.ln1g = ptr_in(14); I.ln1b = ptr_in(15);
    I.f_wg = ptr_in(16); I.f_wu = ptr_in(17); I.f_wd = ptr_in(18); I.router = ptr_in(19); I.m_wg = ptr_in(20); I.m_wu = ptr_in(21); I.m_wd = ptr_in(22); I.p_wu = ptr_in(23);
    I.p_wg = ptr_in(24); I.p_bg = ptr_in(25); I.ln2g = ptr_in(26); I.ln2b = ptr_in(27);
}
typedef pg8::bf16_t pb;
#define WSP(T, off) ((T*)(F.ws + (off)))
#ifndef PHASE_ATTR
#define PHASE_ATTR __forceinline__
#endif
#define PHASE static __device__ PHASE_ATTR void

PHASE ph_prologue() { Frame F; make_frame(F); In I; load_in(I); p0_prologue(F, I); }
PHASE ph_in(int l) { Frame F; make_frame(F);
    pg8::Gemm g{WSP(const pb, WS_XB), WSP(const pb, WS_WIN) + (size_t)l * LDH * DM, DM, DM, DM}; pg8::StaticOrder So; So.init(S, LDH, F.G, F.c);
    pg8::EpiIn E{WSP(pb, WS_HB), LDH, WSP(float, WS_SSQ), WSP(const float, WS_CS)};
    pg8::gemm_phase<pg8::EpiIn, pg8::StaticOrder, true, PG8_SP2>(F.lds + RING_OFF, g, So, E, F.tid);
    if (F.G == 256 && F.c >= 256 - HOLE1_WG) { In I; load_in(I); if (l == 0) bg_convert(F, I, N_PRO256, F.c - (256 - HOLE1_WG), HOLE1_WG, BGQ1); else bg_convert(F, I, N_PRO256 + HOLE1_N + HOLE2_N, F.c - (256 - HOLE3_WG), HOLE3_WG, BGQ3); } }
PHASE ph_upq(int l) { Frame F; make_frame(F);
    pg8::Gemm g{WSP(const pb, WS_HB) + H_QA, WSP(const pb, WS_WQB) + (size_t)l * QW * 512, LDH, 512, 512}; pg8::StaticOrder So; So.init(S, QW, F.G, F.c);
    pg8::EpiUp<true> E{WSP(pb, WS_QB), QW, WSP(const float, WS_SSQ), WSP(const float, WS_CS)};
    pg8::gemm_phase<pg8::EpiUp<true>, pg8::StaticOrder, true, PG8_SP2>(F.lds + RING_OFF, g, So, E, F.tid); }
PHASE ph_upkv(int l) { Frame F; make_frame(F);
    pg8::Gemm g{WSP(const pb, WS_HB) + H_KVA, WSP(const pb, WS_WKVB) + (size_t)l * KVW * 256, LDH, 256, 256}; pg8::StaticOrder So; So.init(S, KVW, F.G, F.c);
    pg8::EpiUp<false> E{WSP(pb, WS_KVB), KVW, WSP(const float, WS_SSQ), WSP(const float, WS_CS)};
    pg8::gemm_phase<pg8::EpiUp<false>, pg8::StaticOrder, true, PG8_SP2>(F.lds + RING_OFF, g, So, E, F.tid); }
PHASE ph_swa(int l) { Frame F; make_frame(F); const float* sinks = ptr_in(11) + l * 8; const float* relb = ptr_in(12);
    for (int u = F.c; u < 512; u += F.G) swa_unit(F, u >> 3, u & 7, WSP(const bf16, WS_HB), WSP(bf16, WS_MIX), sinks, relb); }
PHASE ph_gla1(int l) { Frame F; make_frame(F); const float* wg = ptr_in(8) + (size_t)l * 16 * 256; const float* bg = ptr_in(9) + l * 256; const float* ng = ptr_in(10) + l * 512;
    for (int u = F.c; u < 512; u += F.G) gla_unit<1>(F, u >> 2, u & 3, WSP(const bf16, WS_HB), wg, bg, WSP(float, WS_GUT), WSP(float, WS_GDEC), WSP(const bf16, WS_GSP), ng, WSP(bf16, WS_MIX)); }
PHASE ph_gla3(int l) { Frame F; make_frame(F); const float* wg = ptr_in(8) + (size_t)l * 16 * 256; const float* bg = ptr_in(9) + l * 256; const float* ng = ptr_in(10) + l * 512;
    for (int u = F.c; u < 512; u += F.G) gla_unit<3>(F, u >> 2, u & 3, WSP(const bf16, WS_HB), wg, bg, WSP(float, WS_GUT), WSP(float, WS_GDEC), WSP(const bf16, WS_GSP), ng, WSP(bf16, WS_MIX)); }
PHASE ph_scan() { Frame F; make_frame(F); gla_scan(F, WSP(const float, WS_GUT), WSP(const float, WS_GDEC), WSP(bf16, WS_GSP)); }
PHASE ph_mla() { Frame F; make_frame(F);
    for (int pr = F.c; pr < 256; pr += F.G) { const int h = pr >> 5, qb = pr & 31;
#pragma unroll 1
        for (int k = 0; k < 2; ++k) mla_unit(F, h, k ? qb : 63 - qb, WSP(const bf16, WS_QB), WSP(const bf16, WS_KVB), WSP(const bf16, WS_HB), WSP(bf16, WS_MIX)); } }
PHASE ph_out(int l) { Frame F; make_frame(F);
    pg8::Gemm g{WSP(const pb, WS_MIX), WSP(const pb, WS_WOUT) + (size_t)l * DM * DM, DM, DM, DM}; pg8::StaticOrder So; So.init(S, DM, F.G, F.c);
    pg8::EpiOutRes E{WSP(float, WS_R2), DM, WSP(const pb, WS_XB), ALPHA};
    pg8::gemm_phase<pg8::EpiOutRes, pg8::StaticOrder, true, PG8_SP2>(F.lds + RING_OFF, g, So, E, F.tid); }
PHASE ph_ln1(int l) { Frame F; make_frame(F);
    ln_phase<0, false>(F, WSP(const void, WS_R2), nullptr, nullptr, ptr_in(14) + l * DM, ptr_in(15) + l * DM, nullptr, WSP(bf16, WS_X1B), nullptr); }
PHASE ph_ln1_route(int l) { Frame F; make_frame(F);
    ln_phase<0, true>(F, WSP(const void, WS_R2), nullptr, nullptr, ptr_in(14) + l * DM, ptr_in(15) + l * DM, nullptr, WSP(bf16, WS_X1B), ptr_in(19)); }
PHASE ph_gu_dense() { Frame F; make_frame(F);
    pg8::Gemm g{WSP(const pb, WS_X1B), WSP(const pb, WS_FGU), DM, DM, DM}; pg8::StaticOrder So; So.init(S, NGU, F.G, F.c);
    pg8::EpiSwiGLU E{WSP(pb, WS_HMID), DFF};
    pg8::gemm_phase<pg8::EpiSwiGLU, pg8::StaticOrder, true, PG8_SP2>(F.lds + RING_OFF, g, So, E, F.tid);
    if (F.G == 256 && F.c >= 256 - HOLE2_WG) { In I; load_in(I); bg_convert(F, I, N_PRO256 + HOLE1_N, F.c - (256 - HOLE2_WG), HOLE2_WG, BGQ2); } }
PHASE ph_gather() { Frame F; make_frame(F); moe_gather(F, WSP(const bf16, WS_X1B), WSP(bf16, WS_XG)); }
PHASE ph_gu_moe() { Frame F; make_frame(F); moe_tables(F);
    pg8::Gemm g{WSP(const pb, WS_XG), WSP(const pb, WS_MGU), DM, DM, DM};
    pg8::MoeOrder<NGU / 256> Mo{(const PG8_LAS int*)(F.lds + TE_OFF), (const PG8_LAS int*)(F.lds + TE_OFF) + TBL, (const PG8_LAS int*)(F.lds + TE_OFF) + 2 * TBL, ((const LAS int*)(F.lds + TE_OFF))[MAXTILES], F.G, F.c};
    pg8::EpiSwiGLU E{WSP(pb, WS_HMID), DFF};
    pg8::gemm_phase<pg8::EpiSwiGLU, pg8::MoeOrder<NGU / 256>, true, PG8_SP2>(F.lds + RING_OFF, g, Mo, E, F.tid); }
PHASE ph_plegate(int l) { Frame F; make_frame(F);
    pg8::Gemm g{WSP(const pb, WS_X1B), WSP(const pb, WS_WPG) + (size_t)l * DM * DM, DM, DM, DM}; pg8::StaticOrder So; So.init(S, DM, F.G, F.c);
    pg8::EpiPle<0> E{WSP(pb, WS_PLE), DM, ptr_in(25) + l * DM};
    pg8::gemm_phase<pg8::EpiPle<0>, pg8::StaticOrder, true, PG8_SP2>(F.lds + RING_OFF, g, So, E, F.tid); }
PHASE ph_ple_light(int l) { Frame F; make_frame(F); moe_tables(F);
    const int ntot = ((const LAS int*)(F.lds + TE_OFF))[MAXTILES] * (DM / 256), nheavy = ntot - (ntot / F.G) * F.G;
    if (F.c < nheavy) return;
    pg8::StaticOrder So; So.init(S, DM, F.G - nheavy, F.c - nheavy);
    { pg8::Gemm g{WSP(const pb, WS_X1B), WSP(const pb, WS_WPG) + (size_t)l * DM * DM, DM, DM, DM}; pg8::EpiPle<0> E{WSP(pb, WS_PLE), DM, ptr_in(25) + l * DM};
      pg8::gemm_phase<pg8::EpiPle<0>, pg8::StaticOrder, true, PG8_SP2>(F.lds + RING_OFF, g, So, E, F.tid); }
    { pg8::Gemm g{WSP(const pb, WS_PB) + (size_t)l * S * PLE, WSP(const pb, WS_WPU) + (size_t)l * DM * PLE, PLE, PLE, PLE}; pg8::EpiPle<1> E{WSP(pb, WS_PLE), DM, nullptr};
      pg8::gemm_phase<pg8::EpiPle<1>, pg8::StaticOrder, true, PG8_SP2>(F.lds + RING_OFF, g, So, E, F.tid); } }
PHASE ph_down_dense() { Frame F; make_frame(F);
    pg8::Gemm g{WSP(const pb, WS_HMID), WSP(const pb, WS_FD), DFF, DFF, DFF}; pg8::StaticOrder So; So.init(S, DM, F.G, F.c);
    pg8::EpiBf16 E{WSP(pb, WS_R2), DM};
    pg8::gemm_phase<pg8::EpiBf16, pg8::StaticOrder, true, PG8_SP2>(F.lds + RING_OFF, g, So, E, F.tid); }
PHASE ph_down_moe() { Frame F; make_frame(F); moe_tables(F);
    pg8::Gemm g{WSP(const pb, WS_HMID), WSP(const pb, WS_MD), DFF, DFF, DFF};
    pg8::MoeOrder<DM / 256> Mo{(const PG8_LAS int*)(F.lds + TE_OFF), (const PG8_LAS int*)(F.lds + TE_OFF) + TBL, (const PG8_LAS int*)(F.lds + TE_OFF) + 2 * TBL, ((const LAS int*)(F.lds + TE_OFF))[MAXTILES], F.G, F.c};
    pg8::EpiBf16 E{WSP(pb, WS_R2), DM};
    pg8::gemm_phase<pg8::EpiBf16, pg8::MoeOrder<DM / 256>, true, PG8_SP2>(F.lds + RING_OFF, g, Mo, E, F.tid); }
PHASE ph_pleup(int l) { Frame F; make_frame(F);
    pg8::Gemm g{WSP(const pb, WS_PB) + (size_t)l * S * PLE, WSP(const pb, WS_WPU) + (size_t)l * DM * PLE, PLE, PLE, PLE}; pg8::StaticOrder So; So.init(S, DM, F.G, F.c);
    pg8::EpiPle<1> E{WSP(pb, WS_PLE), DM, nullptr};
    pg8::gemm_phase<pg8::EpiPle<1>, pg8::StaticOrder, true, PG8_SP2>(F.lds + RING_OFF, g, So, E, F.tid); }
PHASE ph_ln2_dense(int l) { Frame F; make_frame(F);
    ln_phase<1, false>(F, WSP(const void, WS_R2), WSP(const bf16, WS_X1B), WSP(const bf16, WS_PLE), ptr_in(26) + l * DM, ptr_in(27) + l * DM, nullptr, WSP(bf16, WS_XB), nullptr); }
PHASE ph_ln2_moe(int l) { Frame F; make_frame(F);
    ln_phase<2, false>(F, WSP(const void, WS_R2), WSP(const bf16, WS_X1B), WSP(const bf16, WS_PLE), ptr_in(26) + l * DM, ptr_in(27) + l * DM, (float*)ptr_in(28), nullptr, nullptr); }
PHASE ph_bar() { Frame F; make_frame(F); XcdBarrier bar; bar.bar = (unsigned*)(F.ctl + CW_BAR); bar.x = xb_xcc_id(); bar.st = F.MISC + 8; xcd_barrier(bar); }

struct Args { const float* in[28]; float* out; unsigned char* ws; };
__global__ void __launch_bounds__(NWAVES * 64, 2) fwd_kernel(Args args) {
    { LAS unsigned char* L = (LAS unsigned char*)lds_dyn;
      for (int u = threadIdx.x; u < (LDS_BYTES - LDSCTL_OFF) / 4; u += NWAVES * 64) ((LAS unsigned*)(L + LDSCTL_OFF))[u] = 0u;
      __syncthreads();
      if (threadIdx.x == 0) { LAS unsigned long long* pt = (LAS unsigned long long*)(L + PT_OFF);
#pragma unroll
          for (int i = 0; i < 28; ++i) pt[i] = (unsigned long long)args.in[i];
          pt[28] = (unsigned long long)args.out; pt[29] = (unsigned long long)args.ws; }
      __syncthreads();
      (void)xcd_barrier_post((unsigned*)((gu32*)(args.ws + WS_CTL) + CW_BAR), (volatile LAS unsigned*)(L + MISC_OFF) + 8); }
#ifndef DUP
#define DUP 0
#endif
#define D(bit, call) do { call; if (DUP & (bit)) { call; } } while (0)
#ifdef ONLY
    ONLY; ph_bar();
#else
    D(1, ph_prologue()); ph_bar();
    D(2, ph_in(0)); ph_bar();
    D(4, ph_upq(0)); D(4, ph_upkv(0)); D(8, ph_swa(0)); D(16, ph_gla1(0)); ph_bar();
    D(32, ph_scan()); D(64, ph_mla()); ph_bar();
    D(128, ph_gla3(0)); ph_bar();
    D(256, ph_out(0)); ph_bar();
    D(512, ph_ln1(0)); ph_bar();
    D(1024, ph_gu_dense()); D(2048, ph_plegate(0)); ph_bar();
    D(4096, ph_down_dense()); ph_pleup(0); ph_bar();
    D(512, ph_ln2_dense(0)); ph_bar();
    D(2, ph_in(1)); ph_bar();
    D(4, ph_upq(1)); D(4, ph_upkv(1)); D(8, ph_swa(1)); D(16, ph_gla1(1)); ph_bar();
    D(32, ph_scan()); D(64, ph_mla()); ph_bar();
    D(128, ph_gla3(1)); ph_bar();
    D(256, ph_out(1)); ph_bar();
    ph_ln1_route(1); ph_bar();
    D(8192, ph_gather()); ph_bar();
#ifdef PLE_LIGHT
    D(16384, ph_gu_moe()); ph_bar();
    D(32768, ph_down_moe()); ph_ple_light(1); ph_bar();
#else
    D(16384, ph_gu_moe()); D(2048, ph_plegate(1)); ph_bar();
    D(32768, ph_down_moe()); ph_pleup(1); ph_bar();
#endif
    ph_ln2_moe(1);
#endif
}

extern "C" void kernel_launch(void* const* d_in, const int* in_sizes, int n_in, void* d_out, int out_size, void* d_ws, size_t ws_size, hipStream_t stream) {
    static int grid = 0;
    if (grid == 0) {
        if (n_in != 28 || in_sizes[0] != S * DM || out_size != S * DM || ws_size < WS_END) { fprintf(stderr, "kernel_launch: unexpected shapes / workspace (n_in %d, ws %zu, need %zu); nothing launched\n", n_in, ws_size, (size_t)WS_END); grid = -1; return; }
        int dev = 0, cus = 0, per_cu = 0;
        if (hipGetDevice(&dev) != hipSuccess || hipDeviceGetAttribute(&cus, hipDeviceAttributeMultiprocessorCount, dev) != hipSuccess) { grid = -1; return; }
        if (hipFuncSetAttribute((const void*)fwd_kernel, hipFuncAttributeMaxDynamicSharedMemorySize, LDS_BYTES) != hipSuccess) { fprintf(stderr, "kernel_launch: hipFuncSetAttribute failed\n"); grid = -1; return; }
        if (hipOccupancyMaxActiveBlocksPerMultiprocessor(&per_cu, (const void*)fwd_kernel, NWAVES * 64, LDS_BYTES) != hipSuccess || per_cu < 1) { fprintf(stderr, "kernel_launch: occupancy query reports %d workgroups per CU\n", per_cu); (void)hipGetLastError(); grid = -1; return; }
        grid = cus;
    }
    if (grid < 0) return;
    if (hipMemsetAsync((char*)d_ws + WS_CTL, 0, CTL_ZERO_BYTES, stream) != hipSuccess) return;
    Args a{};
    for (int i = 0; i < 28; ++i) a.in[i] = (const float*)d_in[i];
    a.out = (float*)d_out; a.ws = (unsigned char*)d_ws;
    hipLaunchKernelGGL(fwd_kernel, dim3(grid), dim3(NWAVES * 64), LDS_BYTES, stream, a);
}
```

```cpp
#include <hip/hip_runtime.h>
#include <cstdio>
#include <cstdint>
namespace pg8 {
#define PG8_LAS __attribute__((address_space(3)))
typedef unsigned short bf16_t;
typedef short bf16x8 __attribute__((ext_vector_type(8)));
typedef float f32x4 __attribute__((ext_vector_type(4)));
typedef unsigned u32x4 __attribute__((ext_vector_type(4)));
constexpr int BM = 256, BK = 64, HALF = 128, HTB = HALF * BK * 2  , STAGE_BYTES = 8 * HTB, NXCD = 8, WGM = 8;

__host__ __device__ __forceinline__ int lds_byte(int r, int c) { const int st = (r >> 4) * 2 + (c >> 5), rr = r & 15, cc = c & 31, ob = rr * 64 + cc * 2; return st * 1024 + (ob ^ (((ob >> 9) & 1) << 5)); }
__host__ __device__ __forceinline__ void stage_rc(int b, int& R, int& C) { const int st = b / 1024, sb = b % 1024, swz = sb ^ (((sb >> 9) & 1) << 5); R = (st >> 1) * 16 + swz / 64; C = (st & 1) * 32 + (swz % 64) / 2; }
__host__ __device__ __forceinline__ int perm32(int rho) { const int n = rho >> 4, i = rho & 15; return 8 * (i >> 2) + 4 * n + (i & 3); }

struct Unit { int pm, pn, pb, rows; };
struct Gemm { const bf16_t* A; const bf16_t* Bt; int lda, ldb, K; };

struct StaticOrder {
    static constexpr bool PARTIAL = false;
    int nM, nN, nwg, G, c;
    __host__ __device__ void init(int M, int N, int G_, int c_) { nM = M / BM; nN = N / BM; nwg = nM * nN; G = G_; c = c_; }
    __host__ __device__ bool next(int i, Unit& u) const {
        const long L = (long)i * G + c; if (L >= nwg) return false;
        int wgid = (int)L; { const int q = nwg / NXCD, r = nwg % NXCD, xcd = wgid % NXCD, off = wgid / NXCD; wgid = (xcd < r ? xcd * (q + 1) : r * (q + 1) + (xcd - r) * q) + off; }
        const int nig = WGM * nN, gid = wgid / nig, fm = gid * WGM, gsz = (nM - fm) < WGM ? (nM - fm) : WGM;
        u.pm = fm + ((wgid % nig) % gsz); u.pn = (wgid % nig) / gsz; u.pb = u.pn; u.rows = BM; return true;
    }
    __device__ __forceinline__ void a_ready(const Unit&) const {}
    __device__ __forceinline__ void done(const Unit&) const {}
};
#ifndef MOE_PARTIAL
#define MOE_PARTIAL false
#endif
template <int nN> struct MoeOrder {
    static constexpr bool PARTIAL = MOE_PARTIAL;
    const PG8_LAS int* te; const PG8_LAS int* trow; const PG8_LAS int* tval; int ntiles, G, c;
    __device__ __forceinline__ bool next(int i, Unit& u) const {
        const int L = i * G + c; if (L >= ntiles * nN) return false;
        const int idx = L / nN; u.pn = L - idx * nN; u.pm = trow[idx]; u.pb = te[idx] * nN + u.pn; u.rows = tval[idx]; return true;
    }
    __device__ __forceinline__ void a_ready(const Unit&) const {}
    __device__ __forceinline__ void done(const Unit&) const {}
};
typedef float f32x2v __attribute__((ext_vector_type(2))); typedef __bf16 bf16x2v __attribute__((ext_vector_type(2)));
__device__ __forceinline__ unsigned cvt_pk_bf16(float lo, float hi) { const f32x2v v = {lo, hi}; const bf16x2v r = __builtin_convertvector(v, bf16x2v); return __builtin_bit_cast(unsigned, r); }
typedef float f32x2 __attribute__((ext_vector_type(2)));
__device__ __forceinline__ float fast_sigmoid(float v) { return __builtin_amdgcn_rcpf(1.0f + __builtin_amdgcn_exp2f(-1.4426950408889634f * v)); }
__device__ __forceinline__ u32x4 pack8(const f32x4 a, const f32x4 b) { u32x4 w; w.x = cvt_pk_bf16(a[0], a[1]); w.y = cvt_pk_bf16(a[2], a[3]); w.z = cvt_pk_bf16(b[0], b[1]); w.w = cvt_pk_bf16(b[2], b[3]); return w; }
__device__ __forceinline__ void rope8(f32x4& a, f32x4& b, const f32x4 c4, const f32x4 s4) {
    const f32x4 a0 = a, b0 = b;
    a[0] = a0[0] * c4[0] - a0[1] * s4[0]; a[1] = a0[1] * c4[0] + a0[0] * s4[0];
    a[2] = a0[2] * c4[1] - a0[3] * s4[1]; a[3] = a0[3] * c4[1] + a0[2] * s4[1];
    b[0] = b0[0] * c4[2] - b0[1] * s4[2]; b[1] = b0[1] * c4[2] + b0[0] * s4[2];
    b[2] = b0[2] * c4[3] - b0[3] * s4[3]; b[3] = b0[3] * c4[3] + b0[2] * s4[3];
}
struct EpiIn {
    static constexpr bool PERM = true, AFTER_DRAIN = false;
    bf16_t* H; int ldc; float* ssq; const float* cs;
    __device__ __forceinline__ void operator()(const f32x4 (&acc)[2][2][4][2], const Unit& u, int wr, int wc, int fr, int fq) const {
        const int row0 = u.pm * BM + wr * 64 + fr, col0 = u.pn * BM + wc * 32 + 8 * fq;
#pragma unroll
        for (int ai = 0; ai < 2; ++ai)
#pragma unroll
            for (int m = 0; m < 4; ++m) { const int row = row0 + ai * HALF + m * 16; bf16_t* rowp = H + (size_t)row * ldc + col0; float s = 0.f;
#pragma unroll
                for (int bj = 0; bj < 2; ++bj) { f32x4 v0 = acc[ai][bj][m][0], v1 = acc[ai][bj][m][1];
                    if (bj == 0 && u.pn == 3 && wc < 2) { const int p0 = (wc * 32 + 8 * fq) >> 1; const f32x4 c4 = *(const f32x4*)(cs + (size_t)row * 64 + p0), s4 = *(const f32x4*)(cs + (size_t)row * 64 + 32 + p0); rope8(v0, v1, c4, s4); }
                    s += (v0[0] * v0[0] + v0[1] * v0[1]) + (v0[2] * v0[2] + v0[3] * v0[3]) + (v1[0] * v1[0] + v1[1] * v1[1]) + (v1[2] * v1[2] + v1[3] * v1[3]);
                    *(u32x4*)(rowp + bj * HALF) = pack8(v0, v1); }
                if (u.pn < 3) { s += __shfl_xor(s, 16); s += __shfl_xor(s, 32); if (fq == 0) ssq[(size_t)row * 12 + u.pn * 4 + wc] = s; } }
    }
};
template <bool ISQ> struct EpiUp {
    static constexpr bool PERM = true, AFTER_DRAIN = false;
    bf16_t* O; int ldc; const float* ssq; const float* cs;
    __device__ __forceinline__ void operator()(const f32x4 (&acc)[2][2][4][2], const Unit& u, int wr, int wc, int fr, int fq) const {
        const int row0 = u.pm * BM + wr * 64 + fr, col0 = u.pn * BM + wc * 32 + 8 * fq;
#pragma unroll
        for (int ai = 0; ai < 2; ++ai)
#pragma unroll
            for (int m = 0; m < 4; ++m) { const int row = row0 + ai * HALF + m * 16; bf16_t* rowp = O + (size_t)row * ldc + col0;
                const float* sp = ssq + (size_t)row * 12 + (ISQ ? 0 : 8); float r;
                if (ISQ) { const f32x4 a = *(const f32x4*)sp, b = *(const f32x4*)(sp + 4);
                    const float s = ((a[0] + a[1]) + (a[2] + a[3])) + ((b[0] + b[1]) + (b[2] + b[3])); r = 1.0f / sqrtf(s * (1.0f / 512.0f) + 1e-6f); }
                else { const f32x4 a = *(const f32x4*)sp; const float s = (a[0] + a[1]) + (a[2] + a[3]); r = 1.0f / sqrtf(s * (1.0f / 256.0f) + 1e-6f); }
#pragma unroll
                for (int bj = 0; bj < 2; ++bj) { f32x4 v0 = acc[ai][bj][m][0] * r, v1 = acc[ai][bj][m][1] * r;
                    if (ISQ) { const int col = col0 + bj * HALF, hc = col % 192;
                        if (hc >= 128) { const int p0 = (hc - 128) >> 1; const f32x4 c4 = *(const f32x4*)(cs + (size_t)row * 64 + p0), s4 = *(const f32x4*)(cs + (size_t)row * 64 + 32 + p0); rope8(v0, v1, c4, s4); } }
                    *(u32x4*)(rowp + bj * HALF) = pack8(v0, v1); } }
    }
};
struct EpiOutRes {
    static constexpr bool PERM = false, AFTER_DRAIN = false;
    float* C; int ldc; const bf16_t* res; float alpha;
    __device__ __forceinline__ void operator()(const f32x4 (&acc)[2][2][4][2], const Unit& u, int wr, int wc, int fr, int fq) const {
        const int row0 = u.pm * BM + wr * 64 + fr, col0 = u.pn * BM + wc * 32 + 4 * fq;
        typedef unsigned u32x2 __attribute__((ext_vector_type(2)));
#pragma unroll
        for (int ai = 0; ai < 2; ++ai)
#pragma unroll
            for (int m = 0; m < 4; ++m) { const size_t ro = (size_t)(row0 + ai * HALF + m * 16) * ldc + col0;
#pragma unroll
                for (int bj = 0; bj < 2; ++bj)
#pragma unroll
                    for (int n = 0; n < 2; ++n) { f32x4 v = acc[ai][bj][m][n]; const u32x2 r = *(const u32x2*)(res + ro + bj * HALF + n * 16);
                        v[0] += alpha * __builtin_bit_cast(float, r.x << 16); v[1] += alpha * __builtin_bit_cast(float, r.x & 0xffff0000u);
                        v[2] += alpha * __builtin_bit_cast(float, r.y << 16); v[3] += alpha * __builtin_bit_cast(float, r.y & 0xffff0000u);
                        *(f32x4*)(C + ro + bj * HALF + n * 16) = v; } }
    }
};
struct EpiBf16 {
    static constexpr bool PERM = true, AFTER_DRAIN = false;
    bf16_t* O; int ldc;
    __device__ __forceinline__ void operator()(const f32x4 (&acc)[2][2][4][2], const Unit& u, int wr, int wc, int fr, int fq) const {
        const int row0 = u.pm * BM + wr * 64 + fr, col0 = u.pn * BM + wc * 32 + 8 * fq;
#pragma unroll
        for (int ai = 0; ai < 2; ++ai)
#pragma unroll
            for (int m = 0; m < 4; ++m) { bf16_t* rowp = O + (size_t)(row0 + ai * HALF + m * 16) * ldc + col0;
#pragma unroll
                for (int bj = 0; bj < 2; ++bj) *(u32x4*)(rowp + bj * HALF) = pack8(acc[ai][bj][m][0], acc[ai][bj][m][1]); }
    }
};
template <int MODE> struct EpiPle {
    static constexpr bool PERM = true, AFTER_DRAIN = false;
    bf16_t* C; int ldc; const float* bias;
    __device__ __forceinline__ void operator()(const f32x4 (&acc)[2][2][4][2], const Unit& u, int wr, int wc, int fr, int fq) const {
        const int row0 = u.pm * BM + wr * 64 + fr, col0 = u.pn * BM + wc * 32 + 8 * fq;
#pragma unroll
        for (int ai = 0; ai < 2; ++ai)
#pragma unroll
            for (int m = 0; m < 4; ++m) { bf16_t* rowp = C + (size_t)(row0 + ai * HALF + m * 16) * ldc + col0;
#pragma unroll
                for (int bj = 0; bj < 2; ++bj) { f32x4 v0 = acc[ai][bj][m][0], v1 = acc[ai][bj][m][1]; bf16_t* cp = rowp + bj * HALF;
                    if (MODE == 0) { const f32x4 b0 = *(const f32x4*)(bias + col0 + bj * HALF), b1 = *(const f32x4*)(bias + col0 + bj * HALF + 4); v0 = v0 + b0; v1 = v1 + b1;
#pragma unroll
                        for (int e = 0; e < 4; ++e) { v0[e] = fast_sigmoid(v0[e]); v1[e] = fast_sigmoid(v1[e]); } }
                    else { const u32x4 s = *(const u32x4*)cp;
                        v0[0] *= __builtin_bit_cast(float, s.x << 16); v0[1] *= __builtin_bit_cast(float, s.x & 0xffff0000u); v0[2] *= __builtin_bit_cast(float, s.y << 16); v0[3] *= __builtin_bit_cast(float, s.y & 0xffff0000u);
                        v1[0] *= __builtin_bit_cast(float, s.z << 16); v1[1] *= __builtin_bit_cast(float, s.z & 0xffff0000u); v1[2] *= __builtin_bit_cast(float, s.w << 16); v1[3] *= __builtin_bit_cast(float, s.w & 0xffff0000u); }
                    *(u32x4*)cp = pack8(v0, v1); } }
    }
};
struct EpiSwiGLU {
    static constexpr bool PERM = true, AFTER_DRAIN = false;
    bf16_t* O; int ldc;
    __device__ __forceinline__ void operator()(const f32x4 (&acc)[2][2][4][2], const Unit& u, int wr, int wc, int fr, int fq) const {
        const int row0 = u.pm * BM + wr * 64 + fr, col0 = u.pn * HALF + wc * 32 + 8 * fq;
#pragma unroll
        for (int ai = 0; ai < 2; ++ai)
#pragma unroll
            for (int m = 0; m < 4; ++m) { bf16_t* rowp = O + (size_t)(row0 + ai * HALF + m * 16) * ldc + col0;
                f32x4 o[2];
#pragma unroll
                for (int n = 0; n < 2; ++n) { const f32x4 g = acc[ai][0][m][n], up = acc[ai][1][m][n];
#pragma unroll
                    for (int e = 0; e < 4; ++e) o[n][e] = g[e] * fast_sigmoid(g[e]) * up[e]; }
                *(u32x4*)rowp = pack8(o[0], o[1]); }
    }
};
template <class Epi, class Sched, bool ALIGN_EPI = false, bool SP2 = false>
__device__ __forceinline__ void gemm_phase(PG8_LAS unsigned char* lds, const Gemm g, const Sched& S, const Epi& E, const int tid) {
    const int wid = __builtin_amdgcn_readfirstlane(tid >> 6), lane = tid & 63, wr = wid >> 2, wc = wid & 3, fr = lane & 15, fq = lane >> 4;
    const int K = g.K, nt = K / BK;
    unsigned voffA[2], voffB[2];
#pragma unroll
    for (int i = 0; i < 2; ++i) { int R, C; stage_rc(tid * 16 + i * 8192, R, C); const int Rb = Epi::PERM ? ((R & ~31) + perm32(R & 31)) : R;
        voffA[i] = (unsigned)(R * g.lda + C) * 2u; voffB[i] = (unsigned)(Rb * g.ldb + C) * 2u; }
    const size_t kstep = (size_t)(BK * 2);
    const size_t hstepA = (size_t)HALF * g.lda * 2, hstepB = (size_t)HALF * g.ldb * 2;
    const size_t tstepA = 2 * hstepA, tstepB = 2 * hstepB;
    const unsigned ldsw = (unsigned)wid * 1024u;
    const int aoff = lds_byte(wr * 64 + fr, fq * 8), boff = lds_byte(wc * 32 + fr, fq * 8);
#define PG8_SA(b, h) (((b) * 2 + (h)) * HTB)
#define PG8_SB(b, h) ((4 + (b) * 2 + (h)) * HTB)
#define PG8_STAGE(bufoff, gbase, voff) do { _Pragma("unroll") for (int _i = 0; _i < 2; ++_i) \
        __builtin_amdgcn_global_load_lds((const unsigned*)((const char*)(gbase) + (voff)[_i]), (PG8_LAS unsigned*)(lds + (bufoff) + ldsw + _i * 8192), 16, 0, 0); } while (0)
#define PG8_LDA(dst, b, h) do { _Pragma("unroll") for (int m = 0; m < 4; ++m) _Pragma("unroll") for (int k = 0; k < 2; ++k) dst[m][k] = *(const PG8_LAS bf16x8*)(lds + PG8_SA(b, h) + aoff + m * 2048 + k * 1024); } while (0)
#define PG8_LDB(dst, b, h) do { _Pragma("unroll") for (int n = 0; n < 2; ++n) _Pragma("unroll") for (int k = 0; k < 2; ++k) dst[n][k] = *(const PG8_LAS bf16x8*)(lds + PG8_SB(b, h) + boff + n * 2048 + k * 1024); } while (0)
#define PG8_MMA(ai, bj, At, Bt) do { __builtin_amdgcn_s_setprio(1); _Pragma("unroll") for (int m = 0; m < 4; ++m) _Pragma("unroll") for (int n = 0; n < 2; ++n) _Pragma("unroll") for (int k = 0; k < 2; ++k) \
        acc[ai][bj][m][n] = __builtin_amdgcn_mfma_f32_16x16x32_bf16(Bt[n][k], At[m][k], acc[ai][bj][m][n], 0, 0, 0); __builtin_amdgcn_s_setprio(0); } while (0)
#define PG8_MMAG(ai, bj, At, Bt) do { if (Sched::PARTIAL && !((ai) == 0 ? on0 : on1)) break; __builtin_amdgcn_s_setprio(1); _Pragma("unroll") for (int m = 0; m < 4; ++m) _Pragma("unroll") for (int n = 0; n < 2; ++n) _Pragma("unroll") for (int k = 0; k < 2; ++k) \
        acc[ai][bj][m][n] = __builtin_amdgcn_mfma_f32_16x16x32_bf16(Bt[n][k], At[m][k], acc[ai][bj][m][n], 0, 0, 0); __builtin_amdgcn_s_setprio(0); } while (0)
#define PG8_WAIT_V(n) asm volatile("s_waitcnt vmcnt(" #n ")" ::: "memory")
#define PG8_WAIT_L(n) asm volatile("s_waitcnt lgkmcnt(" #n ")" ::: "memory")
#define PG8_BAR __builtin_amdgcn_s_barrier()
#define PG8_SCHED __builtin_amdgcn_sched_barrier(0)
    Unit cur, nxt; int ui = 0;
    if (!S.next(0, cur)) return;
    bool on0 = true, on1 = true;
    if constexpr (Sched::PARTIAL) { on0 = cur.rows > wr * 64; on1 = cur.rows > HALF + wr * 64; }
    f32x4 acc[2][2][4][2];
#pragma unroll
    for (int a = 0; a < 2; ++a)
#pragma unroll
        for (int b = 0; b < 2; ++b)
#pragma unroll
            for (int m = 0; m < 4; ++m)
#pragma unroll
                for (int n = 0; n < 2; ++n) acc[a][b][m][n] = (f32x4){0.f, 0.f, 0.f, 0.f};
    bf16x8 At[4][2], B0[2][2], B1[2][2];
    const char* cA = (const char*)g.A + (size_t)cur.pm * tstepA; const char* cB = (const char*)g.Bt + (size_t)cur.pb * tstepB;
    S.a_ready(cur);
    if constexpr (SP2) {
        PG8_STAGE(PG8_SB(0, 0), cB, voffB); PG8_STAGE(PG8_SB(0, 1), cB + hstepB, voffB); PG8_STAGE(PG8_SA(0, 0), cA, voffA); PG8_STAGE(PG8_SA(0, 1), cA + hstepA, voffA);
        if (wr == 1) PG8_BAR;
        PG8_WAIT_V(2); PG8_BAR;
        PG8_STAGE(PG8_SB(1, 0), cB + kstep, voffB); PG8_STAGE(PG8_SA(1, 0), cA + kstep, voffA); PG8_STAGE(PG8_SB(1, 1), cB + hstepB + kstep, voffB);
        PG8_WAIT_V(6); PG8_BAR;
    } else {
        PG8_STAGE(PG8_SB(0, 0), cB, voffB); PG8_STAGE(PG8_SA(0, 0), cA, voffA); PG8_STAGE(PG8_SB(0, 1), cB + hstepB, voffB); PG8_STAGE(PG8_SA(0, 1), cA + hstepA, voffA);
        if (wr == 1) PG8_BAR;
        PG8_WAIT_V(4); PG8_BAR;
        PG8_STAGE(PG8_SB(1, 0), cB + kstep, voffB); PG8_STAGE(PG8_SA(1, 0), cA + kstep, voffA); PG8_STAGE(PG8_SB(1, 1), cB + hstepB + kstep, voffB);
        PG8_WAIT_V(6); PG8_BAR;
    }
    for (;;) {
        const bool has_next = S.next(ui + 1, nxt);
        const char* nA = has_next ? (const char*)g.A + (size_t)nxt.pm * tstepA : cA; const char* nB = has_next ? (const char*)g.Bt + (size_t)nxt.pb * tstepB : cB;
        if (Sched::PARTIAL && !(on0 && on1)) {
        for (int t = 0; t < nt; t += 2) {
            const bool last = (t == nt - 2);
            const char* a1 = cA + (size_t)(t + 1) * kstep;
            const char* a2 = last ? nA : cA + (size_t)(t + 2) * kstep; const char* b2 = last ? nB : cB + (size_t)(t + 2) * kstep;
            const char* a3 = a2 + kstep; const char* b3 = b2 + kstep;
            if (last && has_next) S.a_ready(nxt);
            if constexpr (SP2) {
            PG8_LDB(B0, 0, 0); PG8_LDB(B1, 0, 1); PG8_SCHED; PG8_LDA(At, 0, 0); PG8_STAGE(PG8_SA(1, 1), a1 + hstepA, voffA);
            PG8_WAIT_V(8); PG8_WAIT_L(0); PG8_BAR; PG8_MMAG(0, 0, At, B0); PG8_MMAG(0, 1, At, B1); PG8_BAR; PG8_SCHED;
            PG8_LDA(At, 0, 1); PG8_STAGE(PG8_SB(0, 0), b2, voffB); PG8_STAGE(PG8_SB(0, 1), b2 + hstepB, voffB); PG8_STAGE(PG8_SA(0, 0), a2, voffA);
            PG8_WAIT_V(8); PG8_WAIT_L(0); PG8_BAR; PG8_MMAG(1, 0, At, B0); PG8_MMAG(1, 1, At, B1); PG8_BAR; PG8_SCHED;
            PG8_LDB(B0, 1, 0); PG8_LDB(B1, 1, 1); PG8_SCHED; PG8_LDA(At, 1, 0); PG8_STAGE(PG8_SA(0, 1), a2 + hstepA, voffA);
            PG8_WAIT_V(8); PG8_WAIT_L(0); PG8_BAR; PG8_MMAG(0, 0, At, B0); PG8_MMAG(0, 1, At, B1); PG8_BAR; PG8_SCHED;
            PG8_LDA(At, 1, 1); PG8_STAGE(PG8_SB(1, 0), b3, voffB); PG8_STAGE(PG8_SB(1, 1), b3 + hstepB, voffB); PG8_STAGE(PG8_SA(1, 0), a3, voffA);
            PG8_WAIT_V(8); PG8_WAIT_L(0); PG8_BAR; PG8_MMAG(1, 0, At, B0); PG8_MMAG(1, 1, At, B1); PG8_BAR; PG8_SCHED;
            } else {
            PG8_LDB(B0, 0, 0); PG8_SCHED; PG8_LDA(At, 0, 0); PG8_STAGE(PG8_SA(1, 1), a1 + hstepA, voffA);
            PG8_WAIT_L(8); PG8_BAR; PG8_WAIT_L(0); PG8_MMAG(0, 0, At, B0); PG8_BAR; PG8_SCHED;
            PG8_LDB(B1, 0, 1); PG8_STAGE(PG8_SB(0, 0), b2, voffB);
            PG8_BAR; PG8_WAIT_L(0); PG8_MMAG(0, 1, At, B1); PG8_BAR;
            PG8_LDA(At, 0, 1); PG8_STAGE(PG8_SA(0, 0), a2, voffA);
            PG8_BAR; PG8_WAIT_L(0); PG8_MMAG(1, 0, At, B0); PG8_BAR; PG8_SCHED;
            PG8_STAGE(PG8_SB(0, 1), b2 + hstepB, voffB);
            PG8_WAIT_V(6); PG8_BAR; PG8_MMAG(1, 1, At, B1); PG8_BAR;
            PG8_LDB(B0, 1, 0); PG8_SCHED; PG8_LDA(At, 1, 0); PG8_STAGE(PG8_SA(0, 1), a2 + hstepA, voffA);
            PG8_WAIT_L(8); PG8_BAR; PG8_WAIT_L(0); PG8_MMAG(0, 0, At, B0); PG8_BAR; PG8_SCHED;
            PG8_LDB(B1, 1, 1); PG8_STAGE(PG8_SB(1, 0), b3, voffB);
            PG8_BAR; PG8_WAIT_L(0); PG8_MMAG(0, 1, At, B1); PG8_BAR;
            PG8_LDA(At, 1, 1); PG8_STAGE(PG8_SA(1, 0), a3, voffA);
            PG8_BAR; PG8_WAIT_L(0); PG8_MMAG(1, 0, At, B0); PG8_BAR; PG8_SCHED;
            PG8_STAGE(PG8_SB(1, 1), b3 + hstepB, voffB);
            PG8_WAIT_V(6); PG8_BAR; PG8_MMAG(1, 1, At, B1); PG8_BAR;
            }
        }
        } else {
        for (int t = 0; t < nt; t += 2) {
            const bool last = (t == nt - 2);
            const char* a1 = cA + (size_t)(t + 1) * kstep;
            const char* a2 = last ? nA : cA + (size_t)(t + 2) * kstep; const char* b2 = last ? nB : cB + (size_t)(t + 2) * kstep;
            const char* a3 = a2 + kstep; const char* b3 = b2 + kstep;
            if (last && has_next) S.a_ready(nxt);
            if constexpr (SP2) {
            PG8_LDB(B0, 0, 0); PG8_LDB(B1, 0, 1); PG8_SCHED; PG8_LDA(At, 0, 0); PG8_STAGE(PG8_SA(1, 1), a1 + hstepA, voffA);
            PG8_WAIT_V(8); PG8_WAIT_L(0); PG8_BAR; PG8_MMA(0, 0, At, B0); PG8_MMA(0, 1, At, B1); PG8_BAR; PG8_SCHED;
            PG8_LDA(At, 0, 1); PG8_STAGE(PG8_SB(0, 0), b2, voffB); PG8_STAGE(PG8_SB(0, 1), b2 + hstepB, voffB); PG8_STAGE(PG8_SA(0, 0), a2, voffA);
            PG8_WAIT_V(8); PG8_WAIT_L(0); PG8_BAR; PG8_MMA(1, 0, At, B0); PG8_MMA(1, 1, At, B1); PG8_BAR; PG8_SCHED;
            PG8_LDB(B0, 1, 0); PG8_LDB(B1, 1, 1); PG8_SCHED; PG8_LDA(At, 1, 0); PG8_STAGE(PG8_SA(0, 1), a2 + hstepA, voffA);
            PG8_WAIT_V(8); PG8_WAIT_L(0); PG8_BAR; PG8_MMA(0, 0, At, B0); PG8_MMA(0, 1, At, B1); PG8_BAR; PG8_SCHED;
            PG8_LDA(At, 1, 1); PG8_STAGE(PG8_SB(1, 0), b3, voffB); PG8_STAGE(PG8_SB(1, 1), b3 + hstepB, voffB); PG8_STAGE(PG8_SA(1, 0), a3, voffA);
            PG8_WAIT_V(8); PG8_WAIT_L(0); PG8_BAR; PG8_MMA(1, 0, At, B0); PG8_MMA(1, 1, At, B1); PG8_BAR; PG8_SCHED;
            } else {
            PG8_LDB(B0, 0, 0); PG8_SCHED; PG8_LDA(At, 0, 0); PG8_STAGE(PG8_SA(1, 1), a1 + hstepA, voffA);
            PG8_WAIT_L(8); PG8_BAR; PG8_WAIT_L(0); PG8_MMA(0, 0, At, B0); PG8_BAR; PG8_SCHED;
            PG8_LDB(B1, 0, 1); PG8_STAGE(PG8_SB(0, 0), b2, voffB);
            PG8_BAR; PG8_WAIT_L(0); PG8_MMA(0, 1, At, B1); PG8_BAR;
            PG8_LDA(At, 0, 1); PG8_STAGE(PG8_SA(0, 0), a2, voffA);
            PG8_BAR; PG8_WAIT_L(0); PG8_MMA(1, 0, At, B0); PG8_BAR; PG8_SCHED;
            PG8_STAGE(PG8_SB(0, 1), b2 + hstepB, voffB);
            PG8_WAIT_V(6); PG8_BAR; PG8_MMA(1, 1, At, B1); PG8_BAR;
            PG8_LDB(B0, 1, 0); PG8_SCHED; PG8_LDA(At, 1, 0); PG8_STAGE(PG8_SA(0, 1), a2 + hstepA, voffA);
            PG8_WAIT_L(8); PG8_BAR; PG8_WAIT_L(0); PG8_MMA(0, 0, At, B0); PG8_BAR; PG8_SCHED;
            PG8_LDB(B1, 1, 1); PG8_STAGE(PG8_SB(1, 0), b3, voffB);
            PG8_BAR; PG8_WAIT_L(0); PG8_MMA(0, 1, At, B1); PG8_BAR;
            PG8_LDA(At, 1, 1); PG8_STAGE(PG8_SA(1, 0), a3, voffA);
            PG8_BAR; PG8_WAIT_L(0); PG8_MMA(1, 0, At, B0); PG8_BAR; PG8_SCHED;
            PG8_STAGE(PG8_SB(1, 1), b3 + hstepB, voffB);
            PG8_WAIT_V(6); PG8_BAR; PG8_MMA(1, 1, At, B1); PG8_BAR;
            }
        }
        }
        if constexpr (ALIGN_EPI) { if (wr == 0) PG8_BAR; }
        if constexpr (!Epi::AFTER_DRAIN) { E(acc, cur, wr, wc, fr, fq); S.done(cur); }
        if (!has_next) break;
#pragma unroll
        for (int a = 0; a < 2; ++a)
#pragma unroll
            for (int b = 0; b < 2; ++b)
#pragma unroll
                for (int m = 0; m < 4; ++m)
#pragma unroll
                    for (int n = 0; n < 2; ++n) acc[a][b][m][n] = (f32x4){0.f, 0.f, 0.f, 0.f};
        cur = nxt; cA = nA; cB = nB; ++ui;
        if constexpr (Sched::PARTIAL) { on0 = cur.rows > wr * 64; on1 = cur.rows > HALF + wr * 64; }
        if constexpr (ALIGN_EPI) { if (wr == 1) PG8_BAR; }
    }
    PG8_WAIT_V(0);
    if constexpr (!ALIGN_EPI) { if (wr == 0) PG8_BAR; }
    PG8_BAR;
    if constexpr (Epi::AFTER_DRAIN) { E.fused(acc, cur, wr, wc, fr, fq, lds, wid, lane); S.done(cur); }
#undef PG8_SA
#undef PG8_SB
#undef PG8_STAGE
#undef PG8_LDA
#undef PG8_LDB
#undef PG8_MMA
#undef PG8_MMAG
#undef PG8_WAIT_V
#undef PG8_WAIT_L
#undef PG8_BAR
#undef PG8_SCHED
}
}
#ifndef PLE_LIGHT
#define PLE_LIGHT 1
#endif
constexpr int NWAVES = 8;
constexpr int S = 8192, DM = 2048, DEPTH = 2;
constexpr int IN_COLS = 3152, LDH = 3328;
constexpr int QW = 1536, KVW = 2048;
constexpr int DFF = 5632, NGU = 2 * DFF, NE = 8, PLE = 256;
constexpr int MAXTILES = 72, XG_ROWS = MAXTILES * 256;
constexpr int H_QA = 0, H_KVA = 512, H_KPE = 768, H_GQ = 832, H_GK = 1088, H_GV = 1344, H_GR = 1856, H_SQ = 2368, H_SK = 2880, H_SV = 3008, H_GLR = 3136;
constexpr float LN_EPS = 1e-5f, RMS_EPS = 1e-6f, ALPHA = 1.4142135623730951f;
constexpr float QSCALE = 0.07216878364870322f * 1.4426950408889634f;

constexpr size_t MiB = 1u << 20;
constexpr size_t WS_CTL = 0, CTL_ZERO_BYTES = 1 * MiB;
constexpr size_t WS_CS = 1 * MiB, WS_SSQ = 3 * MiB, WS_ROUTE = 4 * MiB, WS_GDEC = 5 * MiB, WS_PB = 6 * MiB, WS_XB = 14 * MiB;
constexpr size_t WS_WIN = 46 * MiB, WS_WQB = 72 * MiB, WS_WKVB = 75 * MiB, WS_WOUT = 77 * MiB, WS_WPU = 93 * MiB, WS_WPG = 95 * MiB;
constexpr size_t WS_FGU = 111 * MiB, WS_FD = 155 * MiB, WS_MGU = 177 * MiB, WS_MD = 529 * MiB;
constexpr size_t WS_R1 = 705 * MiB;
constexpr size_t WS_HB = WS_R1, WS_QB = WS_R1 + 52 * MiB, WS_KVB = WS_R1 + 76 * MiB, WS_MIX = WS_R1 + 108 * MiB, WS_GUT = WS_R1 + 140 * MiB, WS_GSP = WS_R1 + 156 * MiB, WS_HMID = WS_R1;
constexpr size_t WS_R2 = 905 * MiB;
constexpr size_t WS_X1F = 1049 * MiB, WS_X1B = 1113 * MiB, WS_PLE = 1145 * MiB, WS_XG = 1209 * MiB, WS_XF = 1281 * MiB, WS_END = 1345 * MiB;
static_assert((size_t)DEPTH * LDH * DM * 2 <= 26 * MiB && (size_t)S * LDH * 2 <= 52 * MiB && (size_t)XG_ROWS * DFF * 2 <= 200 * MiB && (size_t)XG_ROWS * DM * 4 <= 144 * MiB && (size_t)XG_ROWS * DM * 2 <= 72 * MiB, "ws map");
constexpr int CW_TMO = 0, CW_CODE = 1;
constexpr int CW_ECNT = 64;
constexpr int CW_BAR = 4096;
constexpr size_t RT_E = 0, RT_POS = 64 * 1024, RT_W = 128 * 1024, RT_SLOT = 192 * 1024;

constexpr int RING_OFF = 0, RING_BYTES = 131072;
constexpr int TBL = MAXTILES + 24;
constexpr int LDSCTL_OFF = RING_BYTES, MISC_OFF = LDSCTL_OFF + 320, TE_OFF = MISC_OFF + 128;
constexpr int LDS_BYTES = 147456;
static_assert(TE_OFF + 3 * TBL * 4 <= LDS_BYTES, "LDS map");

#define GAS __attribute__((address_space(1)))
#define LAS __attribute__((address_space(3)))
typedef unsigned short bf16;
typedef unsigned v4u __attribute__((ext_vector_type(4)));
typedef unsigned v2u __attribute__((ext_vector_type(2)));
typedef float f32x4 __attribute__((ext_vector_type(4)));
typedef float f32x16 __attribute__((ext_vector_type(16)));
typedef short bf16x8 __attribute__((ext_vector_type(8)));
typedef short s16x4 __attribute__((ext_vector_type(4)));
typedef GAS unsigned gu32;
typedef GAS unsigned long long gu64;
#define RLX_AGENT __ATOMIC_RELAXED, __HIP_MEMORY_SCOPE_AGENT
#define LDS_WAIT() asm volatile("s_waitcnt lgkmcnt(0)" ::: "memory")
#define VM_WAIT() asm volatile("s_waitcnt vmcnt(0)" ::: "memory")
__device__ __forceinline__ float bf2f(unsigned h) { return __builtin_bit_cast(float, h << 16); }
__device__ __forceinline__ unsigned f2bf(float f) { unsigned u = __builtin_bit_cast(unsigned, f); return (u + 0x7fffu + ((u >> 16) & 1u)) >> 16; }
__device__ __forceinline__ unsigned pk2(float lo, float hi) { return f2bf(lo) | (f2bf(hi) << 16); }

#define XB_TMO      128
#define XB_XCNT(j)  (256  + 64 * (j))
#define XB_XSUB(j)  (1280 + 64 * (j))
#define XB_XGEN(j)  (2304 + 64 * (j))
#define XB_TOP      3328
#define XB_TOPGEN   3392
#define XCD_BAR_WORDS 3456
#define XB_SPIN_CAP (1u << 18)

__device__ __forceinline__ unsigned xb_ld(unsigned* p)              { return __hip_atomic_load(p, __ATOMIC_RELAXED, __HIP_MEMORY_SCOPE_AGENT); }
__device__ __forceinline__ unsigned xb_add(unsigned* p, unsigned v) { return __hip_atomic_fetch_add(p, v, __ATOMIC_RELAXED, __HIP_MEMORY_SCOPE_AGENT); }
__device__ __forceinline__ unsigned xb_xcc_id() { return (unsigned)__builtin_amdgcn_s_getreg((3 << 11) | 20) & 0xFu; }
#define XB_SPIN(cond, bar) do { unsigned _sp = 0; while (cond) { __builtin_amdgcn_s_sleep(1); \
    if ((++_sp & 255u) == 0u) { if (xb_ld(&(bar)[XB_TMO])) break; if (_sp > XB_SPIN_CAP) { atomicAdd(&(bar)[XB_TMO], 1u); break; } } } } while (0)

struct XcdBarrier {
    unsigned* bar; unsigned x;
    volatile LAS unsigned* st;
};

__device__ __forceinline__ XcdBarrier xcd_barrier_post(unsigned* bar, volatile LAS unsigned* st) {
    XcdBarrier b; b.bar = bar; b.x = xb_xcc_id(); b.st = st;
    if (threadIdx.x == 0) (void)xb_add(&bar[XB_XCNT(b.x)], 1u);
    return b;
}
__device__ __forceinline__ void xcd_barrier_complete(unsigned* bar, unsigned x, unsigned& nloc, unsigned& nx) {
    const unsigned G = gridDim.x * gridDim.y * gridDim.z;
    unsigned sum, cnt, mine, sp = 0u;
    for (;;) {
        sum = 0u; cnt = 0u; mine = 0u;
#pragma unroll
        for (unsigned j = 0; j < 16; ++j) { const unsigned c = xb_ld(&bar[XB_XCNT(j)]); sum += c; cnt += (c > 0u) ? 1u : 0u; mine = (j == x) ? c : mine; }
        if (sum == G) break;
        __builtin_amdgcn_s_sleep(1);
        if ((++sp & 255u) == 0u) { if (xb_ld(&bar[XB_TMO])) break; if (sp > XB_SPIN_CAP) { atomicAdd(&bar[XB_TMO], 1u); break; } }
    }
    nloc = mine > 0u ? mine : 1u; nx = cnt > 0u ? cnt : 1u;
}

__device__ __forceinline__ void xcd_barrier(const XcdBarrier& b) {
    asm volatile("s_waitcnt vmcnt(0)" ::: "memory");
    __syncthreads();
    if (threadIdx.x == 0) {
        unsigned* bar = b.bar;
        __builtin_amdgcn_s_waitcnt(0);
        unsigned nloc = b.st[0], nx = b.st[1];
        if (nloc == 0u) { xcd_barrier_complete(bar, b.x, nloc, nx); b.st[0] = nloc; b.st[1] = nx; }
        const unsigned old = xb_add(&bar[XB_XSUB(b.x)], 1u);
        const unsigned gen = old / nloc;
        if (old + 1u == (gen + 1u) * nloc) {
            __builtin_amdgcn_fence(__ATOMIC_RELEASE, "agent");
            asm volatile("s_waitcnt vmcnt(0)" ::: "memory");
            const unsigned og = xb_add(&bar[XB_TOP], 1u);
            const unsigned tg = og / nx;
            if (og + 1u == (tg + 1u) * nx) xb_add(&bar[XB_TOPGEN], 1u);
            else XB_SPIN(xb_ld(&bar[XB_TOPGEN]) == tg, bar);
            __builtin_amdgcn_fence(__ATOMIC_ACQUIRE, "agent");
            xb_add(&bar[XB_XGEN(b.x)], 1u);
            asm volatile("s_waitcnt vmcnt(0)" ::: "memory");
        } else {
            XB_SPIN(xb_ld(&bar[XB_XGEN(b.x)]) == gen, bar);
            __builtin_amdgcn_fence(__ATOMIC_ACQUIRE, "agent");
            asm volatile("s_waitcnt vmcnt(0)" ::: "memory");
        }
    }
    __syncthreads();
}

struct Frame {
    LAS unsigned char* lds;
    volatile LAS unsigned* MISC;
    gu32* ctl;
    unsigned char* ws;
    int tid, lane, wave;
    int G, c;
};
__device__ __forceinline__ float wave_sum(float v) {
#pragma unroll
    for (int o = 1; o < 64; o <<= 1) v += __shfl_xor(v, o);
    return v;
}
__device__ __forceinline__ unsigned pk2h(float lo, float hi) { return pg8::cvt_pk_bf16(lo, hi); }

template <int MAP> __device__ __forceinline__ int rowmap(int n) {
    if (MAP == 1) { if (n < 768) return n; if (n < 832) { const int j = n - 768; return 768 + ((j & 31) << 1) + (j >> 5); } if (n < 1856) return n; if (n < 1872) return H_GLR + (n - 1856); return n - 16; }
    if (MAP == 2) { const int hd = n / 192; int j = n - hd * 192; if (j >= 128) { const int jj = j - 128; j = 128 + ((jj & 31) << 1) + (jj >> 5); } return hd * 192 + j; }
    if (MAP == 3) return ((n >> 7) << 8) + (n & 127);
    if (MAP == 4) return ((n >> 7) << 8) + 128 + (n & 127);
    return n;
}
constexpr int P0_PD = 33;
template <int MAP> __device__ __forceinline__ void p0_item(const float* W, int K, int N, bf16* WT, const float* gain, float sc, LAS unsigned* scr, int item, int lane) {
    const int nblk = (N + 127) >> 7, kb = item / nblk, nb = item - kb * nblk, k0 = 64 * kb, n0 = 128 * nb;
    const int g = lane >> 4, n4 = lane & 15;
    f32x4 v[2][16];
#pragma unroll
    for (int hf = 0; hf < 2; ++hf) { const bool nok = (n0 + 64 * hf + 4 * n4) < N;
#pragma unroll
        for (int i = 0; i < 16; ++i) { const int k = 8 * (i >> 1) + 2 * g + (i & 1); v[hf][i] = nok ? __builtin_nontemporal_load((const GAS f32x4*)(W + (size_t)(k0 + k) * N + n0 + 64 * hf + 4 * n4)) : (f32x4){0.f, 0.f, 0.f, 0.f}; } }
    const int c = lane & 7;
#pragma unroll
    for (int hf = 0; hf < 2; ++hf) {
#pragma unroll
        for (int j = 0; j < 8; ++j) { const int k = 8 * j + 2 * g; float s0 = sc, s1 = sc; if (gain) { s0 *= gain[k0 + k]; s1 *= gain[k0 + k + 1]; }
#pragma unroll
            for (int e = 0; e < 4; ++e) scr[(4 * n4 + e) * P0_PD + 4 * j + g] = pk2h(v[hf][2 * j][e] * s0, v[hf][2 * j + 1][e] * s1); }
        LDS_WAIT(); asm volatile("" ::: "memory");
#pragma unroll
        for (int s = 0; s < 8; ++s) { const int nl = 8 * s + (lane >> 3); const LAS unsigned* p = scr + nl * P0_PD + 4 * c;
            v4u o; o.x = p[0]; o.y = p[1]; o.z = p[2]; o.w = p[3];
            if (n0 + 64 * hf + nl < N) *(GAS v4u*)(WT + (size_t)rowmap<MAP>(n0 + 64 * hf + nl) * K + k0 + 8 * c) = o; }
        LDS_WAIT(); asm volatile("" ::: "memory"); }
}
struct In {
    const float *x, *p; const int* pos; const float *w_in, *q_gain, *w_qb, *kv_gain, *w_kvb, *gla_wg, *gla_bg, *gla_ng, *sinks, *relb, *w_out, *ln1g, *ln1b,
        *f_wg, *f_wu, *f_wd, *router, *m_wg, *m_wu, *m_wd, *p_wu, *p_wg, *p_bg, *ln2g, *ln2b;
};
constexpr int I_IN = (DM / 64) * ((IN_COLS + 127) / 128), I_QB = (512 / 64) * (QW / 128), I_KVB = (256 / 64) * (KVW / 128), I_OUT = (DM / 64) * (DM / 128), I_PU = (PLE / 64) * (DM / 128), I_PG = I_OUT;
constexpr int I_GU = (DM / 64) * (DFF / 128), I_D = (DFF / 64) * (DM / 128);
constexpr int I_LAYER = I_IN + I_QB + I_KVB + I_OUT + I_PU + I_PG;
constexpr int NITEMS = DEPTH * I_LAYER + 3 * I_GU + 24 * I_GU;
static_assert(I_D == I_GU, "item counts");
#ifndef BGQ1
#define BGQ1 5
#endif
#ifndef BGQ2
#define BGQ2 5
#endif
#ifndef BGQ3
#define BGQ3 4
#endif
constexpr int HOLE1_WG = 96, HOLE2_WG = 128, HOLE3_WG = 96;
constexpr int HOLE1_N = HOLE1_WG * BGQ1 * 8, HOLE2_N = HOLE2_WG * BGQ2 * 8, HOLE3_N = HOLE3_WG * BGQ3 * 8;
constexpr int N_PRO256 = DEPTH * I_LAYER + 3 * I_GU;
constexpr int N_HOLE0 = N_PRO256 + 16 * I_GU;
static_assert(N_HOLE0 + HOLE1_N + HOLE2_N + HOLE3_N >= NITEMS, "the holes must cover the MoE down weights");
constexpr int TRK_SLOTS = 22, TRK_PER_LAYER = TRK_SLOTS * 256 * NWAVES;
static_assert(DEPTH * TRK_PER_LAYER == 4 * 16 * I_GU && DEPTH == 2, "trickle list");
__device__ __forceinline__ void p0_dispatch(const In& I, unsigned char* ws, LAS unsigned* scr, int it, int lane) {
        int r = it;
        if (r < DEPTH * I_LAYER) {
            const int l = r / I_LAYER; r -= l * I_LAYER;
            if (r < I_IN) { p0_item<1>(I.w_in + (size_t)l * DM * IN_COLS, DM, IN_COLS, (bf16*)(ws + WS_WIN) + (size_t)l * LDH * DM, nullptr, 1.f, scr, r, lane); return; } r -= I_IN;
            if (r < I_QB) { p0_item<2>(I.w_qb + (size_t)l * 512 * QW, 512, QW, (bf16*)(ws + WS_WQB) + (size_t)l * QW * 512, I.q_gain + l * 512, QSCALE, scr, r, lane); return; } r -= I_QB;
            if (r < I_KVB) { p0_item<0>(I.w_kvb + (size_t)l * 256 * KVW, 256, KVW, (bf16*)(ws + WS_WKVB) + (size_t)l * KVW * 256, I.kv_gain + l * 256, 1.f, scr, r, lane); return; } r -= I_KVB;
            if (r < I_OUT) { p0_item<0>(I.w_out + (size_t)l * DM * DM, DM, DM, (bf16*)(ws + WS_WOUT) + (size_t)l * DM * DM, nullptr, 1.f, scr, r, lane); return; } r -= I_OUT;
            if (r < I_PU) { p0_item<0>(I.p_wu + (size_t)l * PLE * DM, PLE, DM, (bf16*)(ws + WS_WPU) + (size_t)l * DM * PLE, nullptr, 1.f, scr, r, lane); return; } r -= I_PU;
            p0_item<0>(I.p_wg + (size_t)l * DM * DM, DM, DM, (bf16*)(ws + WS_WPG) + (size_t)l * DM * DM, nullptr, 1.f, scr, r, lane); return;
        }
        r -= DEPTH * I_LAYER;
        if (r < I_GU) { p0_item<3>(I.f_wg, DM, DFF, (bf16*)(ws + WS_FGU), nullptr, 1.f, scr, r, lane); return; } r -= I_GU;
        if (r < I_GU) { p0_item<4>(I.f_wu, DM, DFF, (bf16*)(ws + WS_FGU), nullptr, 1.f, scr, r, lane); return; } r -= I_GU;
        if (r < I_D) { p0_item<0>(I.f_wd, DFF, DM, (bf16*)(ws + WS_FD), nullptr, 1.f, scr, r, lane); return; } r -= I_D;
        if (r < 16 * I_GU) { const int e = r / (2 * I_GU); r -= e * 2 * I_GU;
          if (r < I_GU) { p0_item<3>(I.m_wg + (size_t)e * DM * DFF, DM, DFF, (bf16*)(ws + WS_MGU) + (size_t)e * NGU * DM, nullptr, 1.f, scr, r, lane); return; } r -= I_GU;
          p0_item<4>(I.m_wu + (size_t)e * DM * DFF, DM, DFF, (bf16*)(ws + WS_MGU) + (size_t)e * NGU * DM, nullptr, 1.f, scr, r, lane); return; }
        r -= 16 * I_GU;
        { const int e = r / I_GU; r -= e * I_GU;
          p0_item<0>(I.m_wd + (size_t)e * DFF * DM, DFF, DM, (bf16*)(ws + WS_MD) + (size_t)e * DM * DFF, nullptr, 1.f, scr, r, lane); }
}
__device__ __forceinline__ void bg_convert(Frame& F, const In& I, int first, int rank, int nw, int q) {
    LAS unsigned* scr = (LAS unsigned*)(F.lds + RING_OFF + F.wave * 16384);
    for (int b = 0; b < q; ++b) { const int it = first + (b * nw + rank) * 8 + F.wave; if (it < NITEMS) p0_dispatch(I, F.ws, scr, it, F.lane); }
    __syncthreads();
}
__device__ __forceinline__ void p0_prologue(Frame& F, const In& I) {
    LAS unsigned* scr = (LAS unsigned*)(F.lds + RING_OFF + F.wave * 16384);
    const int gw = F.c * NWAVES + F.wave, NGW = F.G * NWAVES;
    unsigned char* ws = F.ws;
    const int npro = (F.G == 256) ? N_PRO256 : NITEMS;
    for (int it = gw; it < npro; it += NGW) p0_dispatch(I, ws, scr, it, F.lane);
    const int gt = F.c * (NWAVES * 64) + F.tid, NGT = F.G * NWAVES * 64;
    { const GAS f32x4* xs = (const GAS f32x4*)I.x; GAS v4u* xd = (GAS v4u*)(ws + WS_XB);
      for (int i = gt; i < S * DM / 8; i += NGT) { const f32x4 a = __builtin_nontemporal_load(xs + 2 * i), b = __builtin_nontemporal_load(xs + 2 * i + 1); v4u o; o.x = pk2h(a[0], a[1]); o.y = pk2h(a[2], a[3]); o.z = pk2h(b[0], b[1]); o.w = pk2h(b[2], b[3]); xd[i] = o; }
      const GAS f32x4* ps = (const GAS f32x4*)I.p; GAS v4u* pd = (GAS v4u*)(ws + WS_PB);
      for (int i = gt; i < DEPTH * S * PLE / 8; i += NGT) { const f32x4 a = __builtin_nontemporal_load(ps + 2 * i), b = __builtin_nontemporal_load(ps + 2 * i + 1); v4u o; o.x = pk2h(a[0], a[1]); o.y = pk2h(a[2], a[3]); o.z = pk2h(b[0], b[1]); o.w = pk2h(b[2], b[3]); pd[i] = o; } }
    { float* cs = (float*)(ws + WS_CS);
      for (int i = gt; i < S * 32; i += NGT) { const int t = i >> 5, j = i & 31;
          const float inv = (float)exp2(-(double)j * (13.287712379549449 / 32.0));
          const float ang = (float)I.pos[t] * inv;
          double sn, cn; sincos((double)ang, &sn, &cn);
          cs[(size_t)t * 64 + j] = (float)cn; cs[(size_t)t * 64 + 32 + j] = (float)sn; } }
}

__device__ __forceinline__ f32x4 mfma16(bf16x8 a, bf16x8 b, f32x4 c) { return __builtin_amdgcn_mfma_f32_16x16x32_bf16(a, b, c, 0, 0, 0); }
__device__ __forceinline__ f32x16 mfma32(bf16x8 a, bf16x8 b, f32x16 c) { return __builtin_amdgcn_mfma_f32_32x32x16_bf16(a, b, c, 0, 0, 0); }
__device__ __forceinline__ s16x4 tr_read(const LAS bf16* p) { return __builtin_bit_cast(s16x4, __builtin_amdgcn_ds_read_tr16_b64_v4i16((LAS s16x4*)p)); }
__device__ __forceinline__ int crow(int r, int hi) { return (r & 3) + 8 * (r >> 2) + 4 * hi; }
__device__ __forceinline__ bf16x8 pack8f(float a0, float a1, float a2, float a3, float a4, float a5, float a6, float a7) {
    v4u w; w.x = pk2h(a0, a1); w.y = pk2h(a2, a3); w.z = pk2h(a4, a5); w.w = pk2h(a6, a7); return __builtin_bit_cast(bf16x8, w); }

constexpr int SW_KP = 72, SW_VP = 80;
__device__ __forceinline__ void swa_unit(Frame& F, int n, int hq, const bf16* HB, bf16* MIX, const float* sinks, const float* relb) {
    LAS bf16* Ks = (LAS bf16*)(F.lds + RING_OFF); LAS bf16* Vs = Ks + 256 * SW_KP; LAS float* bias = (LAS float*)(Vs + 256 * SW_VP);
    const int tid = F.tid, lane = F.lane, w = F.wave, hk = hq >> 2;
    const int q = lane & 15, kq = lane >> 4, qi = 16 * w + q; const size_t tq = (size_t)n * 128 + qi;
    bf16x8 qf[2];
#pragma unroll
    for (int ks = 0; ks < 2; ++ks) qf[ks] = *(const GAS bf16x8*)(HB + tq * LDH + H_SQ + hq * 64 + 32 * ks + 8 * kq);
#pragma unroll
    for (int i = 0; i < 4; ++i) { const int c = tid + 512 * i, row = c >> 3, ch = c & 7, tk = (n - 1) * 128 + row;
        v4u kv = (v4u){0u, 0u, 0u, 0u}, vv = (v4u){0u, 0u, 0u, 0u};
        if (tk >= 0) { kv = *(const GAS v4u*)(HB + (size_t)tk * LDH + H_SK + hk * 64 + ch * 8); vv = *(const GAS v4u*)(HB + (size_t)tk * LDH + H_SV + hk * 64 + ch * 8); }
        *(LAS v4u*)(Ks + row * SW_KP + ch * 8) = kv; *(LAS v4u*)(Vs + row * SW_VP + ch * 8) = vv; }
    if (tid < 128) { const int d = tid; int b;
        if (d < 16) b = d; else { const float lg = logf((float)d / 16.0f) / 2.0794415416798357f * 16.0f; b = 16 + (int)lg; if (b > 31) b = 31; }
        bias[d] = relb[b * 8 + hq]; }
    __syncthreads();
    f32x4 s[16];
#pragma unroll
    for (int blk = 0; blk < 16; ++blk) { f32x4 a = (f32x4){0.f, 0.f, 0.f, 0.f};
#pragma unroll
        for (int ks = 0; ks < 2; ++ks) { const bf16x8 kf = *(const LAS bf16x8*)(Ks + (16 * blk + q) * SW_KP + 32 * ks + 8 * kq); a = mfma16(kf, qf[ks], a); }
        s[blk] = a; }
    const float sink = sinks[hq]; float mx = sink;
#pragma unroll
    for (int blk = 0; blk < 16; ++blk)
#pragma unroll
        for (int i = 0; i < 4; ++i) { const int kj = 16 * blk + 4 * kq + i, dist = qi + 128 - kj; const bool valid = (dist >= 0) && (dist < 128) && (n > 0 || kj >= 128);
            const float v = valid ? s[blk][i] * 0.125f + bias[dist & 127] : -1e30f; s[blk][i] = v; mx = fmaxf(mx, v); }
    mx = fmaxf(mx, __shfl_xor(mx, 16)); mx = fmaxf(mx, __shfl_xor(mx, 32));
    float sum = 0.f;
#pragma unroll
    for (int blk = 0; blk < 16; ++blk)
#pragma unroll
        for (int i = 0; i < 4; ++i) { const float p = (s[blk][i] > -1e29f) ? __expf(s[blk][i] - mx) : 0.f; s[blk][i] = p; sum += p; }
    sum += __shfl_xor(sum, 16); sum += __shfl_xor(sum, 32);
    const float inv = 1.0f / (sum + __expf(sink - mx));
    f32x4 o[4];
#pragma unroll
    for (int db = 0; db < 4; ++db) o[db] = (f32x4){0.f, 0.f, 0.f, 0.f};
#pragma unroll
    for (int kk = 0; kk < 8; ++kk) {
        const bf16x8 pf = pack8f(s[2 * kk][0] * inv, s[2 * kk][1] * inv, s[2 * kk][2] * inv, s[2 * kk][3] * inv, s[2 * kk + 1][0] * inv, s[2 * kk + 1][1] * inv, s[2 * kk + 1][2] * inv, s[2 * kk + 1][3] * inv);
#pragma unroll
        for (int db = 0; db < 4; ++db) { const LAS bf16* vp = Vs + (32 * kk + 4 * kq + (q >> 2)) * SW_VP + 16 * db + 4 * (q & 3);
            const s16x4 lo = tr_read(vp), hh = tr_read(vp + 16 * SW_VP);
            o[db] = mfma16((bf16x8){lo[0], lo[1], lo[2], lo[3], hh[0], hh[1], hh[2], hh[3]}, pf, o[db]); } }
#pragma unroll
    for (int db = 0; db < 4; ++db) { v2u ov; ov.x = pk2h(o[db][0], o[db][1]); ov.y = pk2h(o[db][2], o[db][3]);
        *(GAS v2u*)(MIX + tq * DM + 1536 + hq * 64 + 16 * db + 4 * kq) = ov; }
    __syncthreads();
}

constexpr int GP = 72;
constexpr int GVP = 144, GKP = 80;
__device__ __forceinline__ bf16x8 gla_trfrag(const LAS bf16* base, int pitch, int j0, int c0, int fr) {
    const LAS bf16* p = base + (j0 + (fr >> 2)) * pitch + c0 + 4 * (fr & 3); const s16x4 lo = tr_read(p), hh = tr_read(p + 4 * pitch);
    return (bf16x8){lo[0], lo[1], lo[2], lo[3], hh[0], hh[1], hh[2], hh[3]}; }
constexpr int GL_GLR = 0, GL_WG = 4096, GL_BG = 8192, GL_B = 8704, GL_QT = 25344, GL_KT = 34560, GL_KDT = 43776, GL_VT = 52992, GL_SPT = 71424, GL_PP = 89856, GL_END = 99072, GL_OO = 0;
template <int STAGE> __device__ __forceinline__ void gla_unit(Frame& F, int c, int h, const bf16* HB, const float* wg, const float* bg, float* UT, float* DEC, const bf16* SPT, const float* ng, bf16* MIX) {
    LAS unsigned char* L = F.lds + RING_OFF;
    LAS float* glr = (LAS float*)(L + GL_GLR); LAS float* Wg = (LAS float*)(L + GL_WG); LAS float* Bg = (LAS float*)(L + GL_BG); LAS float* B = (LAS float*)(L + GL_B);
    LAS bf16* QT = (LAS bf16*)(L + GL_QT); LAS bf16* KT = (LAS bf16*)(L + GL_KT); LAS bf16* KD = (LAS bf16*)(L + GL_QT)  ; LAS bf16* VR = (LAS bf16*)(L + GL_VT);
    LAS bf16* SP = (LAS bf16*)(L + GL_SPT); LAS bf16* PP = (LAS bf16*)(L + GL_PP); LAS float* OO = (LAS float*)(L + GL_OO);
    const int tid = F.tid, lane = F.lane, w = F.wave; const size_t t0 = (size_t)c * 64;
    const v4u kraw = *(const GAS v4u*)(HB + (t0 + (tid >> 3)) * LDH + H_GK + h * 64 + (tid & 7) * 8);
    v4u qraw = (v4u){0u, 0u, 0u, 0u}; if (STAGE == 3) qraw = *(const GAS v4u*)(HB + (t0 + (tid >> 3)) * LDH + H_GQ + h * 64 + (tid & 7) * 8);
    for (int i = tid; i < 1024; i += 512) { const int r = i >> 4, k = i & 15; glr[i] = bf2f(HB[(t0 + r) * LDH + H_GLR + k]); }
    for (int i = tid; i < 1024; i += 512) { const int r = i >> 6, d = i & 63; Wg[i] = wg[r * 256 + h * 64 + d]; }
    if (tid < 64) Bg[tid] = bg[h * 64 + tid];
#pragma unroll
    for (int i = 0; i < 2; ++i) { const int cc = tid + 512 * i, row = cc >> 4, ch = cc & 15; const v4u vv = *(const GAS v4u*)(HB + (t0 + row) * LDH + H_GV + h * 128 + ch * 8);
        *(LAS v4u*)(VR + row * GVP + ch * 8) = vv; }
    if (STAGE == 3) {
#pragma unroll
        for (int i = 0; i < 2; ++i) { const int cc = tid + 512 * i, row = cc >> 3, ch = cc & 7; *(LAS v4u*)(SP + row * GP + ch * 8) = *(const GAS v4u*)(SPT + ((size_t)(c * 4 + h) * 128 + row) * 64 + ch * 8); } }
    __syncthreads();
#pragma unroll
    for (int i = 0; i < 8; ++i) { const int idx = tid + 512 * i, r = idx >> 6, d = idx & 63; float z = Bg[d];
#pragma unroll
        for (int k = 0; k < 16; ++k) z += glr[r * 16 + k] * Wg[k * 64 + d];
        const float ls = fminf(z, 0.f) - 0.6931471805599453f * __builtin_amdgcn_logf(1.0f + __builtin_amdgcn_exp2f(-1.4426950408889634f * fabsf(z))); B[r * 65 + d] = ls * (1.0f / 16.0f); }
    __syncthreads();
    { const int col = tid & 63, seg = tid >> 6; LAS float* SEG = glr;
      float v[8]; float a = 0.f;
#pragma unroll
      for (int k = 0; k < 8; ++k) { a += B[(8 * seg + k) * 65 + col]; v[k] = a; }
      SEG[seg * 64 + col] = a;
      __syncthreads();
      float off = 0.f;
#pragma unroll
      for (int q = 0; q < 7; ++q) off += (q < seg) ? SEG[q * 64 + col] : 0.f;
#pragma unroll
      for (int k = 0; k < 8; ++k) B[(8 * seg + k) * 65 + col] = v[k] + off; }
    __syncthreads();
    { const int i = tid >> 3, d0 = (tid & 7) * 8;
      if (STAGE == 1) {
          float kd[8];
#pragma unroll
          for (int e = 0; e < 8; ++e) { const float kv = bf2f((kraw[e >> 1] >> (16 * (e & 1))) & 0xffffu); kd[e] = kv * __expf(B[63 * 65 + d0 + e] - B[i * 65 + d0 + e]); }
          *(LAS bf16x8*)(KD + i * GKP + d0) = pack8f(kd[0], kd[1], kd[2], kd[3], kd[4], kd[5], kd[6], kd[7]);
          if (i == 63) {
#pragma unroll
              for (int e = 0; e < 8; ++e) DEC[(size_t)(c * 4 + h) * 64 + d0 + e] = __expf(B[63 * 65 + d0 + e]); }
      } else {
          float qv[8], kv[8];
#pragma unroll
          for (int e = 0; e < 8; ++e) { const float b = B[i * 65 + d0 + e]; qv[e] = bf2f((qraw[e >> 1] >> (16 * (e & 1))) & 0xffffu) * 0.125f * __expf(b); kv[e] = bf2f((kraw[e >> 1] >> (16 * (e & 1))) & 0xffffu) * __expf(-b); }
          *(LAS bf16x8*)(QT + i * GP + d0) = pack8f(qv[0], qv[1], qv[2], qv[3], qv[4], qv[5], qv[6], qv[7]);
          *(LAS bf16x8*)(KT + i * GP + d0) = pack8f(kv[0], kv[1], kv[2], kv[3], kv[4], kv[5], kv[6], kv[7]); } }
    __syncthreads();
    const int fr = lane & 15, fq = lane >> 4, rb = w & 3, cb = w >> 2;
    if (STAGE == 1) {
        bf16x8 af[2];
#pragma unroll
        for (int ks = 0; ks < 2; ++ks) af[ks] = gla_trfrag(KD, GKP, 32 * ks + 8 * fq, 16 * rb, fr);
#pragma unroll
        for (int eb = 0; eb < 4; ++eb) { f32x4 a = (f32x4){0.f, 0.f, 0.f, 0.f}; const int e0 = 16 * (4 * cb + eb);
#pragma unroll
            for (int ks = 0; ks < 2; ++ks) { const bf16x8 bfr = gla_trfrag(VR, GVP, 32 * ks + 8 * fq, e0, fr); a = mfma16(af[ks], bfr, a); }
            *(GAS f32x4*)(UT + ((size_t)(c * 4 + h) * 128 + e0 + fr) * 64 + 16 * rb + 4 * fq) = a; }
        __syncthreads();
    } else {
        { bf16x8 af[2];
#pragma unroll
          for (int ks = 0; ks < 2; ++ks) af[ks] = *(const LAS bf16x8*)(QT + (16 * rb + fr) * GP + 32 * ks + 8 * fq);
#pragma unroll
          for (int jb = 0; jb < 2; ++jb) { f32x4 a = (f32x4){0.f, 0.f, 0.f, 0.f}; const int j0 = 16 * (2 * cb + jb);
#pragma unroll
              for (int ks = 0; ks < 2; ++ks) { const bf16x8 bfr = *(const LAS bf16x8*)(KT + (j0 + fr) * GP + 32 * ks + 8 * fq); a = mfma16(af[ks], bfr, a); }
#pragma unroll
              for (int i = 0; i < 4; ++i) { const int ii = 16 * rb + 4 * fq + i, jj = j0 + fr; PP[ii * GP + jj] = (bf16)(pk2h(jj <= ii ? a[i] : 0.f, 0.f) & 0xffffu); } } }
        __syncthreads();
        f32x4 o[4];
        { bf16x8 pf[2], qf[2];
#pragma unroll
          for (int ks = 0; ks < 2; ++ks) { pf[ks] = *(const LAS bf16x8*)(PP + (16 * rb + fr) * GP + 32 * ks + 8 * fq); qf[ks] = *(const LAS bf16x8*)(QT + (16 * rb + fr) * GP + 32 * ks + 8 * fq); }
#pragma unroll
          for (int eb = 0; eb < 4; ++eb) { f32x4 a = (f32x4){0.f, 0.f, 0.f, 0.f}; const int e0 = 16 * (4 * cb + eb);
#pragma unroll
              for (int ks = 0; ks < 2; ++ks) { const bf16x8 vb = gla_trfrag(VR, GVP, 32 * ks + 8 * fq, e0, fr); a = mfma16(pf[ks], vb, a);
                  const bf16x8 sb = *(const LAS bf16x8*)(SP + (e0 + fr) * GP + 32 * ks + 8 * fq); a = mfma16(qf[ks], sb, a); }
              o[eb] = a; } }
        __syncthreads();
#pragma unroll
        for (int eb = 0; eb < 4; ++eb)
#pragma unroll
            for (int i = 0; i < 4; ++i) OO[(16 * rb + 4 * fq + i) * 132 + 16 * (4 * cb + eb) + fr] = o[eb][i];
        __syncthreads();
        { const int i = tid >> 3, e0 = (tid & 7) * 16; float v[16]; float ss = 0.f;
#pragma unroll
          for (int e = 0; e < 16; ++e) { v[e] = OO[i * 132 + e0 + e]; ss += v[e] * v[e]; }
          ss += __shfl_xor(ss, 1); ss += __shfl_xor(ss, 2); ss += __shfl_xor(ss, 4);
          const float rinv = 1.0f / sqrtf(ss * (1.0f / 128.0f) + RMS_EPS);
          const bf16* rp = HB + (t0 + i) * LDH + H_GR + h * 128 + e0; const float* gp = ng + h * 128 + e0;
          const v4u r0 = *(const GAS v4u*)rp, r1 = *(const GAS v4u*)(rp + 8);
          float ov[16];
#pragma unroll
          for (int e = 0; e < 16; ++e) { const unsigned rw = (e < 8 ? r0[e >> 1] : r1[(e - 8) >> 1]); const float rv = bf2f((rw >> (16 * (e & 1))) & 0xffffu);
              ov[e] = v[e] * rinv * gp[e] * (rv * pg8::fast_sigmoid(rv)); }
          bf16* op = MIX + (t0 + i) * DM + 1024 + h * 128 + e0;
          *(GAS bf16x8*)op = pack8f(ov[0], ov[1], ov[2], ov[3], ov[4], ov[5], ov[6], ov[7]);
          *(GAS bf16x8*)(op + 8) = pack8f(ov[8], ov[9], ov[10], ov[11], ov[12], ov[13], ov[14], ov[15]); }
        __syncthreads();
    }
}
__device__ __forceinline__ void gla_scan(Frame& F, const float* UT, const float* DEC, bf16* SPT) {
    const int gt = F.c * (NWAVES * 64) + F.tid; if (gt >= 4 * 128 * 64) return;
    const int d = gt & 63, he = gt >> 6, h = he >> 7;
    float s = 0.f;
#pragma unroll 8
    for (int c = 0; c < 128; ++c) { const size_t o = ((size_t)c * 512 + he) * 64 + d; SPT[o] = (bf16)(pk2h(s, 0.f) & 0xffffu); s = DEC[(size_t)(c * 4 + h) * 64 + d] * s + UT[o]; }
}

constexpr int ML_KP = 200, ML_VP = 160;
constexpr int ML_KB = 64 * ML_KP * 2, ML_VB = 64 * ML_VP * 2, ML_STAGE = ML_KB + ML_VB;
static_assert(2 * ML_STAGE <= RING_BYTES && 4 * 64 * 64 * 4 + 4 * 2 * 64 * 4 <= 2 * ML_STAGE, "MLA LDS");
__device__ __forceinline__ void trk_decode(int mi, const float* m_wg, const float* m_wu, bf16* MGU, const float*& src, bf16*& dst) {
    const int it = mi >> 2, qn = mi & 3, e = it / (2 * I_GU), r = it - e * 2 * I_GU, up = r >= I_GU ? 1 : 0, idx = r - up * I_GU, kb = idx / 44, nb = idx - kb * 44;
    src = (up ? m_wu : m_wg) + (size_t)e * DM * DFF + (size_t)(64 * kb) * DFF + 128 * nb + 32 * qn;
    dst = MGU + (size_t)e * NGU * DM + (size_t)(256 * nb + 128 * up + 32 * qn) * DM + 64 * kb;
}
__device__ __forceinline__ void mla_unit(Frame& F, int h, int qb, const bf16* QB, const bf16* KVB, const bf16* HB, bf16* MIX, const int g0, const int trk, const float* m_wg, const float* m_wu, bf16* MGU) {
    LAS unsigned char* L = F.lds + RING_OFF;
    int tid_ = F.tid; asm volatile("" : "+v"(tid_));
    const int tid = tid_, lane = tid & 63, w = F.wave, rg = w & 3, kh = w >> 2, r32 = lane & 31, hi = lane >> 5;
    const int q0 = 128 * qb, NT = 2 * qb + 2, qabs = q0 + 32 * rg + r32;
    bf16x8 qf[12];
    { const bf16* qp = QB + (size_t)qabs * QW + h * 192 + 8 * hi;
#pragma unroll
      for (int ks = 0; ks < 12; ++ks) qf[ks] = *(const GAS bf16x8*)(qp + 16 * ks); }
    unsigned doff[6]; bool dpe[6];
#pragma unroll
    for (int i = 0; i < 6; ++i) { const int jn = w + 8 * i;
        if (jn < 25) { const int c = 64 * jn + lane, row = c / 25, ch = c - 25 * row;
            dpe[i] = (ch >= 16 && ch < 24);
            doff[i] = dpe[i] ? (unsigned)(row * LDH + H_KPE + (ch - 16) * 8) * 2u : (unsigned)(row * KVW + h * 256 + (ch < 16 ? ch : 0) * 8) * 2u; }
        else { const int c = 64 * (jn - 25) + lane, row = c / 20, ch = c - 20 * row;
            dpe[i] = false; doff[i] = (unsigned)(row * KVW + h * 256 + 128 + (ch < 16 ? ch : 0) * 8) * 2u; } }
#define ML_DMA(t, b) do { const char* kb_ = (const char*)KVB + (size_t)(t) * (64 * KVW * 2); const char* pb_ = (const char*)HB + (size_t)(t) * (64 * LDH * 2); \
        _Pragma("unroll") for (int i_ = 0; i_ < 6; ++i_) { const int jn_ = w + 8 * i_; if (jn_ < 45) { const char* g_ = (dpe[i_] ? pb_ : kb_) + doff[i_]; \
            __builtin_amdgcn_global_load_lds((const unsigned*)g_, (LAS unsigned*)(L + (b) * ML_STAGE + jn_ * 1024), 16, 0, 0); } } } while (0)
    ML_DMA(0, 0);
    asm volatile("s_waitcnt vmcnt(0)" ::: "memory");
    __syncthreads();
    float m = -60000.f, l = 0.f; f32x16 o[4];
#pragma unroll
    for (int db = 0; db < 4; ++db)
#pragma unroll
        for (int r = 0; r < 16; ++r) o[db][r] = 0.f;
    const int li = lane & 15, trow = li >> 2, tcol = 16 * ((lane >> 4) & 1) + 4 * (li & 3);
    int gph = g0 % 6, sl = g0 / 6; f32x4 tv[8];
#pragma unroll
    for (int i = 0; i < 8; ++i) tv[i] = (f32x4){0.f, 0.f, 0.f, 0.f};
    const int tg8 = lane >> 3, tc = lane & 7;
    for (int t = 0; t < NT; ++t) {
        const bool more = (t + 1 < NT);
        if (trk >= 0 && gph == 1) { const float* src; bf16* dst; trk_decode(trk + sl * (256 * NWAVES), m_wg, m_wu, MGU, src, dst);
            LAS unsigned* scr = (LAS unsigned*)(L + 2 * ML_STAGE + w * (32 * 33 * 4));
#pragma unroll
            for (int j = 0; j < 4; ++j)
#pragma unroll
                for (int e = 0; e < 4; ++e) scr[(4 * tc + e) * 33 + tg8 + 8 * j] = pk2h(tv[2 * j][e], tv[2 * j + 1][e]);
            LDS_WAIT(); asm volatile("" ::: "memory");
#pragma unroll
            for (int s4 = 0; s4 < 4; ++s4) { const int nl = 8 * s4 + tg8; const LAS unsigned* p = scr + nl * 33 + 4 * tc;
                v4u o; o.x = p[0]; o.y = p[1]; o.z = p[2]; o.w = p[3];
                *(GAS v4u*)(dst + (size_t)nl * DM + 8 * tc) = o; }
            LDS_WAIT(); asm volatile("" ::: "memory"); }
        if (trk >= 0 && gph == 0) { const float* src; bf16* dst; trk_decode(trk + sl * (256 * NWAVES), m_wg, m_wu, MGU, src, dst);
#pragma unroll
            for (int i = 0; i < 8; ++i) tv[i] = __builtin_nontemporal_load((const GAS f32x4*)(src + (size_t)(2 * tg8 + (i & 1) + 16 * (i >> 1)) * DFF + 4 * tc)); }
        if (++gph == 6) { gph = 0; ++sl; }
        if (more) ML_DMA(t + 1, (t + 1) & 1);
        const LAS bf16* Kb = (const LAS bf16*)(L + (t & 1) * ML_STAGE); const LAS bf16* Vb = (const LAS bf16*)(L + (t & 1) * ML_STAGE + ML_KB);
        f32x16 p;
#pragma unroll
        for (int r = 0; r < 16; ++r) p[r] = 0.f;
        { const LAS bf16* kp = Kb + (32 * kh + r32) * ML_KP + 8 * hi; bf16x8 kf[12];
#pragma unroll
          for (int ks = 0; ks < 12; ++ks) kf[ks] = *(const LAS bf16x8*)(kp + 16 * ks);
          __builtin_amdgcn_sched_barrier(0);
#pragma unroll
          for (int ks = 0; ks < 12; ++ks) p = mfma32(kf[ks], qf[ks], p); }
        if (t >= NT - 2) { const int kb = 64 * t + 32 * kh;
#pragma unroll
            for (int r = 0; r < 16; ++r) if (kb + crow(r, hi) > qabs) p[r] = -1e30f; }
        float tm = p[0];
#pragma unroll
        for (int r = 1; r < 16; ++r) tm = fmaxf(tm, p[r]);
        { float sa = tm, sb = tm;
          asm volatile("s_nop 1\n\tv_permlane32_swap_b32_e32 %0, %1\n\ts_nop 1\n\tv_max_f32_e32 %0, %0, %1\n\ts_nop 0" : "+v"(sa), "+v"(sb));
          tm = sa; }
        const float mn = fmaxf(m, tm), alpha = __builtin_amdgcn_exp2f(m - mn);
        float rs = 0.f;
#pragma unroll
        for (int r = 0; r < 16; ++r) { const float e = __builtin_amdgcn_exp2f(p[r] - mn); p[r] = e; rs += e; }
        { float sa = rs, sb = rs;
          asm volatile("s_nop 1\n\tv_permlane32_swap_b32_e32 %0, %1\n\ts_nop 1\n\tv_add_f32_e32 %0, %0, %1\n\ts_nop 0" : "+v"(sa), "+v"(sb));
          rs = sa; }
        l = l * alpha + rs; m = mn;
        if (__any(alpha != 1.0f)) {
#pragma unroll
            for (int db = 0; db < 4; ++db)
#pragma unroll
                for (int r = 0; r < 16; ++r) o[db][r] *= alpha; }
        bf16x8 pf[2];
        pf[0] = pack8f(p[0], p[1], p[2], p[3], p[4], p[5], p[6], p[7]); pf[1] = pack8f(p[8], p[9], p[10], p[11], p[12], p[13], p[14], p[15]);
        { s16x4 vlo[2][4], vhh[2][4];
#pragma unroll
          for (int s = 0; s < 2; ++s) { const LAS bf16* vp = Vb + (32 * kh + 16 * s + 4 * hi + trow) * ML_VP + tcol;
#pragma unroll
              for (int db = 0; db < 4; ++db) { vlo[s][db] = tr_read(vp + 32 * db); vhh[s][db] = tr_read(vp + 8 * ML_VP + 32 * db); } }
          __builtin_amdgcn_sched_barrier(0);
#pragma unroll
          for (int s = 0; s < 2; ++s)
#pragma unroll
              for (int db = 0; db < 4; ++db) { const bf16x8 vf = (bf16x8){vlo[s][db][0], vlo[s][db][1], vlo[s][db][2], vlo[s][db][3], vhh[s][db][0], vhh[s][db][1], vhh[s][db][2], vhh[s][db][3]};
                  o[db] = mfma32(vf, pf[s], o[db]); } }
        asm volatile("s_waitcnt vmcnt(0)" ::: "memory");
        __syncthreads();
    }
#undef ML_DMA
    LAS float* MS = (LAS float*)L; LAS float* ML = (LAS float*)(L + 4 * 64 * 64 * 4);
    if (kh == 1) {
#pragma unroll
        for (int db = 0; db < 4; ++db)
#pragma unroll
            for (int r = 0; r < 16; ++r) MS[(rg * 64 + db * 16 + r) * 64 + lane] = o[db][r];
        ML[(rg * 2 + 0) * 64 + lane] = m; ML[(rg * 2 + 1) * 64 + lane] = l; }
    __syncthreads();
    if (kh == 0) {
        const float m1 = ML[(rg * 2 + 0) * 64 + lane], l1 = ML[(rg * 2 + 1) * 64 + lane];
        const float mt = fmaxf(m, m1), a0 = __builtin_amdgcn_exp2f(m - mt), a1 = __builtin_amdgcn_exp2f(m1 - mt);
        const float inv = 1.0f / (l * a0 + l1 * a1), w0 = a0 * inv, w1 = a1 * inv;
        bf16* op = MIX + (size_t)qabs * DM + h * 128 + 4 * hi;
#pragma unroll
        for (int db = 0; db < 4; ++db)
#pragma unroll
            for (int g = 0; g < 4; ++g) { float v[4];
#pragma unroll
                for (int e = 0; e < 4; ++e) { const int r = 4 * g + e; v[e] = o[db][r] * w0 + MS[(rg * 64 + db * 16 + r) * 64 + lane] * w1; }
                v2u ov; ov.x = pk2h(v[0], v[1]); ov.y = pk2h(v[2], v[3]); *(GAS v2u*)(op + 32 * db + 8 * g) = ov; } }
    __syncthreads();
}

__device__ __forceinline__ f32x4 ld4bf(const bf16* p) { const v2u r = __builtin_nontemporal_load((const GAS v2u*)p);     return (f32x4){__builtin_bit_cast(float, r.x << 16), __builtin_bit_cast(float, r.x & 0xffff0000u), __builtin_bit_cast(float, r.y << 16), __builtin_bit_cast(float, r.y & 0xffff0000u)}; }
template <int MODE, bool ROUTE> __device__ __forceinline__ void ln_phase(Frame& F, const void* Yv, const bf16* X1, const bf16* PLEB, const float* gam, const float* bet, float* OF, bf16* OB, const float* router) {
    unsigned char* ws = F.ws;
    LAS float* Wr = (LAS float*)(F.lds + RING_OFF);
    if (ROUTE) { for (int i = F.tid; i < DM * 8 / 4; i += NWAVES * 64) ((LAS f32x4*)Wr)[i] = ((const GAS f32x4*)router)[i]; __syncthreads(); }
    const int gw = F.c * NWAVES + F.wave, NGW = F.G * NWAVES, lane = F.lane;
    for (int row = gw; row < S; row += NGW) {
        f32x4 v[8]; float s = 0.f;
        if (MODE == 0) { const GAS f32x4* yp = (const GAS f32x4*)((const float*)Yv + (size_t)row * DM) + lane;
#pragma unroll
            for (int j = 0; j < 8; ++j) v[j] = __builtin_nontemporal_load(yp + 64 * j);
        } else {
            const bf16* xp = X1 + (size_t)row * DM + 4 * lane; const bf16* pp = PLEB + (size_t)row * DM + 4 * lane; const bf16* Y = (const bf16*)Yv;
            if (MODE == 1) { const bf16* yp = Y + (size_t)row * DM + 4 * lane;
#pragma unroll
                for (int j = 0; j < 8; ++j) v[j] = ALPHA * ld4bf(xp + 256 * j) + ld4bf(yp + 256 * j) + ld4bf(pp + 256 * j);
            } else {
                const int* slot = (const int*)(ws + WS_ROUTE + RT_SLOT) + 2 * row; const float* tw = (const float*)(ws + WS_ROUTE + RT_W) + 2 * row;
                const int s0 = slot[0], s1 = slot[1]; const float w0 = tw[0], w1 = tw[1];
                const bf16* y0 = Y + (size_t)s0 * DM + 4 * lane; const bf16* y1 = Y + (size_t)s1 * DM + 4 * lane;
#pragma unroll
                for (int j = 0; j < 8; ++j) v[j] = ALPHA * ld4bf(xp + 256 * j) + (w0 * ld4bf(y0 + 256 * j) + w1 * ld4bf(y1 + 256 * j)) + ld4bf(pp + 256 * j);
            }
        }
#pragma unroll
        for (int j = 0; j < 8; ++j) s += (v[j][0] + v[j][1]) + (v[j][2] + v[j][3]);
        const float mean = wave_sum(s) * (1.0f / DM); float s2 = 0.f;
#pragma unroll
        for (int j = 0; j < 8; ++j) { v[j] = v[j] - mean; s2 += (v[j][0] * v[j][0] + v[j][1] * v[j][1]) + (v[j][2] * v[j][2] + v[j][3] * v[j][3]); }
        const float rstd = 1.0f / sqrtf(wave_sum(s2) * (1.0f / DM) + LN_EPS);
#pragma unroll
        for (int j = 0; j < 8; ++j) { const f32x4 g = ((const GAS f32x4*)gam)[lane + 64 * j], b = ((const GAS f32x4*)bet)[lane + 64 * j]; v[j] = v[j] * rstd * g + b; }
        if (OF) { GAS f32x4* of = (GAS f32x4*)(OF + (size_t)row * DM) + lane;
#pragma unroll
            for (int j = 0; j < 8; ++j) of[64 * j] = v[j]; }
        if (OB) { GAS v2u* ob = (GAS v2u*)(OB + (size_t)row * DM) + lane;
#pragma unroll
            for (int j = 0; j < 8; ++j) { v2u o; o.x = pk2h(v[j][0], v[j][1]); o.y = pk2h(v[j][2], v[j][3]); ob[64 * j] = o; } }
        if (ROUTE) {
            float lg[8];
#pragma unroll
            for (int e = 0; e < 8; ++e) lg[e] = 0.f;
#pragma unroll
            for (int j = 0; j < 8; ++j) { __builtin_amdgcn_sched_barrier(0);
#pragma unroll
                for (int k = 0; k < 4; ++k) { const int col = 4 * (lane + 64 * j) + k; const f32x4 wa = *(const LAS f32x4*)(Wr + col * 8), wb = *(const LAS f32x4*)(Wr + col * 8 + 4); const float xv = v[j][k];
                    lg[0] += xv * wa[0]; lg[1] += xv * wa[1]; lg[2] += xv * wa[2]; lg[3] += xv * wa[3]; lg[4] += xv * wb[0]; lg[5] += xv * wb[1]; lg[6] += xv * wb[2]; lg[7] += xv * wb[3]; } }
#pragma unroll
            for (int e = 0; e < 8; ++e) lg[e] = wave_sum(lg[e]);
            int i0 = 0; float v0 = lg[0];
#pragma unroll
            for (int e = 1; e < 8; ++e) if (lg[e] > v0) { v0 = lg[e]; i0 = e; }
            int i1 = -1; float v1 = -3.0e38f;
#pragma unroll
            for (int e = 0; e < 8; ++e) if (e != i0 && lg[e] > v1) { v1 = lg[e]; i1 = e; }
            if (lane == 0) { const float w0 = 1.0f / (1.0f + __expf(v1 - v0));
                const int p0 = (int)__hip_atomic_fetch_add(F.ctl + CW_ECNT + i0, 1u, RLX_AGENT), p1 = (int)__hip_atomic_fetch_add(F.ctl + CW_ECNT + i1, 1u, RLX_AGENT);
                int* te = (int*)(ws + WS_ROUTE + RT_E) + 2 * row; int* tp = (int*)(ws + WS_ROUTE + RT_POS) + 2 * row; float* tw = (float*)(ws + WS_ROUTE + RT_W) + 2 * row;
                te[0] = i0; te[1] = i1; tp[0] = p0; tp[1] = p1; tw[0] = w0; tw[1] = 1.0f - w0; }
        }
    }
    if (ROUTE) __syncthreads();
}
__device__ __forceinline__ void moe_tables(Frame& F) {
    LAS int* TE = (LAS int*)(F.lds + TE_OFF); LAS int* TR = TE + TBL; LAS int* TV = TR + TBL; LAS int* CN = TE + MAXTILES + 8;
    if (F.tid < NE) CN[F.tid] = (int)__hip_atomic_load(F.ctl + CW_ECNT + F.tid, RLX_AGENT);
    __syncthreads();
    if (F.tid == 0) { int t = 0;
        for (int pass = 0; pass < 2; ++pass) { int ptile = 0;
            for (int e = 0; e < NE; ++e) { const int cnt = CN[e], nt = (cnt + 255) >> 8;
                for (int k = 0; k < nt; ++k, ++ptile) { const int rows = (cnt - 256 * k) < 256 ? (cnt - 256 * k) : 256;
                    if ((MOE_PARTIAL ? ((rows < 256) == (pass == 0)) : (pass == 0)) && t < MAXTILES) { TE[t] = e; TR[t] = ptile; TV[t] = rows; ++t; } } } }
        TE[MAXTILES] = t; }
    __syncthreads();
}
__device__ __forceinline__ void moe_gather(Frame& F, const bf16* X1B, bf16* XG) {
    unsigned char* ws = F.ws;
    int base[NE]; { int acc = 0;
#pragma unroll
        for (int e = 0; e < NE; ++e) { base[e] = acc; const int cnt = (int)__hip_atomic_load(F.ctl + CW_ECNT + e, RLX_AGENT); acc += ((cnt + 255) >> 8) << 8; } }
    const int gw = F.c * NWAVES + F.wave, NGW = F.G * NWAVES, lane = F.lane;
    for (int it = gw; it < 2 * S; it += NGW) { const int row = it >> 1, k = it & 1;
        const int e = ((const int*)(ws + WS_ROUTE + RT_E))[it], pos = ((const int*)(ws + WS_ROUTE + RT_POS))[it];
        int b = 0;
#pragma unroll
        for (int j = 0; j < NE; ++j) b = (e == j) ? base[j] : b;
        const int slot = b + pos;
        if (lane == 0) ((int*)(ws + WS_ROUTE + RT_SLOT))[it] = slot;
        const GAS v4u* src = (const GAS v4u*)(X1B + (size_t)row * DM) + lane; GAS v4u* dst = (GAS v4u*)(XG + (size_t)slot * DM) + lane;
#pragma unroll
        for (int j = 0; j < 4; ++j) dst[64 * j] = src[64 * j]; (void)k; }
}

#ifndef PG8_SP2
#define PG8_SP2 true
#endif
constexpr int PT_OFF = TE_OFF + 3 * TBL * 4;
static_assert(PT_OFF % 8 == 0 && PT_OFF + 32 * 8 <= LDS_BYTES, "LDS map");
extern __shared__ __attribute__((aligned(16))) unsigned char lds_dyn[];
__device__ __forceinline__ const float* ptr_in(int i) { const unsigned long long v = ((const LAS unsigned long long*)((LAS unsigned char*)lds_dyn + PT_OFF))[i];
    const unsigned lo = __builtin_amdgcn_readfirstlane((unsigned)v), hi = __builtin_amdgcn_readfirstlane((unsigned)(v >> 32)); return (const float*)(const GAS float*)(((unsigned long long)hi << 32) | lo); }
__device__ __forceinline__ void make_frame(Frame& F) {
    F.lds = (LAS unsigned char*)lds_dyn; F.MISC = (volatile LAS unsigned*)(F.lds + MISC_OFF);
    { int t = threadIdx.x; asm volatile("" : "+v"(t)); F.tid = t; } F.lane = F.tid & 63; F.wave = __builtin_amdgcn_readfirstlane(F.tid >> 6);
    { int gg = gridDim.x, cc = blockIdx.x; asm volatile("" : "+s"(gg), "+s"(cc)); F.G = gg; F.c = cc; } F.ws = (unsigned char*)ptr_in(29); F.ctl = (gu32*)(F.ws + WS_CTL);
}
__device__ __forceinline__ void load_in(In& I) {
    I.x = ptr_in(0); I.p = ptr_in(1); I.pos = (const int*)ptr_in(2); I.w_in = ptr_in(3); I.q_gain = ptr_in(4); I.w_qb = ptr_in(5); I.kv_gain = ptr_in(6); I.w_kvb = ptr_in(7);
    I.gla_wg = ptr_in(8); I.gla_bg = ptr_in(9); I.gla_ng = ptr_in(10); I.sinks = ptr_in(11); I.relb = ptr_in(12); I.w_out = ptr_in(13); I.ln1g = ptr_in(14); I.ln1b = ptr_in(15);
    I.f_wg = ptr_in(16); I.f_wu = ptr_in(17); I.f_wd = ptr_in(18); I.router = ptr_in(19); I.m_wg = ptr_in(20); I.m_wu = ptr_in(21); I.m_wd = ptr_in(22); I.p_wu = ptr_in(23);
    I.p_wg = ptr_in(24); I.p_bg = ptr_in(25); I.ln2g = ptr_in(26); I.ln2b = ptr_in(27);
}
typedef pg8::bf16_t pb;
#define WSP(T, off) ((T*)(F.ws + (off)))
#ifndef PHASE_ATTR
#define PHASE_ATTR __forceinline__
#endif
#define PHASE static __device__ PHASE_ATTR void

PHASE ph_prologue() { Frame F; make_frame(F); In I; load_in(I); p0_prologue(F, I); }
PHASE ph_in(int l) { Frame F; make_frame(F);
    pg8::Gemm g{WSP(const pb, WS_XB), WSP(const pb, WS_WIN) + (size_t)l * LDH * DM, DM, DM, DM}; pg8::StaticOrder So; So.init(S, LDH, F.G, F.c);
    pg8::EpiIn E{WSP(pb, WS_HB), LDH, WSP(float, WS_SSQ), WSP(const float, WS_CS)};
    pg8::gemm_phase<pg8::EpiIn, pg8::StaticOrder, true, PG8_SP2>(F.lds + RING_OFF, g, So, E, F.tid);
    if (F.G == 256 && F.c >= 256 - HOLE1_WG) { In I; load_in(I); if (l == 0) bg_convert(F, I, N_HOLE0, F.c - (256 - HOLE1_WG), HOLE1_WG, BGQ1); else bg_convert(F, I, N_HOLE0 + HOLE1_N + HOLE2_N, F.c - (256 - HOLE3_WG), HOLE3_WG, BGQ3); } }
PHASE ph_upq(int l) { Frame F; make_frame(F);
    pg8::Gemm g{WSP(const pb, WS_HB) + H_QA, WSP(const pb, WS_WQB) + (size_t)l * QW * 512, LDH, 512, 512}; pg8::StaticOrder So; So.init(S, QW, F.G, F.c);
    pg8::EpiUp<true> E{WSP(pb, WS_QB), QW, WSP(const float, WS_SSQ), WSP(const float, WS_CS)};
    pg8::gemm_phase<pg8::EpiUp<true>, pg8::StaticOrder, true, PG8_SP2>(F.lds + RING_OFF, g, So, E, F.tid); }
PHASE ph_upkv(int l) { Frame F; make_frame(F);
    pg8::Gemm g{WSP(const pb, WS_HB) + H_KVA, WSP(const pb, WS_WKVB) + (size_t)l * KVW * 256, LDH, 256, 256}; pg8::StaticOrder So; So.init(S, KVW, F.G, F.c);
    pg8::EpiUp<false> E{WSP(pb, WS_KVB), KVW, WSP(const float, WS_SSQ), WSP(const float, WS_CS)};
    pg8::gemm_phase<pg8::EpiUp<false>, pg8::StaticOrder, true, PG8_SP2>(F.lds + RING_OFF, g, So, E, F.tid); }
PHASE ph_swa(int l) { Frame F; make_frame(F); const float* sinks = ptr_in(11) + l * 8; const float* relb = ptr_in(12);
    for (int u = F.c; u < 512; u += F.G) swa_unit(F, u >> 3, u & 7, WSP(const bf16, WS_HB), WSP(bf16, WS_MIX), sinks, relb); }
PHASE ph_gla1(int l) { Frame F; make_frame(F); const float* wg = ptr_in(8) + (size_t)l * 16 * 256; const float* bg = ptr_in(9) + l * 256; const float* ng = ptr_in(10) + l * 512;
    for (int u = F.c; u < 512; u += F.G) gla_unit<1>(F, u >> 2, u & 3, WSP(const bf16, WS_HB), wg, bg, WSP(float, WS_GUT), WSP(float, WS_GDEC), WSP(const bf16, WS_GSP), ng, WSP(bf16, WS_MIX)); }
PHASE ph_gla3(int l) { Frame F; make_frame(F); const float* wg = ptr_in(8) + (size_t)l * 16 * 256; const float* bg = ptr_in(9) + l * 256; const float* ng = ptr_in(10) + l * 512;
    for (int u = F.c; u < 512; u += F.G) gla_unit<3>(F, u >> 2, u & 3, WSP(const bf16, WS_HB), wg, bg, WSP(float, WS_GUT), WSP(float, WS_GDEC), WSP(const bf16, WS_GSP), ng, WSP(bf16, WS_MIX)); }
PHASE ph_scan() { Frame F; make_frame(F); gla_scan(F, WSP(const float, WS_GUT), WSP(const float, WS_GDEC), WSP(bf16, WS_GSP)); }
PHASE ph_mla(int l) { Frame F; make_frame(F);
    const int trk = (F.G == 256) ? l * TRK_PER_LAYER + F.c * NWAVES + F.wave : -1;
    const float* m_wg = ptr_in(20); const float* m_wu = ptr_in(21);
    for (int pr = F.c; pr < 256; pr += F.G) { const int h = pr >> 5, qb = pr & 31;
#pragma unroll 1
        for (int k = 0; k < 2; ++k) mla_unit(F, h, k ? qb : 63 - qb, WSP(const bf16, WS_QB), WSP(const bf16, WS_KVB), WSP(const bf16, WS_HB), WSP(bf16, WS_MIX), k ? 128 - 2 * qb : 0, trk, m_wg, m_wu, WSP(bf16, WS_MGU)); } }
PHASE ph_out(int l) { Frame F; make_frame(F);
    pg8::Gemm g{WSP(const pb, WS_MIX), WSP(const pb, WS_WOUT) + (size_t)l * DM * DM, DM, DM, DM}; pg8::StaticOrder So; So.init(S, DM, F.G, F.c);
    pg8::EpiOutRes E{WSP(float, WS_R2), DM, WSP(const pb, WS_XB), ALPHA};
    pg8::gemm_phase<pg8::EpiOutRes, pg8::StaticOrder, true, PG8_SP2>(F.lds + RING_OFF, g, So, E, F.tid); }
PHASE ph_ln1(int l) { Frame F; make_frame(F);
    ln_phase<0, false>(F, WSP(const void, WS_R2), nullptr, nullptr, ptr_in(14) + l * DM, ptr_in(15) + l * DM, nullptr, WSP(bf16, WS_X1B), nullptr); }
PHASE ph_ln1_route(int l) { Frame F; make_frame(F);
    ln_phase<0, true>(F, WSP(const void, WS_R2), nullptr, nullptr, ptr_in(14) + l * DM, ptr_in(15) + l * DM, nullptr, WSP(bf16, WS_X1B), ptr_in(19)); }
PHASE ph_gu_dense() { Frame F; make_frame(F);
    pg8::Gemm g{WSP(const pb, WS_X1B), WSP(const pb, WS_FGU), DM, DM, DM}; pg8::StaticOrder So; So.init(S, NGU, F.G, F.c);
    pg8::EpiSwiGLU E{WSP(pb, WS_HMID), DFF};
    pg8::gemm_phase<pg8::EpiSwiGLU, pg8::StaticOrder, true, PG8_SP2>(F.lds + RING_OFF, g, So, E, F.tid);
    if (F.G == 256 && F.c >= 256 - HOLE2_WG) { In I; load_in(I); bg_convert(F, I, N_HOLE0 + HOLE1_N, F.c - (256 - HOLE2_WG), HOLE2_WG, BGQ2); } }
PHASE ph_gather() { Frame F; make_frame(F); moe_gather(F, WSP(const bf16, WS_X1B), WSP(bf16, WS_XG)); }
PHASE ph_gu_moe() { Frame F; make_frame(F); moe_tables(F);
    pg8::Gemm g{WSP(const pb, WS_XG), WSP(const pb, WS_MGU), DM, DM, DM};
    pg8::MoeOrder<NGU / 256> Mo{(const PG8_LAS int*)(F.lds + TE_OFF), (const PG8_LAS int*)(F.lds + TE_OFF) + TBL, (const PG8_LAS int*)(F.lds + TE_OFF) + 2 * TBL, ((const LAS int*)(F.lds + TE_OFF))[MAXTILES], F.G, F.c};
    pg8::EpiSwiGLU E{WSP(pb, WS_HMID), DFF};
    pg8::gemm_phase<pg8::EpiSwiGLU, pg8::MoeOrder<NGU / 256>, true, PG8_SP2>(F.lds + RING_OFF, g, Mo, E, F.tid); }
PHASE ph_plegate(int l) { Frame F; make_frame(F);
    pg8::Gemm g{WSP(const pb, WS_X1B), WSP(const pb, WS_WPG) + (size_t)l * DM * DM, DM, DM, DM}; pg8::StaticOrder So; So.init(S, DM, F.G, F.c);
    pg8::EpiPle<0> E{WSP(pb, WS_PLE), DM, ptr_in(25) + l * DM};
    pg8::gemm_phase<pg8::EpiPle<0>, pg8::StaticOrder, true, PG8_SP2>(F.lds + RING_OFF, g, So, E, F.tid); }
PHASE ph_ple_light(int l) { Frame F; make_frame(F); moe_tables(F);
    const int ntot = ((const LAS int*)(F.lds + TE_OFF))[MAXTILES] * (DM / 256), nheavy = ntot - (ntot / F.G) * F.G;
    if (F.c < nheavy) return;
    pg8::StaticOrder So; So.init(S, DM, F.G - nheavy, F.c - nheavy);
    { pg8::Gemm g{WSP(const pb, WS_X1B), WSP(const pb, WS_WPG) + (size_t)l * DM * DM, DM, DM, DM}; pg8::EpiPle<0> E{WSP(pb, WS_PLE), DM, ptr_in(25) + l * DM};
      pg8::gemm_phase<pg8::EpiPle<0>, pg8::StaticOrder, true, PG8_SP2>(F.lds + RING_OFF, g, So, E, F.tid); }
    { pg8::Gemm g{WSP(const pb, WS_PB) + (size_t)l * S * PLE, WSP(const pb, WS_WPU) + (size_t)l * DM * PLE, PLE, PLE, PLE}; pg8::EpiPle<1> E{WSP(pb, WS_PLE), DM, nullptr};
      pg8::gemm_phase<pg8::EpiPle<1>, pg8::StaticOrder, true, PG8_SP2>(F.lds + RING_OFF, g, So, E, F.tid); } }
PHASE ph_down_dense() { Frame F; make_frame(F);
    pg8::Gemm g{WSP(const pb, WS_HMID), WSP(const pb, WS_FD), DFF, DFF, DFF}; pg8::StaticOrder So; So.init(S, DM, F.G, F.c);
    pg8::EpiBf16 E{WSP(pb, WS_R2), DM};
    pg8::gemm_phase<pg8::EpiBf16, pg8::StaticOrder, true, PG8_SP2>(F.lds + RING_OFF, g, So, E, F.tid); }
PHASE ph_down_moe() { Frame F; make_frame(F); moe_tables(F);
    pg8::Gemm g{WSP(const pb, WS_HMID), WSP(const pb, WS_MD), DFF, DFF, DFF};
    pg8::MoeOrder<DM / 256> Mo{(const PG8_LAS int*)(F.lds + TE_OFF), (const PG8_LAS int*)(F.lds + TE_OFF) + TBL, (const PG8_LAS int*)(F.lds + TE_OFF) + 2 * TBL, ((const LAS int*)(F.lds + TE_OFF))[MAXTILES], F.G, F.c};
    pg8::EpiBf16 E{WSP(pb, WS_R2), DM};
    pg8::gemm_phase<pg8::EpiBf16, pg8::MoeOrder<DM / 256>, true, PG8_SP2>(F.lds + RING_OFF, g, Mo, E, F.tid); }
PHASE ph_pleup(int l) { Frame F; make_frame(F);
    pg8::Gemm g{WSP(const pb, WS_PB) + (size_t)l * S * PLE, WSP(const pb, WS_WPU) + (size_t)l * DM * PLE, PLE, PLE, PLE}; pg8::StaticOrder So; So.init(S, DM, F.G, F.c);
    pg8::EpiPle<1> E{WSP(pb, WS_PLE), DM, nullptr};
    pg8::gemm_phase<pg8::EpiPle<1>, pg8::StaticOrder, true, PG8_SP2>(F.lds + RING_OFF, g, So, E, F.tid); }
PHASE ph_ln2_dense(int l) { Frame F; make_frame(F);
    ln_phase<1, false>(F, WSP(const void, WS_R2), WSP(const bf16, WS_X1B), WSP(const bf16, WS_PLE), ptr_in(26) + l * DM, ptr_in(27) + l * DM, nullptr, WSP(bf16, WS_XB), nullptr); }
PHASE ph_ln2_moe(int l) { Frame F; make_frame(F);
    ln_phase<2, false>(F, WSP(const void, WS_R2), WSP(const bf16, WS_X1B), WSP(const bf16, WS_PLE), ptr_in(26) + l * DM, ptr_in(27) + l * DM, (float*)ptr_in(28), nullptr, nullptr); }
PHASE ph_bar() { Frame F; make_frame(F); XcdBarrier bar; bar.bar = (unsigned*)(F.ctl + CW_BAR); bar.x = xb_xcc_id(); bar.st = F.MISC + 8; xcd_barrier(bar); }

struct Args { const float* in[28]; float* out; unsigned char* ws; };
__global__ void __launch_bounds__(NWAVES * 64, 2) fwd_kernel(Args args) {
    { LAS unsigned char* L = (LAS unsigned char*)lds_dyn;
      for (int u = threadIdx.x; u < (LDS_BYTES - LDSCTL_OFF) / 4; u += NWAVES * 64) ((LAS unsigned*)(L + LDSCTL_OFF))[u] = 0u;
      __syncthreads();
      if (threadIdx.x == 0) { LAS unsigned long long* pt = (LAS unsigned long long*)(L + PT_OFF);
#pragma unroll
          for (int i = 0; i < 28; ++i) pt[i] = (unsigned long long)args.in[i];
          pt[28] = (unsigned long long)args.out; pt[29] = (unsigned long long)args.ws; }
      __syncthreads();
      (void)xcd_barrier_post((unsigned*)((gu32*)(args.ws + WS_CTL) + CW_BAR), (volatile LAS unsigned*)(L + MISC_OFF) + 8); }
#ifndef DUP
#define DUP 0
#endif
#define D(bit, call) do { call; if (DUP & (bit)) { call; } } while (0)
#ifdef ONLY
    ONLY; ph_bar();
#else
    D(1, ph_prologue()); ph_bar();
    D(2, ph_in(0)); ph_bar();
    D(4, ph_upq(0)); D(4, ph_upkv(0)); D(8, ph_swa(0)); D(16, ph_gla1(0)); ph_bar();
    D(32, ph_scan()); D(64, ph_mla(0)); ph_bar();
    D(128, ph_gla3(0)); ph_bar();
    D(256, ph_out(0)); ph_bar();
    D(512, ph_ln1(0)); ph_bar();
    D(1024, ph_gu_dense()); D(2048, ph_plegate(0)); ph_bar();
    D(4096, ph_down_dense()); ph_pleup(0); ph_bar();
    D(512, ph_ln2_dense(0)); ph_bar();
    D(2, ph_in(1)); ph_bar();
    D(4, ph_upq(1)); D(4, ph_upkv(1)); D(8, ph_swa(1)); D(16, ph_gla1(1)); ph_bar();
    D(32, ph_scan()); D(64, ph_mla(1)); ph_bar();
    D(128, ph_gla3(1)); ph_bar();
    D(256, ph_out(1)); ph_bar();
    ph_ln1_route(1); ph_bar();
    D(8192, ph_gather()); ph_bar();
#ifdef PLE_LIGHT
    D(16384, ph_gu_moe()); ph_bar();
    D(32768, ph_down_moe()); ph_ple_light(1); ph_bar();
#else
    D(16384, ph_gu_moe()); D(2048, ph_plegate(1)); ph_bar();
    D(32768, ph_down_moe()); ph_pleup(1); ph_bar();
#endif
    ph_ln2_moe(1);
#endif
}

extern "C" void kernel_launch(void* const* d_in, const int* in_sizes, int n_in, void* d_out, int out_size, void* d_ws, size_t ws_size, hipStream_t stream) {
    static int grid = 0;
    if (grid == 0) {
        if (n_in != 28 || in_sizes[0] != S * DM || out_size != S * DM || ws_size < WS_END) { fprintf(stderr, "kernel_launch: unexpected shapes / workspace (n_in %d, ws %zu, need %zu); nothing launched\n", n_in, ws_size, (size_t)WS_END); grid = -1; return; }
        int dev = 0, cus = 0, per_cu = 0;
        if (hipGetDevice(&dev) != hipSuccess || hipDeviceGetAttribute(&cus, hipDeviceAttributeMultiprocessorCount, dev) != hipSuccess) { grid = -1; return; }
        if (hipFuncSetAttribute((const void*)fwd_kernel, hipFuncAttributeMaxDynamicSharedMemorySize, LDS_BYTES) != hipSuccess) { fprintf(stderr, "kernel_launch: hipFuncSetAttribute failed\n"); grid = -1; return; }
        if (hipOccupancyMaxActiveBlocksPerMultiprocessor(&per_cu, (const void*)fwd_kernel, NWAVES * 64, LDS_BYTES) != hipSuccess || per_cu < 1) { fprintf(stderr, "kernel_launch: occupancy query reports %d workgroups per CU\n", per_cu); (void)hipGetLastError(); grid = -1; return; }
        grid = cus;
    }
    if (grid < 0) return;
    if (hipMemsetAsync((char*)d_ws + WS_CTL, 0, CTL_ZERO_BYTES, stream) != hipSuccess) return;
    Args a{};
    for (int i = 0; i < 28; ++i) a.in[i] = (const float*)d_in[i];
    a.out = (float*)d_out; a.ws = (unsigned char*)d_ws;
    hipLaunchKernelGGL(fwd_kernel, dim3(grid), dim3(NWAVES * 64), LDS_BYTES, stream, a);
}
```

```cpp
#include <hip/hip_runtime.h>
#include <cstdio>
#include <cstdint>
namespace pg8 {
#define PG8_LAS __attribute__((address_space(3)))
typedef unsigned short bf16_t;
typedef short bf16x8 __attribute__((ext_vector_type(8)));
typedef float f32x4 __attribute__((ext_vector_type(4)));
typedef unsigned u32x4 __attribute__((ext_vector_type(4)));
constexpr int BM = 256, BK = 64, HALF = 128, HTB = HALF * BK * 2  , STAGE_BYTES = 8 * HTB, NXCD = 8, WGM = 8;

__host__ __device__ __forceinline__ int lds_byte(int r, int c) { const int st = (r >> 4) * 2 + (c >> 5), rr = r & 15, cc = c & 31, ob = rr * 64 + cc * 2; return st * 1024 + (ob ^ (((ob >> 9) & 1) << 5)); }
__host__ __device__ __forceinline__ void stage_rc(int b, int& R, int& C) { const int st = b / 1024, sb = b % 1024, swz = sb ^ (((sb >> 9) & 1) << 5); R = (st >> 1) * 16 + swz / 64; C = (st & 1) * 32 + (swz % 64) / 2; }
__host__ __device__ __forceinline__ int perm32(int rho) { const int n = rho >> 4, i = rho & 15; return 8 * (i >> 2) + 4 * n + (i & 3); }

struct Unit { int pm, pn, pb, rows; };
struct Gemm { const bf16_t* A; const bf16_t* Bt; int lda, ldb, K; };

struct StaticOrder {
    static constexpr bool PARTIAL = false;
    int nM, nN, nwg, G, c;
    __host__ __device__ void init(int M, int N, int G_, int c_) { nM = M / BM; nN = N / BM; nwg = nM * nN; G = G_; c = c_; }
    __host__ __device__ bool next(int i, Unit& u) const {
        const long L = (long)i * G + c; if (L >= nwg) return false;
        int wgid = (int)L; { const int q = nwg / NXCD, r = nwg % NXCD, xcd = wgid % NXCD, off = wgid / NXCD; wgid = (xcd < r ? xcd * (q + 1) : r * (q + 1) + (xcd - r) * q) + off; }
        const int nig = WGM * nN, gid = wgid / nig, fm = gid * WGM, gsz = (nM - fm) < WGM ? (nM - fm) : WGM;
        u.pm = fm + ((wgid % nig) % gsz); u.pn = (wgid % nig) / gsz; u.pb = u.pn; u.rows = BM; return true;
    }
    __device__ __forceinline__ void a_ready(const Unit&) const {}
    __device__ __forceinline__ void done(const Unit&) const {}
};
#ifndef MOE_PARTIAL
#define MOE_PARTIAL false
#endif
template <int nN> struct MoeOrder {
    static constexpr bool PARTIAL = MOE_PARTIAL;
    const PG8_LAS int* te; const PG8_LAS int* trow; const PG8_LAS int* tval; int ntiles, G, c;
    __device__ __forceinline__ bool next(int i, Unit& u) const {
        const int L = i * G + c; if (L >= ntiles * nN) return false;
        const int idx = L / nN; u.pn = L - idx * nN; u.pm = trow[idx]; u.pb = te[idx] * nN + u.pn; u.rows = tval[idx]; return true;
    }
    __device__ __forceinline__ void a_ready(const Unit&) const {}
    __device__ __forceinline__ void done(const Unit&) const {}
};
typedef float f32x2v __attribute__((ext_vector_type(2))); typedef __bf16 bf16x2v __attribute__((ext_vector_type(2)));
__device__ __forceinline__ unsigned cvt_pk_bf16(float lo, float hi) { const f32x2v v = {lo, hi}; const bf16x2v r = __builtin_convertvector(v, bf16x2v); return __builtin_bit_cast(unsigned, r); }
typedef float f32x2 __attribute__((ext_vector_type(2)));
__device__ __forceinline__ float fast_sigmoid(float v) { return __builtin_amdgcn_rcpf(1.0f + __builtin_amdgcn_exp2f(-1.4426950408889634f * v)); }
__device__ __forceinline__ u32x4 pack8(const f32x4 a, const f32x4 b) { u32x4 w; w.x = cvt_pk_bf16(a[0], a[1]); w.y = cvt_pk_bf16(a[2], a[3]); w.z = cvt_pk_bf16(b[0], b[1]); w.w = cvt_pk_bf16(b[2], b[3]); return w; }
__device__ __forceinline__ void rope8(f32x4& a, f32x4& b, const f32x4 c4, const f32x4 s4) {
    const f32x4 a0 = a, b0 = b;
    a[0] = a0[0] * c4[0] - a0[1] * s4[0]; a[1] = a0[1] * c4[0] + a0[0] * s4[0];
    a[2] = a0[2] * c4[1] - a0[3] * s4[1]; a[3] = a0[3] * c4[1] + a0[2] * s4[1];
    b[0] = b0[0] * c4[2] - b0[1] * s4[2]; b[1] = b0[1] * c4[2] + b0[0] * s4[2];
    b[2] = b0[2] * c4[3] - b0[3] * s4[3]; b[3] = b0[3] * c4[3] + b0[2] * s4[3];
}
struct EpiIn {
    static constexpr bool PERM = true, AFTER_DRAIN = false;
    bf16_t* H; int ldc; float* ssq; const float* cs;
    __device__ __forceinline__ void operator()(const f32x4 (&acc)[2][2][4][2], const Unit& u, int wr, int wc, int fr, int fq) const {
        const int row0 = u.pm * BM + wr * 64 + fr, col0 = u.pn * BM + wc * 32 + 8 * fq;
#pragma unroll
        for (int ai = 0; ai < 2; ++ai)
#pragma unroll
            for (int m = 0; m < 4; ++m) { const int row = row0 + ai * HALF + m * 16; bf16_t* rowp = H + (size_t)row * ldc + col0; float s = 0.f;
#pragma unroll
                for (int bj = 0; bj < 2; ++bj) { f32x4 v0 = acc[ai][bj][m][0], v1 = acc[ai][bj][m][1];
                    if (bj == 0 && u.pn == 3 && wc < 2) { const int p0 = (wc * 32 + 8 * fq) >> 1; const f32x4 c4 = *(const f32x4*)(cs + (size_t)row * 64 + p0), s4 = *(const f32x4*)(cs + (size_t)row * 64 + 32 + p0); rope8(v0, v1, c4, s4); }
                    s += (v0[0] * v0[0] + v0[1] * v0[1]) + (v0[2] * v0[2] + v0[3] * v0[3]) + (v1[0] * v1[0] + v1[1] * v1[1]) + (v1[2] * v1[2] + v1[3] * v1[3]);
                    *(u32x4*)(rowp + bj * HALF) = pack8(v0, v1); }
                if (u.pn < 3) { s += __shfl_xor(s, 16); s += __shfl_xor(s, 32); if (fq == 0) ssq[(size_t)row * 12 + u.pn * 4 + wc] = s; } }
    }
};
template <bool ISQ> struct EpiUp {
    static constexpr bool PERM = true, AFTER_DRAIN = false;
    bf16_t* O; int ldc; const float* ssq; const float* cs;
    __device__ __forceinline__ void operator()(const f32x4 (&acc)[2][2][4][2], const Unit& u, int wr, int wc, int fr, int fq) const {
        const int row0 = u.pm * BM + wr * 64 + fr, col0 = u.pn * BM + wc * 32 + 8 * fq;
#pragma unroll
        for (int ai = 0; ai < 2; ++ai)
#pragma unroll
            for (int m = 0; m < 4; ++m) { const int row = row0 + ai * HALF + m * 16; bf16_t* rowp = O + (size_t)row * ldc + col0;
                const float* sp = ssq + (size_t)row * 12 + (ISQ ? 0 : 8); float r;
                if (ISQ) { const f32x4 a = *(const f32x4*)sp, b = *(const f32x4*)(sp + 4);
                    const float s = ((a[0] + a[1]) + (a[2] + a[3])) + ((b[0] + b[1]) + (b[2] + b[3])); r = 1.0f / sqrtf(s * (1.0f / 512.0f) + 1e-6f); }
                else { const f32x4 a = *(const f32x4*)sp; const float s = (a[0] + a[1]) + (a[2] + a[3]); r = 1.0f / sqrtf(s * (1.0f / 256.0f) + 1e-6f); }
#pragma unroll
                for (int bj = 0; bj < 2; ++bj) { f32x4 v0 = acc[ai][bj][m][0] * r, v1 = acc[ai][bj][m][1] * r;
                    if (ISQ) { const int col = col0 + bj * HALF, hc = col % 192;
                        if (hc >= 128) { const int p0 = (hc - 128) >> 1; const f32x4 c4 = *(const f32x4*)(cs + (size_t)row * 64 + p0), s4 = *(const f32x4*)(cs + (size_t)row * 64 + 32 + p0); rope8(v0, v1, c4, s4); } }
                    *(u32x4*)(rowp + bj * HALF) = pack8(v0, v1); } }
    }
};
struct EpiOutRes {
    static constexpr bool PERM = false, AFTER_DRAIN = false;
    float* C; int ldc; const bf16_t* res; float alpha;
    __device__ __forceinline__ void operator()(const f32x4 (&acc)[2][2][4][2], const Unit& u, int wr, int wc, int fr, int fq) const {
        const int row0 = u.pm * BM + wr * 64 + fr, col0 = u.pn * BM + wc * 32 + 4 * fq;
        typedef unsigned u32x2 __attribute__((ext_vector_type(2)));
#pragma unroll
        for (int ai = 0; ai < 2; ++ai)
#pragma unroll
            for (int m = 0; m < 4; ++m) { const size_t ro = (size_t)(row0 + ai * HALF + m * 16) * ldc + col0;
#pragma unroll
                for (int bj = 0; bj < 2; ++bj)
#pragma unroll
                    for (int n = 0; n < 2; ++n) { f32x4 v = acc[ai][bj][m][n]; const u32x2 r = *(const u32x2*)(res + ro + bj * HALF + n * 16);
                        v[0] += alpha * __builtin_bit_cast(float, r.x << 16); v[1] += alpha * __builtin_bit_cast(float, r.x & 0xffff0000u);
                        v[2] += alpha * __builtin_bit_cast(float, r.y << 16); v[3] += alpha * __builtin_bit_cast(float, r.y & 0xffff0000u);
                        *(f32x4*)(C + ro + bj * HALF + n * 16) = v; } }
    }
};
struct EpiBf16 {
    static constexpr bool PERM = true, AFTER_DRAIN = false;
    bf16_t* O; int ldc;
    __device__ __forceinline__ void operator()(const f32x4 (&acc)[2][2][4][2], const Unit& u, int wr, int wc, int fr, int fq) const {
        const int row0 = u.pm * BM + wr * 64 + fr, col0 = u.pn * BM + wc * 32 + 8 * fq;
#pragma unroll
        for (int ai = 0; ai < 2; ++ai)
#pragma unroll
            for (int m = 0; m < 4; ++m) { bf16_t* rowp = O + (size_t)(row0 + ai * HALF + m * 16) * ldc + col0;
#pragma unroll
                for (int bj = 0; bj < 2; ++bj) *(u32x4*)(rowp + bj * HALF) = pack8(acc[ai][bj][m][0], acc[ai][bj][m][1]); }
    }
};
template <int MODE> struct EpiPle {
    static constexpr bool PERM = true, AFTER_DRAIN = false;
    bf16_t* C; int ldc; const float* bias;
    __device__ __forceinline__ void operator()(const f32x4 (&acc)[2][2][4][2], const Unit& u, int wr, int wc, int fr, int fq) const {
        const int row0 = u.pm * BM + wr * 64 + fr, col0 = u.pn * BM + wc * 32 + 8 * fq;
#pragma unroll
        for (int ai = 0; ai < 2; ++ai)
#pragma unroll
            for (int m = 0; m < 4; ++m) { bf16_t* rowp = C + (size_t)(row0 + ai * HALF + m * 16) * ldc + col0;
#pragma unroll
                for (int bj = 0; bj < 2; ++bj) { f32x4 v0 = acc[ai][bj][m][0], v1 = acc[ai][bj][m][1]; bf16_t* cp = rowp + bj * HALF;
                    if (MODE == 0) { const f32x4 b0 = *(const f32x4*)(bias + col0 + bj * HALF), b1 = *(const f32x4*)(bias + col0 + bj * HALF + 4); v0 = v0 + b0; v1 = v1 + b1;
#pragma unroll
                        for (int e = 0; e < 4; ++e) { v0[e] = fast_sigmoid(v0[e]); v1[e] = fast_sigmoid(v1[e]); } }
                    else { const u32x4 s = *(const u32x4*)cp;
                        v0[0] *= __builtin_bit_cast(float, s.x << 16); v0[1] *= __builtin_bit_cast(float, s.x & 0xffff0000u); v0[2] *= __builtin_bit_cast(float, s.y << 16); v0[3] *= __builtin_bit_cast(float, s.y & 0xffff0000u);
                        v1[0] *= __builtin_bit_cast(float, s.z << 16); v1[1] *= __builtin_bit_cast(float, s.z & 0xffff0000u); v1[2] *= __builtin_bit_cast(float, s.w << 16); v1[3] *= __builtin_bit_cast(float, s.w & 0xffff0000u); }
                    *(u32x4*)cp = pack8(v0, v1); } }
    }
};
struct EpiSwiGLU {
    static constexpr bool PERM = true, AFTER_DRAIN = false;
    bf16_t* O; int ldc;
    __device__ __forceinline__ void operator()(const f32x4 (&acc)[2][2][4][2], const Unit& u, int wr, int wc, int fr, int fq) const {
        const int row0 = u.pm * BM + wr * 64 + fr, col0 = u.pn * HALF + wc * 32 + 8 * fq;
#pragma unroll
        for (int ai = 0; ai < 2; ++ai)
#pragma unroll
            for (int m = 0; m < 4; ++m) { bf16_t* rowp = O + (size_t)(row0 + ai * HALF + m * 16) * ldc + col0;
                f32x4 o[2];
#pragma unroll
                for (int n = 0; n < 2; ++n) { const f32x4 g = acc[ai][0][m][n], up = acc[ai][1][m][n];
#pragma unroll
                    for (int e = 0; e < 4; ++e) o[n][e] = g[e] * fast_sigmoid(g[e]) * up[e]; }
                *(u32x4*)rowp = pack8(o[0], o[1]); }
    }
};
template <class Epi, class Sched, bool ALIGN_EPI = false, bool SP2 = false>
__device__ __forceinline__ void gemm_phase(PG8_LAS unsigned char* lds, const Gemm g, const Sched& S, const Epi& E, const int tid) {
    const int wid = __builtin_amdgcn_readfirstlane(tid >> 6), lane = tid & 63, wr = wid >> 2, wc = wid & 3, fr = lane & 15, fq = lane >> 4;
    const int K = g.K, nt = K / BK;
    unsigned voffA[2], voffB[2];
#pragma unroll
    for (int i = 0; i < 2; ++i) { int R, C; stage_rc(tid * 16 + i * 8192, R, C); const int Rb = Epi::PERM ? ((R & ~31) + perm32(R & 31)) : R;
        voffA[i] = (unsigned)(R * g.lda + C) * 2u; voffB[i] = (unsigned)(Rb * g.ldb + C) * 2u; }
    const size_t kstep = (size_t)(BK * 2);
    const size_t hstepA = (size_t)HALF * g.lda * 2, hstepB = (size_t)HALF * g.ldb * 2;
    const size_t tstepA = 2 * hstepA, tstepB = 2 * hstepB;
    const unsigned ldsw = (unsigned)wid * 1024u;
    const int aoff = lds_byte(wr * 64 + fr, fq * 8), boff = lds_byte(wc * 32 + fr, fq * 8);
#define PG8_SA(b, h) (((b) * 2 + (h)) * HTB)
#define PG8_SB(b, h) ((4 + (b) * 2 + (h)) * HTB)
#define PG8_STAGE(bufoff, gbase, voff) do { _Pragma("unroll") for (int _i = 0; _i < 2; ++_i) \
        __builtin_amdgcn_global_load_lds((const unsigned*)((const char*)(gbase) + (voff)[_i]), (PG8_LAS unsigned*)(lds + (bufoff) + ldsw + _i * 8192), 16, 0, 0); } while (0)
#define PG8_LDA(dst, b, h) do { _Pragma("unroll") for (int m = 0; m < 4; ++m) _Pragma("unroll") for (int k = 0; k < 2; ++k) dst[m][k] = *(const PG8_LAS bf16x8*)(lds + PG8_SA(b, h) + aoff + m * 2048 + k * 1024); } while (0)
#define PG8_LDB(dst, b, h) do { _Pragma("unroll") for (int n = 0; n < 2; ++n) _Pragma("unroll") for (int k = 0; k < 2; ++k) dst[n][k] = *(const PG8_LAS bf16x8*)(lds + PG8_SB(b, h) + boff + n * 2048 + k * 1024); } while (0)
#define PG8_MMA(ai, bj, At, Bt) do { __builtin_amdgcn_s_setprio(1); _Pragma("unroll") for (int m = 0; m < 4; ++m) _Pragma("unroll") for (int n = 0; n < 2; ++n) _Pragma("unroll") for (int k = 0; k < 2; ++k) \
        acc[ai][bj][m][n] = __builtin_amdgcn_mfma_f32_16x16x32_bf16(Bt[n][k], At[m][k], acc[ai][bj][m][n], 0, 0, 0); __builtin_amdgcn_s_setprio(0); } while (0)
#define PG8_MMAG(ai, bj, At, Bt) do { if (Sched::PARTIAL && !((ai) == 0 ? on0 : on1)) break; __builtin_amdgcn_s_setprio(1); _Pragma("unroll") for (int m = 0; m < 4; ++m) _Pragma("unroll") for (int n = 0; n < 2; ++n) _Pragma("unroll") for (int k = 0; k < 2; ++k) \
        acc[ai][bj][m][n] = __builtin_amdgcn_mfma_f32_16x16x32_bf16(Bt[n][k], At[m][k], acc[ai][bj][m][n], 0, 0, 0); __builtin_amdgcn_s_setprio(0); } while (0)
#define PG8_WAIT_V(n) asm volatile("s_waitcnt vmcnt(" #n ")" ::: "memory")
#define PG8_WAIT_L(n) asm volatile("s_waitcnt lgkmcnt(" #n ")" ::: "memory")
#define PG8_BAR __builtin_amdgcn_s_barrier()
#define PG8_SCHED __builtin_amdgcn_sched_barrier(0)
    Unit cur, nxt; int ui = 0;
    if (!S.next(0, cur)) return;
    bool on0 = true, on1 = true;
    if constexpr (Sched::PARTIAL) { on0 = cur.rows > wr * 64; on1 = cur.rows > HALF + wr * 64; }
    f32x4 acc[2][2][4][2];
#pragma unroll
    for (int a = 0; a < 2; ++a)
#pragma unroll
        for (int b = 0; b < 2; ++b)
#pragma unroll
            for (int m = 0; m < 4; ++m)
#pragma unroll
                for (int n = 0; n < 2; ++n) acc[a][b][m][n] = (f32x4){0.f, 0.f, 0.f, 0.f};
    bf16x8 At[4][2], B0[2][2], B1[2][2];
    const char* cA = (const char*)g.A + (size_t)cur.pm * tstepA; const char* cB = (const char*)g.Bt + (size_t)cur.pb * tstepB;
    S.a_ready(cur);
    if constexpr (SP2) {
        PG8_STAGE(PG8_SB(0, 0), cB, voffB); PG8_STAGE(PG8_SB(0, 1), cB + hstepB, voffB); PG8_STAGE(PG8_SA(0, 0), cA, voffA); PG8_STAGE(PG8_SA(0, 1), cA + hstepA, voffA);
        if (wr == 1) PG8_BAR;
        PG8_WAIT_V(2); PG8_BAR;
        PG8_STAGE(PG8_SB(1, 0), cB + kstep, voffB); PG8_STAGE(PG8_SA(1, 0), cA + kstep, voffA); PG8_STAGE(PG8_SB(1, 1), cB + hstepB + kstep, voffB);
        PG8_WAIT_V(6); PG8_BAR;
    } else {
        PG8_STAGE(PG8_SB(0, 0), cB, voffB); PG8_STAGE(PG8_SA(0, 0), cA, voffA); PG8_STAGE(PG8_SB(0, 1), cB + hstepB, voffB); PG8_STAGE(PG8_SA(0, 1), cA + hstepA, voffA);
        if (wr == 1) PG8_BAR;
        PG8_WAIT_V(4); PG8_BAR;
        PG8_STAGE(PG8_SB(1, 0), cB + kstep, voffB); PG8_STAGE(PG8_SA(1, 0), cA + kstep, voffA); PG8_STAGE(PG8_SB(1, 1), cB + hstepB + kstep, voffB);
        PG8_WAIT_V(6); PG8_BAR;
    }
    for (;;) {
        const bool has_next = S.next(ui + 1, nxt);
        const char* nA = has_next ? (const char*)g.A + (size_t)nxt.pm * tstepA : cA; const char* nB = has_next ? (const char*)g.Bt + (size_t)nxt.pb * tstepB : cB;
        if (Sched::PARTIAL && !(on0 && on1)) {
        for (int t = 0; t < nt; t += 2) {
            const bool last = (t == nt - 2);
            const char* a1 = cA + (size_t)(t + 1) * kstep;
            const char* a2 = last ? nA : cA + (size_t)(t + 2) * kstep; const char* b2 = last ? nB : cB + (size_t)(t + 2) * kstep;
            const char* a3 = a2 + kstep; const char* b3 = b2 + kstep;
            if (last && has_next) S.a_ready(nxt);
            if constexpr (SP2) {
            PG8_LDB(B0, 0, 0); PG8_LDB(B1, 0, 1); PG8_SCHED; PG8_LDA(At, 0, 0); PG8_STAGE(PG8_SA(1, 1), a1 + hstepA, voffA);
            PG8_WAIT_V(8); PG8_WAIT_L(0); PG8_BAR; PG8_MMAG(0, 0, At, B0); PG8_MMAG(0, 1, At, B1); PG8_BAR; PG8_SCHED;
            PG8_LDA(At, 0, 1); PG8_STAGE(PG8_SB(0, 0), b2, voffB); PG8_STAGE(PG8_SB(0, 1), b2 + hstepB, voffB); PG8_STAGE(PG8_SA(0, 0), a2, voffA);
            PG8_WAIT_V(8); PG8_WAIT_L(0); PG8_BAR; PG8_MMAG(1, 0, At, B0); PG8_MMAG(1, 1, At, B1); PG8_BAR; PG8_SCHED;
            PG8_LDB(B0, 1, 0); PG8_LDB(B1, 1, 1); PG8_SCHED; PG8_LDA(At, 1, 0); PG8_STAGE(PG8_SA(0, 1), a2 + hstepA, voffA);
            PG8_WAIT_V(8); PG8_WAIT_L(0); PG8_BAR; PG8_MMAG(0, 0, At, B0); PG8_MMAG(0, 1, At, B1); PG8_BAR; PG8_SCHED;
            PG8_LDA(At, 1, 1); PG8_STAGE(PG8_SB(1, 0), b3, voffB); PG8_STAGE(PG8_SB(1, 1), b3 + hstepB, voffB); PG8_STAGE(PG8_SA(1, 0), a3, voffA);
            PG8_WAIT_V(8); PG8_WAIT_L(0); PG8_BAR; PG8_MMAG(1, 0, At, B0); PG8_MMAG(1, 1, At, B1); PG8_BAR; PG8_SCHED;
            } else {
            PG8_LDB(B0, 0, 0); PG8_SCHED; PG8_LDA(At, 0, 0); PG8_STAGE(PG8_SA(1, 1), a1 + hstepA, voffA);
            PG8_WAIT_L(8); PG8_BAR; PG8_WAIT_L(0); PG8_MMAG(0, 0, At, B0); PG8_BAR; PG8_SCHED;
            PG8_LDB(B1, 0, 1); PG8_STAGE(PG8_SB(0, 0), b2, voffB);
            PG8_BAR; PG8_WAIT_L(0); PG8_MMAG(0, 1, At, B1); PG8_BAR;
            PG8_LDA(At, 0, 1); PG8_STAGE(PG8_SA(0, 0), a2, voffA);
            PG8_BAR; PG8_WAIT_L(0); PG8_MMAG(1, 0, At, B0); PG8_BAR; PG8_SCHED;
            PG8_STAGE(PG8_SB(0, 1), b2 + hstepB, voffB);
            PG8_WAIT_V(6); PG8_BAR; PG8_MMAG(1, 1, At, B1); PG8_BAR;
            PG8_LDB(B0, 1, 0); PG8_SCHED; PG8_LDA(At, 1, 0); PG8_STAGE(PG8_SA(0, 1), a2 + hstepA, voffA);
            PG8_WAIT_L(8); PG8_BAR; PG8_WAIT_L(0); PG8_MMAG(0, 0, At, B0); PG8_BAR; PG8_SCHED;
            PG8_LDB(B1, 1, 1); PG8_STAGE(PG8_SB(1, 0), b3, voffB);
            PG8_BAR; PG8_WAIT_L(0); PG8_MMAG(0, 1, At, B1); PG8_BAR;
            PG8_LDA(At, 1, 1); PG8_STAGE(PG8_SA(1, 0), a3, voffA);
            PG8_BAR; PG8_WAIT_L(0); PG8_MMAG(1, 0, At, B0); PG8_BAR; PG8_SCHED;
            PG8_STAGE(PG8_SB(1, 1), b3 + hstepB, voffB);
            PG8_WAIT_V(6); PG8_BAR; PG8_MMAG(1, 1, At, B1); PG8_BAR;
            }
        }
        } else {
        for (int t = 0; t < nt; t += 2) {
            const bool last = (t == nt - 2);
            const char* a1 = cA + (size_t)(t + 1) * kstep;
            const char* a2 = last ? nA : cA + (size_t)(t + 2) * kstep; const char* b2 = last ? nB : cB + (size_t)(t + 2) * kstep;
            const char* a3 = a2 + kstep; const char* b3 = b2 + kstep;
            if (last && has_next) S.a_ready(nxt);
            if constexpr (SP2) {
            PG8_LDB(B0, 0, 0); PG8_LDB(B1, 0, 1); PG8_SCHED; PG8_LDA(At, 0, 0); PG8_STAGE(PG8_SA(1, 1), a1 + hstepA, voffA);
            PG8_WAIT_V(8); PG8_WAIT_L(0); PG8_BAR; PG8_MMA(0, 0, At, B0); PG8_MMA(0, 1, At, B1); PG8_BAR; PG8_SCHED;
            PG8_LDA(At, 0, 1); PG8_STAGE(PG8_SB(0, 0), b2, voffB); PG8_STAGE(PG8_SB(0, 1), b2 + hstepB, voffB); PG8_STAGE(PG8_SA(0, 0), a2, voffA);
            PG8_WAIT_V(8); PG8_WAIT_L(0); PG8_BAR; PG8_MMA(1, 0, At, B0); PG8_MMA(1, 1, At, B1); PG8_BAR; PG8_SCHED;
            PG8_LDB(B0, 1, 0); PG8_LDB(B1, 1, 1); PG8_SCHED; PG8_LDA(At, 1, 0); PG8_STAGE(PG8_SA(0, 1), a2 + hstepA, voffA);
            PG8_WAIT_V(8); PG8_WAIT_L(0); PG8_BAR; PG8_MMA(0, 0, At, B0); PG8_MMA(0, 1, At, B1); PG8_BAR; PG8_SCHED;
            PG8_LDA(At, 1, 1); PG8_STAGE(PG8_SB(1, 0), b3, voffB); PG8_STAGE(PG8_SB(1, 1), b3 + hstepB, voffB); PG8_STAGE(PG8_SA(1, 0), a3, voffA);
            PG8_WAIT_V(8); PG8_WAIT_L(0); PG8_BAR; PG8_MMA(1, 0, At, B0); PG8_MMA(1, 1, At, B1); PG8_BAR; PG8_SCHED;
            } else {
            PG8_LDB(B0, 0, 0); PG8_SCHED; PG8_LDA(At, 0, 0); PG8_STAGE(PG8_SA(1, 1), a1 + hstepA, voffA);
            PG8_WAIT_L(8); PG8_BAR; PG8_WAIT_L(0); PG8_MMA(0, 0, At, B0); PG8_BAR; PG8_SCHED;
            PG8_LDB(B1, 0, 1); PG8_STAGE(PG8_SB(0, 0), b2, voffB);
            PG8_BAR; PG8_WAIT_L(0); PG8_MMA(0, 1, At, B1); PG8_BAR;
            PG8_LDA(At, 0, 1); PG8_STAGE(PG8_SA(0, 0), a2, voffA);
            PG8_BAR; PG8_WAIT_L(0); PG8_MMA(1, 0, At, B0); PG8_BAR; PG8_SCHED;
            PG8_STAGE(PG8_SB(0, 1), b2 + hstepB, voffB);
            PG8_WAIT_V(6); PG8_BAR; PG8_MMA(1, 1, At, B1); PG8_BAR;
            PG8_LDB(B0, 1, 0); PG8_SCHED; PG8_LDA(At, 1, 0); PG8_STAGE(PG8_SA(0, 1), a2 + hstepA, voffA);
            PG8_WAIT_L(8); PG8_BAR; PG8_WAIT_L(0); PG8_MMA(0, 0, At, B0); PG8_BAR; PG8_SCHED;
            PG8_LDB(B1, 1, 1); PG8_STAGE(PG8_SB(1, 0), b3, voffB);
            PG8_BAR; PG8_WAIT_L(0); PG8_MMA(0, 1, At, B1); PG8_BAR;
            PG8_LDA(At, 1, 1); PG8_STAGE(PG8_SA(1, 0), a3, voffA);
            PG8_BAR; PG8_WAIT_L(0); PG8_MMA(1, 0, At, B0); PG8_BAR; PG8_SCHED;
            PG8_STAGE(PG8_SB(1, 1), b3 + hstepB, voffB);
            PG8_WAIT_V(6); PG8_BAR; PG8_MMA(1, 1, At, B1); PG8_BAR;
            }
        }
        }
        if constexpr (ALIGN_EPI) { if (wr == 0) PG8_BAR; }
        if constexpr (!Epi::AFTER_DRAIN) { E(acc, cur, wr, wc, fr, fq); S.done(cur); }
        if (!has_next) break;
#pragma unroll
        for (int a = 0; a < 2; ++a)
#pragma unroll
            for (int b = 0; b < 2; ++b)
#pragma unroll
                for (int m = 0; m < 4; ++m)
#pragma unroll
                    for (int n = 0; n < 2; ++n) acc[a][b][m][n] = (f32x4){0.f, 0.f, 0.f, 0.f};
        cur = nxt; cA = nA; cB = nB; ++ui;
        if constexpr (Sched::PARTIAL) { on0 = cur.rows > wr * 64; on1 = cur.rows > HALF + wr * 64; }
        if constexpr (ALIGN_EPI) { if (wr == 1) PG8_BAR; }
    }
    PG8_WAIT_V(0);
    if constexpr (!ALIGN_EPI) { if (wr == 0) PG8_BAR; }
    PG8_BAR;
    if constexpr (Epi::AFTER_DRAIN) { E.fused(acc, cur, wr, wc, fr, fq, lds, wid, lane); S.done(cur); }
#undef PG8_SA
#undef PG8_SB
#undef PG8_STAGE
#undef PG8_LDA
#undef PG8_LDB
#undef PG8_MMA
#undef PG8_MMAG
#undef PG8_WAIT_V
#undef PG8_WAIT_L
#undef PG8_BAR
#undef PG8_SCHED
}
}
#ifndef PLE_LIGHT
#define PLE_LIGHT 1
#endif
constexpr int NWAVES = 8;
constexpr int S = 8192, DM = 2048, DEPTH = 2;
constexpr int IN_COLS = 3152, LDH = 3328;
constexpr int QW = 1536, KVW = 2048;
constexpr int DFF = 5632, NGU = 2 * DFF, NE = 8, PLE = 256;
constexpr int MAXTILES = 72, XG_ROWS = MAXTILES * 256;
constexpr int H_QA = 0, H_KVA = 512, H_KPE = 768, H_GQ = 832, H_GK = 1088, H_GV = 1344, H_GR = 1856, H_SQ = 2368, H_SK = 2880, H_SV = 3008, H_GLR = 3136;
constexpr float LN_EPS = 1e-5f, RMS_EPS = 1e-6f, ALPHA = 1.4142135623730951f;
constexpr float QSCALE = 0.07216878364870322f * 1.4426950408889634f;

constexpr size_t MiB = 1u << 20;
constexpr size_t WS_CTL = 0, CTL_ZERO_BYTES = 1 * MiB;
constexpr size_t WS_CS = 1 * MiB, WS_SSQ = 3 * MiB, WS_ROUTE = 4 * MiB, WS_GDEC = 5 * MiB, WS_PB = 6 * MiB, WS_XB = 14 * MiB;
constexpr size_t WS_WIN = 46 * MiB, WS_WQB = 72 * MiB, WS_WKVB = 75 * MiB, WS_WOUT = 77 * MiB, WS_WPU = 93 * MiB, WS_WPG = 95 * MiB;
constexpr size_t WS_FGU = 111 * MiB, WS_FD = 155 * MiB, WS_MGU = 177 * MiB, WS_MD = 529 * MiB;
constexpr size_t WS_R1 = 705 * MiB;
constexpr size_t WS_HB = WS_R1, WS_QB = WS_R1 + 52 * MiB, WS_KVB = WS_R1 + 76 * MiB, WS_MIX = WS_R1 + 108 * MiB, WS_GUT = WS_R1 + 140 * MiB, WS_GSP = WS_R1 + 156 * MiB, WS_HMID = WS_R1;
constexpr size_t WS_R2 = 905 * MiB;
constexpr size_t WS_X1F = 1049 * MiB, WS_X1B = 1113 * MiB, WS_PLE = 1145 * MiB, WS_XG = 1209 * MiB, WS_XF = 1281 * MiB, WS_END = 1345 * MiB;
static_assert((size_t)DEPTH * LDH * DM * 2 <= 26 * MiB && (size_t)S * LDH * 2 <= 52 * MiB && (size_t)XG_ROWS * DFF * 2 <= 200 * MiB && (size_t)XG_ROWS * DM * 4 <= 144 * MiB && (size_t)XG_ROWS * DM * 2 <= 72 * MiB, "ws map");
constexpr int CW_TMO = 0, CW_CODE = 1;
constexpr int CW_ECNT = 64;
constexpr int CW_BAR = 4096;
constexpr size_t RT_E = 0, RT_POS = 64 * 1024, RT_W = 128 * 1024, RT_SLOT = 192 * 1024;

constexpr int RING_OFF = 0, RING_BYTES = 131072;
constexpr int TBL = MAXTILES + 24;
constexpr int LDSCTL_OFF = RING_BYTES, MISC_OFF = LDSCTL_OFF + 320, TE_OFF = MISC_OFF + 128;
constexpr int LDS_BYTES = 147456;
static_assert(TE_OFF + 3 * TBL * 4 <= LDS_BYTES, "LDS map");

#define GAS __attribute__((address_space(1)))
#define LAS __attribute__((address_space(3)))
typedef unsigned short bf16;
typedef unsigned v4u __attribute__((ext_vector_type(4)));
typedef unsigned v2u __attribute__((ext_vector_type(2)));
typedef float f32x4 __attribute__((ext_vector_type(4)));
typedef float f32x16 __attribute__((ext_vector_type(16)));
typedef short bf16x8 __attribute__((ext_vector_type(8)));
typedef short s16x4 __attribute__((ext_vector_type(4)));
typedef GAS unsigned gu32;
typedef GAS unsigned long long gu64;
#define RLX_AGENT __ATOMIC_RELAXED, __HIP_MEMORY_SCOPE_AGENT
#define LDS_WAIT() asm volatile("s_waitcnt lgkmcnt(0)" ::: "memory")
#define VM_WAIT() asm volatile("s_waitcnt vmcnt(0)" ::: "memory")
__device__ __forceinline__ float bf2f(unsigned h) { return __builtin_bit_cast(float, h << 16); }
__device__ __forceinline__ unsigned f2bf(float f) { unsigned u = __builtin_bit_cast(unsigned, f); return (u + 0x7fffu + ((u >> 16) & 1u)) >> 16; }
__device__ __forceinline__ unsigned pk2(float lo, float hi) { return f2bf(lo) | (f2bf(hi) << 16); }

#define XB_TMO      128
#define XB_XCNT(j)  (256  + 64 * (j))
#define XB_XSUB(j)  (1280 + 64 * (j))
#define XB_XGEN(j)  (2304 + 64 * (j))
#define XB_TOP      3328
#define XB_TOPGEN   3392
#define XCD_BAR_WORDS 3456
#define XB_SPIN_CAP (1u << 18)

__device__ __forceinline__ unsigned xb_ld(unsigned* p)              { return __hip_atomic_load(p, __ATOMIC_RELAXED, __HIP_MEMORY_SCOPE_AGENT); }
__device__ __forceinline__ unsigned xb_add(unsigned* p, unsigned v) { return __hip_atomic_fetch_add(p, v, __ATOMIC_RELAXED, __HIP_MEMORY_SCOPE_AGENT); }
__device__ __forceinline__ unsigned xb_xcc_id() { return (unsigned)__builtin_amdgcn_s_getreg((3 << 11) | 20) & 0xFu; }
#define XB_SPIN(cond, bar) do { unsigned _sp = 0; while (cond) { __builtin_amdgcn_s_sleep(1); \
    if ((++_sp & 255u) == 0u) { if (xb_ld(&(bar)[XB_TMO])) break; if (_sp > XB_SPIN_CAP) { atomicAdd(&(bar)[XB_TMO], 1u); break; } } } } while (0)

struct XcdBarrier {
    unsigned* bar; unsigned x;
    volatile LAS unsigned* st;
};

__device__ __forceinline__ XcdBarrier xcd_barrier_post(unsigned* bar, volatile LAS unsigned* st) {
    XcdBarrier b; b.bar = bar; b.x = xb_xcc_id(); b.st = st;
    if (threadIdx.x == 0) (void)xb_add(&bar[XB_XCNT(b.x)], 1u);
    return b;
}
__device__ __forceinline__ void xcd_barrier_complete(unsigned* bar, unsigned x, unsigned& nloc, unsigned& nx) {
    const unsigned G = gridDim.x * gridDim.y * gridDim.z;
    unsigned sum, cnt, mine, sp = 0u;
    for (;;) {
        sum = 0u; cnt = 0u; mine = 0u;
#pragma unroll
        for (unsigned j = 0; j < 16; ++j) { const unsigned c = xb_ld(&bar[XB_XCNT(j)]); sum += c; cnt += (c > 0u) ? 1u : 0u; mine = (j == x) ? c : mine; }
        if (sum == G) break;
        __builtin_amdgcn_s_sleep(1);
        if ((++sp & 255u) == 0u) { if (xb_ld(&bar[XB_TMO])) break; if (sp > XB_SPIN_CAP) { atomicAdd(&bar[XB_TMO], 1u); break; } }
    }
    nloc = mine > 0u ? mine : 1u; nx = cnt > 0u ? cnt : 1u;
}

__device__ __forceinline__ void xcd_barrier(const XcdBarrier& b) {
    asm volatile("s_waitcnt vmcnt(0)" ::: "memory");
    __syncthreads();
    if (threadIdx.x == 0) {
        unsigned* bar = b.bar;
        __builtin_amdgcn_s_waitcnt(0);
        unsigned nloc = b.st[0], nx = b.st[1];
        if (nloc == 0u) { xcd_barrier_complete(bar, b.x, nloc, nx); b.st[0] = nloc; b.st[1] = nx; }
        const unsigned old = xb_add(&bar[XB_XSUB(b.x)], 1u);
        const unsigned gen = old / nloc;
        if (old + 1u == (gen + 1u) * nloc) {
            __builtin_amdgcn_fence(__ATOMIC_RELEASE, "agent");
            asm volatile("s_waitcnt vmcnt(0)" ::: "memory");
            const unsigned og = xb_add(&bar[XB_TOP], 1u);
            const unsigned tg = og / nx;
            if (og + 1u == (tg + 1u) * nx) xb_add(&bar[XB_TOPGEN], 1u);
            else XB_SPIN(xb_ld(&bar[XB_TOPGEN]) == tg, bar);
            __builtin_amdgcn_fence(__ATOMIC_ACQUIRE, "agent");
            xb_add(&bar[XB_XGEN(b.x)], 1u);
            asm volatile("s_waitcnt vmcnt(0)" ::: "memory");
        } else {
            XB_SPIN(xb_ld(&bar[XB_XGEN(b.x)]) == gen, bar);
            __builtin_amdgcn_fence(__ATOMIC_ACQUIRE, "agent");
            asm volatile("s_waitcnt vmcnt(0)" ::: "memory");
        }
    }
    __syncthreads();
}

struct Frame {
    LAS unsigned char* lds;
    volatile LAS unsigned* MISC;
    gu32* ctl;
    unsigned char* ws;
    int tid, lane, wave;
    int G, c;
};
__device__ __forceinline__ float wave_sum(float v) {
#pragma unroll
    for (int o = 1; o < 64; o <<= 1) v += __shfl_xor(v, o);
    return v;
}
__device__ __forceinline__ unsigned pk2h(float lo, float hi) { return pg8::cvt_pk_bf16(lo, hi); }

template <int MAP> __device__ __forceinline__ int rowmap(int n) {
    if (MAP == 1) { if (n < 768) return n; if (n < 832) { const int j = n - 768; return 768 + ((j & 31) << 1) + (j >> 5); } if (n < 1856) return n; if (n < 1872) return H_GLR + (n - 1856); return n - 16; }
    if (MAP == 2) { const int hd = n / 192; int j = n - hd * 192; if (j >= 128) { const int jj = j - 128; j = 128 + ((jj & 31) << 1) + (jj >> 5); } return hd * 192 + j; }
    if (MAP == 3) return ((n >> 7) << 8) + (n & 127);
    if (MAP == 4) return ((n >> 7) << 8) + 128 + (n & 127);
    return n;
}
constexpr int P0_PD = 33;
template <int MAP> __device__ __forceinline__ void p0_item(const float* W, int K, int N, bf16* WT, const float* gain, float sc, LAS unsigned* scr, int item, int lane) {
    const int nblk = (N + 127) >> 7, kb = item / nblk, nb = item - kb * nblk, k0 = 64 * kb, n0 = 128 * nb;
    const int g = lane >> 4, n4 = lane & 15;
    f32x4 v[2][16];
#pragma unroll
    for (int hf = 0; hf < 2; ++hf) { const bool nok = (n0 + 64 * hf + 4 * n4) < N;
#pragma unroll
        for (int i = 0; i < 16; ++i) { const int k = 8 * (i >> 1) + 2 * g + (i & 1); v[hf][i] = nok ? __builtin_nontemporal_load((const GAS f32x4*)(W + (size_t)(k0 + k) * N + n0 + 64 * hf + 4 * n4)) : (f32x4){0.f, 0.f, 0.f, 0.f}; } }
    const int c = lane & 7;
#pragma unroll
    for (int hf = 0; hf < 2; ++hf) {
#pragma unroll
        for (int j = 0; j < 8; ++j) { const int k = 8 * j + 2 * g; float s0 = sc, s1 = sc; if (gain) { s0 *= gain[k0 + k]; s1 *= gain[k0 + k + 1]; }
#pragma unroll
            for (int e = 0; e < 4; ++e) scr[(4 * n4 + e) * P0_PD + 4 * j + g] = pk2h(v[hf][2 * j][e] * s0, v[hf][2 * j + 1][e] * s1); }
        LDS_WAIT(); asm volatile("" ::: "memory");
#pragma unroll
        for (int s = 0; s < 8; ++s) { const int nl = 8 * s + (lane >> 3); const LAS unsigned* p = scr + nl * P0_PD + 4 * c;
            v4u o; o.x = p[0]; o.y = p[1]; o.z = p[2]; o.w = p[3];
            if (n0 + 64 * hf + nl < N) *(GAS v4u*)(WT + (size_t)rowmap<MAP>(n0 + 64 * hf + nl) * K + k0 + 8 * c) = o; }
        LDS_WAIT(); asm volatile("" ::: "memory"); }
}
struct In {
    const float *x, *p; const int* pos; const float *w_in, *q_gain, *w_qb, *kv_gain, *w_kvb, *gla_wg, *gla_bg, *gla_ng, *sinks, *relb, *w_out, *ln1g, *ln1b,
        *f_wg, *f_wu, *f_wd, *router, *m_wg, *m_wu, *m_wd, *p_wu, *p_wg, *p_bg, *ln2g, *ln2b;
};
constexpr int I_IN = (DM / 64) * ((IN_COLS + 127) / 128), I_QB = (512 / 64) * (QW / 128), I_KVB = (256 / 64) * (KVW / 128), I_OUT = (DM / 64) * (DM / 128), I_PU = (PLE / 64) * (DM / 128), I_PG = I_OUT;
constexpr int I_GU = (DM / 64) * (DFF / 128), I_D = (DFF / 64) * (DM / 128);
constexpr int I_LAYER = I_IN + I_QB + I_KVB + I_OUT + I_PU + I_PG;
constexpr int NITEMS = DEPTH * I_LAYER + 3 * I_GU + 24 * I_GU;
static_assert(I_D == I_GU, "item counts");
#ifndef BGQ1
#define BGQ1 5
#endif
#ifndef BGQ2
#define BGQ2 5
#endif
#ifndef BGQ3
#define BGQ3 4
#endif
constexpr int HOLE1_WG = 96, HOLE2_WG = 128, HOLE3_WG = 96;
constexpr int HOLE1_N = HOLE1_WG * BGQ1 * 8, HOLE2_N = HOLE2_WG * BGQ2 * 8, HOLE3_N = HOLE3_WG * BGQ3 * 8;
constexpr int N_PRO256 = DEPTH * I_LAYER + 3 * I_GU;
constexpr int N_HOLE0 = N_PRO256 + 16 * I_GU;
static_assert(N_HOLE0 + HOLE1_N + HOLE2_N + HOLE3_N >= NITEMS, "the holes must cover the MoE down weights");
constexpr int TRK_SLOTS = 22, TRK_PER_LAYER = TRK_SLOTS * 256 * NWAVES;
static_assert(DEPTH * TRK_PER_LAYER == 4 * 16 * I_GU && DEPTH == 2, "trickle list");
__device__ __forceinline__ void p0_dispatch(const In& I, unsigned char* ws, LAS unsigned* scr, int it, int lane) {
        int r = it;
        if (r < DEPTH * I_LAYER) {
            const int l = r / I_LAYER; r -= l * I_LAYER;
            if (r < I_IN) { p0_item<1>(I.w_in + (size_t)l * DM * IN_COLS, DM, IN_COLS, (bf16*)(ws + WS_WIN) + (size_t)l * LDH * DM, nullptr, 1.f, scr, r, lane); return; } r -= I_IN;
            if (r < I_QB) { p0_item<2>(I.w_qb + (size_t)l * 512 * QW, 512, QW, (bf16*)(ws + WS_WQB) + (size_t)l * QW * 512, I.q_gain + l * 512, QSCALE, scr, r, lane); return; } r -= I_QB;
            if (r < I_KVB) { p0_item<0>(I.w_kvb + (size_t)l * 256 * KVW, 256, KVW, (bf16*)(ws + WS_WKVB) + (size_t)l * KVW * 256, I.kv_gain + l * 256, 1.f, scr, r, lane); return; } r -= I_KVB;
            if (r < I_OUT) { p0_item<0>(I.w_out + (size_t)l * DM * DM, DM, DM, (bf16*)(ws + WS_WOUT) + (size_t)l * DM * DM, nullptr, 1.f, scr, r, lane); return; } r -= I_OUT;
            if (r < I_PU) { p0_item<0>(I.p_wu + (size_t)l * PLE * DM, PLE, DM, (bf16*)(ws + WS_WPU) + (size_t)l * DM * PLE, nullptr, 1.f, scr, r, lane); return; } r -= I_PU;
            p0_item<0>(I.p_wg + (size_t)l * DM * DM, DM, DM, (bf16*)(ws + WS_WPG) + (size_t)l * DM * DM, nullptr, 1.f, scr, r, lane); return;
        }
        r -= DEPTH * I_LAYER;
        if (r < I_GU) { p0_item<3>(I.f_wg, DM, DFF, (bf16*)(ws + WS_FGU), nullptr, 1.f, scr, r, lane); return; } r -= I_GU;
        if (r < I_GU) { p0_item<4>(I.f_wu, DM, DFF, (bf16*)(ws + WS_FGU), nullptr, 1.f, scr, r, lane); return; } r -= I_GU;
        if (r < I_D) { p0_item<0>(I.f_wd, DFF, DM, (bf16*)(ws + WS_FD), nullptr, 1.f, scr, r, lane); return; } r -= I_D;
        if (r < 16 * I_GU) { const int e = r / (2 * I_GU); r -= e * 2 * I_GU;
          if (r < I_GU) { p0_item<3>(I.m_wg + (size_t)e * DM * DFF, DM, DFF, (bf16*)(ws + WS_MGU) + (size_t)e * NGU * DM, nullptr, 1.f, scr, r, lane); return; } r -= I_GU;
          p0_item<4>(I.m_wu + (size_t)e * DM * DFF, DM, DFF, (bf16*)(ws + WS_MGU) + (size_t)e * NGU * DM, nullptr, 1.f, scr, r, lane); return; }
        r -= 16 * I_GU;
        { const int e = r / I_GU; r -= e * I_GU;
          p0_item<0>(I.m_wd + (size_t)e * DFF * DM, DFF, DM, (bf16*)(ws + WS_MD) + (size_t)e * DM * DFF, nullptr, 1.f, scr, r, lane); }
}
__device__ __forceinline__ void bg_convert(Frame& F, const In& I, int first, int rank, int nw, int q) {
    LAS unsigned* scr = (LAS unsigned*)(F.lds + RING_OFF + F.wave * 16384);
    for (int b = 0; b < q; ++b) { const int it = first + (b * nw + rank) * 8 + F.wave; if (it < NITEMS) p0_dispatch(I, F.ws, scr, it, F.lane); }
    __syncthreads();
}
__device__ __forceinline__ void p0_prologue(Frame& F, const In& I) {
    LAS unsigned* scr = (LAS unsigned*)(F.lds + RING_OFF + F.wave * 16384);
    const int gw = F.c * NWAVES + F.wave, NGW = F.G * NWAVES;
    unsigned char* ws = F.ws;
    const int npro = (F.G == 256) ? N_PRO256 : NITEMS;
    for (int it = gw; it < npro; it += NGW) p0_dispatch(I, ws, scr, it, F.lane);
    const int gt = F.c * (NWAVES * 64) + F.tid, NGT = F.G * NWAVES * 64;
    { const GAS f32x4* xs = (const GAS f32x4*)I.x; GAS v4u* xd = (GAS v4u*)(ws + WS_XB);
      for (int i = gt; i < S * DM / 8; i += NGT) { const f32x4 a = __builtin_nontemporal_load(xs + 2 * i), b = __builtin_nontemporal_load(xs + 2 * i + 1); v4u o; o.x = pk2h(a[0], a[1]); o.y = pk2h(a[2], a[3]); o.z = pk2h(b[0], b[1]); o.w = pk2h(b[2], b[3]); xd[i] = o; }
      const GAS f32x4* ps = (const GAS f32x4*)I.p; GAS v4u* pd = (GAS v4u*)(ws + WS_PB);
      for (int i = gt; i < DEPTH * S * PLE / 8; i += NGT) { const f32x4 a = __builtin_nontemporal_load(ps + 2 * i), b = __builtin_nontemporal_load(ps + 2 * i + 1); v4u o; o.x = pk2h(a[0], a[1]); o.y = pk2h(a[2], a[3]); o.z = pk2h(b[0], b[1]); o.w = pk2h(b[2], b[3]); pd[i] = o; } }
    { float* cs = (float*)(ws + WS_CS);
      for (int i = gt; i < S * 32; i += NGT) { const int t = i >> 5, j = i & 31;
          const float inv = (float)exp2(-(double)j * (13.287712379549449 / 32.0));
          const float ang = (float)I.pos[t] * inv;
          double sn, cn; sincos((double)ang, &sn, &cn);
          cs[(size_t)t * 64 + j] = (float)cn; cs[(size_t)t * 64 + 32 + j] = (float)sn; } }
}

__device__ __forceinline__ f32x4 mfma16(bf16x8 a, bf16x8 b, f32x4 c) { return __builtin_amdgcn_mfma_f32_16x16x32_bf16(a, b, c, 0, 0, 0); }
__device__ __forceinline__ f32x16 mfma32(bf16x8 a, bf16x8 b, f32x16 c) { return __builtin_amdgcn_mfma_f32_32x32x16_bf16(a, b, c, 0, 0, 0); }
__device__ __forceinline__ s16x4 tr_read(const LAS bf16* p) { return __builtin_bit_cast(s16x4, __builtin_amdgcn_ds_read_tr16_b64_v4i16((LAS s16x4*)p)); }
__device__ __forceinline__ int crow(int r, int hi) { return (r & 3) + 8 * (r >> 2) + 4 * hi; }
__device__ __forceinline__ bf16x8 pack8f(float a0, float a1, float a2, float a3, float a4, float a5, float a6, float a7) {
    v4u w; w.x = pk2h(a0, a1); w.y = pk2h(a2, a3); w.z = pk2h(a4, a5); w.w = pk2h(a6, a7); return __builtin_bit_cast(bf16x8, w); }

constexpr int SW_KP = 72, SW_VP = 80;
__device__ __forceinline__ void swa_unit(Frame& F, int n, int hq, const bf16* HB, bf16* MIX, const float* sinks, const float* relb) {
    LAS bf16* Ks = (LAS bf16*)(F.lds + RING_OFF); LAS bf16* Vs = Ks + 256 * SW_KP; LAS float* bias = (LAS float*)(Vs + 256 * SW_VP);
    const int tid = F.tid, lane = F.lane, w = F.wave, hk = hq >> 2;
    const int q = lane & 15, kq = lane >> 4, qi = 16 * w + q; const size_t tq = (size_t)n * 128 + qi;
    bf16x8 qf[2];
#pragma unroll
    for (int ks = 0; ks < 2; ++ks) qf[ks] = *(const GAS bf16x8*)(HB + tq * LDH + H_SQ + hq * 64 + 32 * ks + 8 * kq);
#pragma unroll
    for (int i = 0; i < 4; ++i) { const int c = tid + 512 * i, row = c >> 3, ch = c & 7, tk = (n - 1) * 128 + row;
        v4u kv = (v4u){0u, 0u, 0u, 0u}, vv = (v4u){0u, 0u, 0u, 0u};
        if (tk >= 0) { kv = *(const GAS v4u*)(HB + (size_t)tk * LDH + H_SK + hk * 64 + ch * 8); vv = *(const GAS v4u*)(HB + (size_t)tk * LDH + H_SV + hk * 64 + ch * 8); }
        *(LAS v4u*)(Ks + row * SW_KP + ch * 8) = kv; *(LAS v4u*)(Vs + row * SW_VP + ch * 8) = vv; }
    if (tid < 128) { const int d = tid; int b;
        if (d < 16) b = d; else { const float lg = logf((float)d / 16.0f) / 2.0794415416798357f * 16.0f; b = 16 + (int)lg; if (b > 31) b = 31; }
        bias[d] = relb[b * 8 + hq]; }
    __syncthreads();
    f32x4 s[16];
#pragma unroll
    for (int blk = 0; blk < 16; ++blk) { f32x4 a = (f32x4){0.f, 0.f, 0.f, 0.f};
#pragma unroll
        for (int ks = 0; ks < 2; ++ks) { const bf16x8 kf = *(const LAS bf16x8*)(Ks + (16 * blk + q) * SW_KP + 32 * ks + 8 * kq); a = mfma16(kf, qf[ks], a); }
        s[blk] = a; }
    const float sink = sinks[hq]; float mx = sink;
#pragma unroll
    for (int blk = 0; blk < 16; ++blk)
#pragma unroll
        for (int i = 0; i < 4; ++i) { const int kj = 16 * blk + 4 * kq + i, dist = qi + 128 - kj; const bool valid = (dist >= 0) && (dist < 128) && (n > 0 || kj >= 128);
            const float v = valid ? s[blk][i] * 0.125f + bias[dist & 127] : -1e30f; s[blk][i] = v; mx = fmaxf(mx, v); }
    mx = fmaxf(mx, __shfl_xor(mx, 16)); mx = fmaxf(mx, __shfl_xor(mx, 32));
    float sum = 0.f;
#pragma unroll
    for (int blk = 0; blk < 16; ++blk)
#pragma unroll
        for (int i = 0; i < 4; ++i) { const float p = (s[blk][i] > -1e29f) ? __expf(s[blk][i] - mx) : 0.f; s[blk][i] = p; sum += p; }
    sum += __shfl_xor(sum, 16); sum += __shfl_xor(sum, 32);
    const float inv = 1.0f / (sum + __expf(sink - mx));
    f32x4 o[4];
#pragma unroll
    for (int db = 0; db < 4; ++db) o[db] = (f32x4){0.f, 0.f, 0.f, 0.f};
#pragma unroll
    for (int kk = 0; kk < 8; ++kk) {
        const bf16x8 pf = pack8f(s[2 * kk][0] * inv, s[2 * kk][1] * inv, s[2 * kk][2] * inv, s[2 * kk][3] * inv, s[2 * kk + 1][0] * inv, s[2 * kk + 1][1] * inv, s[2 * kk + 1][2] * inv, s[2 * kk + 1][3] * inv);
#pragma unroll
        for (int db = 0; db < 4; ++db) { const LAS bf16* vp = Vs + (32 * kk + 4 * kq + (q >> 2)) * SW_VP + 16 * db + 4 * (q & 3);
            const s16x4 lo = tr_read(vp), hh = tr_read(vp + 16 * SW_VP);
            o[db] = mfma16((bf16x8){lo[0], lo[1], lo[2], lo[3], hh[0], hh[1], hh[2], hh[3]}, pf, o[db]); } }
#pragma unroll
    for (int db = 0; db < 4; ++db) { v2u ov; ov.x = pk2h(o[db][0], o[db][1]); ov.y = pk2h(o[db][2], o[db][3]);
        *(GAS v2u*)(MIX + tq * DM + 1536 + hq * 64 + 16 * db + 4 * kq) = ov; }
    __syncthreads();
}

constexpr int GP = 72;
constexpr int GVP = 144, GKP = 80;
__device__ __forceinline__ bf16x8 gla_trfrag(const LAS bf16* base, int pitch, int j0, int c0, int fr) {
    const LAS bf16* p = base + (j0 + (fr >> 2)) * pitch + c0 + 4 * (fr & 3); const s16x4 lo = tr_read(p), hh = tr_read(p + 4 * pitch);
    return (bf16x8){lo[0], lo[1], lo[2], lo[3], hh[0], hh[1], hh[2], hh[3]}; }
constexpr int GL_GLR = 0, GL_WG = 4096, GL_BG = 8192, GL_B = 8704, GL_QT = 25344, GL_KT = 34560, GL_KDT = 43776, GL_VT = 52992, GL_SPT = 71424, GL_PP = 89856, GL_END = 99072, GL_OO = 0;
template <int STAGE> __device__ __forceinline__ void gla_unit(Frame& F, int c, int h, const bf16* HB, const float* wg, const float* bg, float* UT, float* DEC, const bf16* SPT, const float* ng, bf16* MIX) {
    LAS unsigned char* L = F.lds + RING_OFF;
    LAS float* glr = (LAS float*)(L + GL_GLR); LAS float* Wg = (LAS float*)(L + GL_WG); LAS float* Bg = (LAS float*)(L + GL_BG); LAS float* B = (LAS float*)(L + GL_B);
    LAS bf16* QT = (LAS bf16*)(L + GL_QT); LAS bf16* KT = (LAS bf16*)(L + GL_KT); LAS bf16* KD = (LAS bf16*)(L + GL_QT)  ; LAS bf16* VR = (LAS bf16*)(L + GL_VT);
    LAS bf16* SP = (LAS bf16*)(L + GL_SPT); LAS bf16* PP = (LAS bf16*)(L + GL_PP); LAS float* OO = (LAS float*)(L + GL_OO);
    const int tid = F.tid, lane = F.lane, w = F.wave; const size_t t0 = (size_t)c * 64;
    const v4u kraw = *(const GAS v4u*)(HB + (t0 + (tid >> 3)) * LDH + H_GK + h * 64 + (tid & 7) * 8);
    v4u qraw = (v4u){0u, 0u, 0u, 0u}; if (STAGE == 3) qraw = *(const GAS v4u*)(HB + (t0 + (tid >> 3)) * LDH + H_GQ + h * 64 + (tid & 7) * 8);
    for (int i = tid; i < 1024; i += 512) { const int r = i >> 4, k = i & 15; glr[i] = bf2f(HB[(t0 + r) * LDH + H_GLR + k]); }
    for (int i = tid; i < 1024; i += 512) { const int r = i >> 6, d = i & 63; Wg[i] = wg[r * 256 + h * 64 + d]; }
    if (tid < 64) Bg[tid] = bg[h * 64 + tid];
#pragma unroll
    for (int i = 0; i < 2; ++i) { const int cc = tid + 512 * i, row = cc >> 4, ch = cc & 15; const v4u vv = *(const GAS v4u*)(HB + (t0 + row) * LDH + H_GV + h * 128 + ch * 8);
        *(LAS v4u*)(VR + row * GVP + ch * 8) = vv; }
    if (STAGE == 3) {
#pragma unroll
        for (int i = 0; i < 2; ++i) { const int cc = tid + 512 * i, row = cc >> 3, ch = cc & 7; *(LAS v4u*)(SP + row * GP + ch * 8) = *(const GAS v4u*)(SPT + ((size_t)(c * 4 + h) * 128 + row) * 64 + ch * 8); } }
    __syncthreads();
#pragma unroll
    for (int i = 0; i < 8; ++i) { const int idx = tid + 512 * i, r = idx >> 6, d = idx & 63; float z = Bg[d];
#pragma unroll
        for (int k = 0; k < 16; ++k) z += glr[r * 16 + k] * Wg[k * 64 + d];
        const float ls = fminf(z, 0.f) - 0.6931471805599453f * __builtin_amdgcn_logf(1.0f + __builtin_amdgcn_exp2f(-1.4426950408889634f * fabsf(z))); B[r * 65 + d] = ls * (1.0f / 16.0f); }
    __syncthreads();
    { const int col = tid & 63, seg = tid >> 6; LAS float* SEG = glr;
      float v[8]; float a = 0.f;
#pragma unroll
      for (int k = 0; k < 8; ++k) { a += B[(8 * seg + k) * 65 + col]; v[k] = a; }
      SEG[seg * 64 + col] = a;
      __syncthreads();
      float off = 0.f;
#pragma unroll
      for (int q = 0; q < 7; ++q) off += (q < seg) ? SEG[q * 64 + col] : 0.f;
#pragma unroll
      for (int k = 0; k < 8; ++k) B[(8 * seg + k) * 65 + col] = v[k] + off; }
    __syncthreads();
    { const int i = tid >> 3, d0 = (tid & 7) * 8;
      if (STAGE == 1) {
          float kd[8];
#pragma unroll
          for (int e = 0; e < 8; ++e) { const float kv = bf2f((kraw[e >> 1] >> (16 * (e & 1))) & 0xffffu); kd[e] = kv * __expf(B[63 * 65 + d0 + e] - B[i * 65 + d0 + e]); }
          *(LAS bf16x8*)(KD + i * GKP + d0) = pack8f(kd[0], kd[1], kd[2], kd[3], kd[4], kd[5], kd[6], kd[7]);
          if (i == 63) {
#pragma unroll
              for (int e = 0; e < 8; ++e) DEC[(size_t)(c * 4 + h) * 64 + d0 + e] = __expf(B[63 * 65 + d0 + e]); }
      } else {
          float qv[8], kv[8];
#pragma unroll
          for (int e = 0; e < 8; ++e) { const float b = B[i * 65 + d0 + e]; qv[e] = bf2f((qraw[e >> 1] >> (16 * (e & 1))) & 0xffffu) * 0.125f * __expf(b); kv[e] = bf2f((kraw[e >> 1] >> (16 * (e & 1))) & 0xffffu) * __expf(-b); }
          *(LAS bf16x8*)(QT + i * GP + d0) = pack8f(qv[0], qv[1], qv[2], qv[3], qv[4], qv[5], qv[6], qv[7]);
          *(LAS bf16x8*)(KT + i * GP + d0) = pack8f(kv[0], kv[1], kv[2], kv[3], kv[4], kv[5], kv[6], kv[7]); } }
    __syncthreads();
    const int fr = lane & 15, fq = lane >> 4, rb = w & 3, cb = w >> 2;
    if (STAGE == 1) {
        bf16x8 af[2];
#pragma unroll
        for (int ks = 0; ks < 2; ++ks) af[ks] = gla_trfrag(KD, GKP, 32 * ks + 8 * fq, 16 * rb, fr);
#pragma unroll
        for (int eb = 0; eb < 4; ++eb) { f32x4 a = (f32x4){0.f, 0.f, 0.f, 0.f}; const int e0 = 16 * (4 * cb + eb);
#pragma unroll
            for (int ks = 0; ks < 2; ++ks) { const bf16x8 bfr = gla_trfrag(VR, GVP, 32 * ks + 8 * fq, e0, fr); a = mfma16(af[ks], bfr, a); }
            *(GAS f32x4*)(UT + ((size_t)(c * 4 + h) * 128 + e0 + fr) * 64 + 16 * rb + 4 * fq) = a; }
        __syncthreads();
    } else {
        { bf16x8 af[2];
#pragma unroll
          for (int ks = 0; ks < 2; ++ks) af[ks] = *(const LAS bf16x8*)(QT + (16 * rb + fr) * GP + 32 * ks + 8 * fq);
#pragma unroll
          for (int jb = 0; jb < 2; ++jb) { f32x4 a = (f32x4){0.f, 0.f, 0.f, 0.f}; const int j0 = 16 * (2 * cb + jb);
#pragma unroll
              for (int ks = 0; ks < 2; ++ks) { const bf16x8 bfr = *(const LAS bf16x8*)(KT + (j0 + fr) * GP + 32 * ks + 8 * fq); a = mfma16(af[ks], bfr, a); }
#pragma unroll
              for (int i = 0; i < 4; ++i) { const int ii = 16 * rb + 4 * fq + i, jj = j0 + fr; PP[ii * GP + jj] = (bf16)(pk2h(jj <= ii ? a[i] : 0.f, 0.f) & 0xffffu); } } }
        __syncthreads();
        f32x4 o[4];
        { bf16x8 pf[2], qf[2];
#pragma unroll
          for (int ks = 0; ks < 2; ++ks) { pf[ks] = *(const LAS bf16x8*)(PP + (16 * rb + fr) * GP + 32 * ks + 8 * fq); qf[ks] = *(const LAS bf16x8*)(QT + (16 * rb + fr) * GP + 32 * ks + 8 * fq); }
#pragma unroll
          for (int eb = 0; eb < 4; ++eb) { f32x4 a = (f32x4){0.f, 0.f, 0.f, 0.f}; const int e0 = 16 * (4 * cb + eb);
#pragma unroll
              for (int ks = 0; ks < 2; ++ks) { const bf16x8 vb = gla_trfrag(VR, GVP, 32 * ks + 8 * fq, e0, fr); a = mfma16(pf[ks], vb, a);
                  const bf16x8 sb = *(const LAS bf16x8*)(SP + (e0 + fr) * GP + 32 * ks + 8 * fq); a = mfma16(qf[ks], sb, a); }
              o[eb] = a; } }
        __syncthreads();
#pragma unroll
        for (int eb = 0; eb < 4; ++eb)
#pragma unroll
            for (int i = 0; i < 4; ++i) OO[(16 * rb + 4 * fq + i) * 132 + 16 * (4 * cb + eb) + fr] = o[eb][i];
        __syncthreads();
        { const int i = tid >> 3, e0 = (tid & 7) * 16; float v[16]; float ss = 0.f;
#pragma unroll
          for (int e = 0; e < 16; ++e) { v[e] = OO[i * 132 + e0 + e]; ss += v[e] * v[e]; }
          ss += __shfl_xor(ss, 1); ss += __shfl_xor(ss, 2); ss += __shfl_xor(ss, 4);
          const float rinv = 1.0f / sqrtf(ss * (1.0f / 128.0f) + RMS_EPS);
          const bf16* rp = HB + (t0 + i) * LDH + H_GR + h * 128 + e0; const float* gp = ng + h * 128 + e0;
          const v4u r0 = *(const GAS v4u*)rp, r1 = *(const GAS v4u*)(rp + 8);
          float ov[16];
#pragma unroll
          for (int e = 0; e < 16; ++e) { const unsigned rw = (e < 8 ? r0[e >> 1] : r1[(e - 8) >> 1]); const float rv = bf2f((rw >> (16 * (e & 1))) & 0xffffu);
              ov[e] = v[e] * rinv * gp[e] * (rv * pg8::fast_sigmoid(rv)); }
          bf16* op = MIX + (t0 + i) * DM + 1024 + h * 128 + e0;
          *(GAS bf16x8*)op = pack8f(ov[0], ov[1], ov[2], ov[3], ov[4], ov[5], ov[6], ov[7]);
          *(GAS bf16x8*)(op + 8) = pack8f(ov[8], ov[9], ov[10], ov[11], ov[12], ov[13], ov[14], ov[15]); }
        __syncthreads();
    }
}
__device__ __forceinline__ void gla_scan(Frame& F, const float* UT, const float* DEC, bf16* SPT) {
    const int gt = F.c * (NWAVES * 64) + F.tid; if (gt >= 4 * 128 * 64) return;
    const int d = gt & 63, he = gt >> 6, h = he >> 7;
    float s = 0.f;
#pragma unroll 8
    for (int c = 0; c < 128; ++c) { const size_t o = ((size_t)c * 512 + he) * 64 + d; SPT[o] = (bf16)(pk2h(s, 0.f) & 0xffffu); s = DEC[(size_t)(c * 4 + h) * 64 + d] * s + UT[o]; }
}

constexpr int ML_KP = 200, ML_VP = 160;
constexpr int ML_KB = 64 * ML_KP * 2, ML_VB = 64 * ML_VP * 2, ML_STAGE = ML_KB + ML_VB;
static_assert(2 * ML_STAGE <= RING_BYTES && 4 * 64 * 64 * 4 + 4 * 2 * 64 * 4 <= 2 * ML_STAGE, "MLA LDS");
__device__ __forceinline__ void glds16(const void* gsrc, unsigned lds_dst) { unsigned keep;
    asm volatile("s_mov_b32 %0, m0\n\ts_mov_b32 m0, %2\n\ts_nop 0\n\tglobal_load_lds_dwordx4 %1, off\n\ts_mov_b32 m0, %0" : "=&s"(keep) : "v"(gsrc), "s"(lds_dst) : "memory"); }
__device__ __forceinline__ void trk_decode(int mi, const float* m_wg, const float* m_wu, bf16* MGU, const float*& src, bf16*& dst) {
    const int it = mi >> 2, qn = mi & 3, e = it / (2 * I_GU), r = it - e * 2 * I_GU, up = r >= I_GU ? 1 : 0, idx = r - up * I_GU, kb = idx / 44, nb = idx - kb * 44;
    src = (up ? m_wu : m_wg) + (size_t)e * DM * DFF + (size_t)(64 * kb) * DFF + 128 * nb + 32 * qn;
    dst = MGU + (size_t)e * NGU * DM + (size_t)(256 * nb + 128 * up + 32 * qn) * DM + 64 * kb;
}
__device__ __forceinline__ void mla_unit(Frame& F, int h, int qb, const bf16* QB, const bf16* KVB, const bf16* HB, bf16* MIX, const int g0, const int trk, const float* m_wg, const float* m_wu, bf16* MGU) {
    LAS unsigned char* L = F.lds + RING_OFF;
    int tid_ = F.tid; asm volatile("" : "+v"(tid_));
    const int tid = tid_, lane = tid & 63, w = F.wave, rg = w & 3, kh = w >> 2, r32 = lane & 31, hi = lane >> 5;
    const int q0 = 128 * qb, NT = 2 * qb + 2, qabs = q0 + 32 * rg + r32;
    bf16x8 qf[12];
    { const bf16* qp = QB + (size_t)qabs * QW + h * 192 + 8 * hi;
#pragma unroll
      for (int ks = 0; ks < 12; ++ks) qf[ks] = *(const GAS bf16x8*)(qp + 16 * ks); }
    unsigned doff[6]; bool dpe[6];
#pragma unroll
    for (int i = 0; i < 6; ++i) { const int jn = w + 8 * i;
        if (jn < 25) { const int c = 64 * jn + lane, row = c / 25, ch = c - 25 * row;
            dpe[i] = (ch >= 16 && ch < 24);
            doff[i] = dpe[i] ? (unsigned)(row * LDH + H_KPE + (ch - 16) * 8) * 2u : (unsigned)(row * KVW + h * 256 + (ch < 16 ? ch : 0) * 8) * 2u; }
        else { const int c = 64 * (jn - 25) + lane, row = c / 20, ch = c - 20 * row;
            dpe[i] = false; doff[i] = (unsigned)(row * KVW + h * 256 + 128 + (ch < 16 ? ch : 0) * 8) * 2u; } }
#define ML_DMA(t, b) do { const char* kb_ = (const char*)KVB + (size_t)(t) * (64 * KVW * 2); const char* pb_ = (const char*)HB + (size_t)(t) * (64 * LDH * 2); \
        _Pragma("unroll") for (int i_ = 0; i_ < 6; ++i_) { const int jn_ = w + 8 * i_; if (jn_ < 45) { const char* g_ = (dpe[i_] ? pb_ : kb_) + doff[i_]; \
            glds16(g_, (unsigned)__builtin_amdgcn_readfirstlane((int)(lds0 + (b) * ML_STAGE + jn_ * 1024))); } } } while (0)
    const unsigned lds0 = (unsigned)(size_t)L;
    ML_DMA(0, 0);
#pragma unroll
    for (int ks = 0; ks < 12; ++ks) asm volatile("" :: "v"(qf[ks]));
    asm volatile("s_waitcnt vmcnt(0)" ::: "memory");
    __syncthreads();
    float m = -60000.f, l = 0.f; f32x16 o[4];
#pragma unroll
    for (int db = 0; db < 4; ++db)
#pragma unroll
        for (int r = 0; r < 16; ++r) o[db][r] = 0.f;
    const int li = lane & 15, trow = li >> 2, tcol = 16 * ((lane >> 4) & 1) + 4 * (li & 3);
    int gph = g0 % 6, sl = g0 / 6; f32x4 tv[8];
#pragma unroll
    for (int i = 0; i < 8; ++i) tv[i] = (f32x4){0.f, 0.f, 0.f, 0.f};
    const int tg8 = lane >> 3, tc = lane & 7;
    for (int t = 0; t < NT; ++t) {
        const bool more = (t + 1 < NT);
        if (trk >= 0 && gph == 1) { const float* src; bf16* dst; trk_decode(trk + sl * (256 * NWAVES), m_wg, m_wu, MGU, src, dst);
            LAS unsigned* scr = (LAS unsigned*)(L + 2 * ML_STAGE + w * (32 * 33 * 4));
#pragma unroll
            for (int j = 0; j < 4; ++j)
#pragma unroll
                for (int e = 0; e < 4; ++e) scr[(4 * tc + e) * 33 + tg8 + 8 * j] = pk2h(tv[2 * j][e], tv[2 * j + 1][e]);
            LDS_WAIT(); asm volatile("" ::: "memory");
#pragma unroll
            for (int s4 = 0; s4 < 4; ++s4) { const int nl = 8 * s4 + tg8; const LAS unsigned* p = scr + nl * 33 + 4 * tc;
                v4u o; o.x = p[0]; o.y = p[1]; o.z = p[2]; o.w = p[3];
                *(GAS v4u*)(dst + (size_t)nl * DM + 8 * tc) = o; }
            LDS_WAIT(); asm volatile("" ::: "memory"); }
        if (more) ML_DMA(t + 1, (t + 1) & 1);
        const bool tld = (trk >= 0 && gph == 0);
        if (tld) { const float* src; bf16* dst; trk_decode(trk + sl * (256 * NWAVES), m_wg, m_wu, MGU, src, dst);
#pragma unroll
            for (int i = 0; i < 8; ++i) tv[i] = __builtin_nontemporal_load((const GAS f32x4*)(src + (size_t)(2 * tg8 + (i & 1) + 16 * (i >> 1)) * DFF + 4 * tc)); }
        if (++gph == 6) { gph = 0; ++sl; }
        const LAS bf16* Kb = (const LAS bf16*)(L + (t & 1) * ML_STAGE); const LAS bf16* Vb = (const LAS bf16*)(L + (t & 1) * ML_STAGE + ML_KB);
        f32x16 p;
#pragma unroll
        for (int r = 0; r < 16; ++r) p[r] = 0.f;
        { const LAS bf16* kp = Kb + (32 * kh + r32) * ML_KP + 8 * hi; bf16x8 kf[12];
#pragma unroll
          for (int ks = 0; ks < 12; ++ks) kf[ks] = *(const LAS bf16x8*)(kp + 16 * ks);
          __builtin_amdgcn_sched_barrier(0);
#pragma unroll
          for (int ks = 0; ks < 12; ++ks) p = mfma32(kf[ks], qf[ks], p); }
        if (t >= NT - 2) { const int kb = 64 * t + 32 * kh;
#pragma unroll
            for (int r = 0; r < 16; ++r) if (kb + crow(r, hi) > qabs) p[r] = -1e30f; }
        float tm = p[0];
#pragma unroll
        for (int r = 1; r < 16; ++r) tm = fmaxf(tm, p[r]);
        { float sa = tm, sb = tm;
          asm volatile("s_nop 1\n\tv_permlane32_swap_b32_e32 %0, %1\n\ts_nop 1\n\tv_max_f32_e32 %0, %0, %1\n\ts_nop 0" : "+v"(sa), "+v"(sb));
          tm = sa; }
        const float mn = fmaxf(m, tm), alpha = __builtin_amdgcn_exp2f(m - mn);
        float rs = 0.f;
#pragma unroll
        for (int r = 0; r < 16; ++r) { const float e = __builtin_amdgcn_exp2f(p[r] - mn); p[r] = e; rs += e; }
        { float sa = rs, sb = rs;
          asm volatile("s_nop 1\n\tv_permlane32_swap_b32_e32 %0, %1\n\ts_nop 1\n\tv_add_f32_e32 %0, %0, %1\n\ts_nop 0" : "+v"(sa), "+v"(sb));
          rs = sa; }
        l = l * alpha + rs; m = mn;
        if (__any(alpha != 1.0f)) {
#pragma unroll
            for (int db = 0; db < 4; ++db)
#pragma unroll
                for (int r = 0; r < 16; ++r) o[db][r] *= alpha; }
        bf16x8 pf[2];
        pf[0] = pack8f(p[0], p[1], p[2], p[3], p[4], p[5], p[6], p[7]); pf[1] = pack8f(p[8], p[9], p[10], p[11], p[12], p[13], p[14], p[15]);
        { s16x4 vlo[2][4], vhh[2][4];
#pragma unroll
          for (int s = 0; s < 2; ++s) { const LAS bf16* vp = Vb + (32 * kh + 16 * s + 4 * hi + trow) * ML_VP + tcol;
#pragma unroll
              for (int db = 0; db < 4; ++db) { vlo[s][db] = tr_read(vp + 32 * db); vhh[s][db] = tr_read(vp + 8 * ML_VP + 32 * db); } }
          __builtin_amdgcn_sched_barrier(0);
#pragma unroll
          for (int s = 0; s < 2; ++s)
#pragma unroll
              for (int db = 0; db < 4; ++db) { const bf16x8 vf = (bf16x8){vlo[s][db][0], vlo[s][db][1], vlo[s][db][2], vlo[s][db][3], vhh[s][db][0], vhh[s][db][1], vhh[s][db][2], vhh[s][db][3]};
                  o[db] = mfma32(vf, pf[s], o[db]); } }
        if (tld) asm volatile("s_waitcnt vmcnt(8) lgkmcnt(0)" ::: "memory"); else asm volatile("s_waitcnt vmcnt(0) lgkmcnt(0)" ::: "memory");
        __builtin_amdgcn_s_barrier();
        asm volatile("" ::: "memory");
    }
#undef ML_DMA
    LAS float* MS = (LAS float*)L; LAS float* ML = (LAS float*)(L + 4 * 64 * 64 * 4);
    if (kh == 1) {
#pragma unroll
        for (int db = 0; db < 4; ++db)
#pragma unroll
            for (int r = 0; r < 16; ++r) MS[(rg * 64 + db * 16 + r) * 64 + lane] = o[db][r];
        ML[(rg * 2 + 0) * 64 + lane] = m; ML[(rg * 2 + 1) * 64 + lane] = l; }
    __syncthreads();
    if (kh == 0) {
        const float m1 = ML[(rg * 2 + 0) * 64 + lane], l1 = ML[(rg * 2 + 1) * 64 + lane];
        const float mt = fmaxf(m, m1), a0 = __builtin_amdgcn_exp2f(m - mt), a1 = __builtin_amdgcn_exp2f(m1 - mt);
        const float inv = 1.0f / (l * a0 + l1 * a1), w0 = a0 * inv, w1 = a1 * inv;
        bf16* op = MIX + (size_t)qabs * DM + h * 128 + 4 * hi;
#pragma unroll
        for (int db = 0; db < 4; ++db)
#pragma unroll
            for (int g = 0; g < 4; ++g) { float v[4];
#pragma unroll
                for (int e = 0; e < 4; ++e) { const int r = 4 * g + e; v[e] = o[db][r] * w0 + MS[(rg * 64 + db * 16 + r) * 64 + lane] * w1; }
                v2u ov; ov.x = pk2h(v[0], v[1]); ov.y = pk2h(v[2], v[3]); *(GAS v2u*)(op + 32 * db + 8 * g) = ov; } }
    __syncthreads();
}

__device__ __forceinline__ f32x4 ld4bf(const bf16* p) { const v2u r = __builtin_nontemporal_load((const GAS v2u*)p);     return (f32x4){__builtin_bit_cast(float, r.x << 16), __builtin_bit_cast(float, r.x & 0xffff0000u), __builtin_bit_cast(float, r.y << 16), __builtin_bit_cast(float, r.y & 0xffff0000u)}; }
template <int MODE, bool ROUTE> __device__ __forceinline__ void ln_phase(Frame& F, const void* Yv, const bf16* X1, const bf16* PLEB, const float* gam, const float* bet, float* OF, bf16* OB, const float* router) {
    unsigned char* ws = F.ws;
    LAS float* Wr = (LAS float*)(F.lds + RING_OFF);
    if (ROUTE) { for (int i = F.tid; i < DM * 8 / 4; i += NWAVES * 64) ((LAS f32x4*)Wr)[i] = ((const GAS f32x4*)router)[i]; __syncthreads(); }
    const int gw = F.c * NWAVES + F.wave, NGW = F.G * NWAVES, lane = F.lane;
    for (int row = gw; row < S; row += NGW) {
        f32x4 v[8]; float s = 0.f;
        if (MODE == 0) { const GAS f32x4* yp = (const GAS f32x4*)((const float*)Yv + (size_t)row * DM) + lane;
#pragma unroll
            for (int j = 0; j < 8; ++j) v[j] = __builtin_nontemporal_load(yp + 64 * j);
        } else {
            const bf16* xp = X1 + (size_t)row * DM + 4 * lane; const bf16* pp = PLEB + (size_t)row * DM + 4 * lane; const bf16* Y = (const bf16*)Yv;
            if (MODE == 1) { const bf16* yp = Y + (size_t)row * DM + 4 * lane;
#pragma unroll
                for (int j = 0; j < 8; ++j) v[j] = ALPHA * ld4bf(xp + 256 * j) + ld4bf(yp + 256 * j) + ld4bf(pp + 256 * j);
            } else {
                const int* slot = (const int*)(ws + WS_ROUTE + RT_SLOT) + 2 * row; const float* tw = (const float*)(ws + WS_ROUTE + RT_W) + 2 * row;
                const int s0 = slot[0], s1 = slot[1]; const float w0 = tw[0], w1 = tw[1];
                const bf16* y0 = Y + (size_t)s0 * DM + 4 * lane; const bf16* y1 = Y + (size_t)s1 * DM + 4 * lane;
#pragma unroll
                for (int j = 0; j < 8; ++j) v[j] = ALPHA * ld4bf(xp + 256 * j) + (w0 * ld4bf(y0 + 256 * j) + w1 * ld4bf(y1 + 256 * j)) + ld4bf(pp + 256 * j);
            }
        }
#pragma unroll
        for (int j = 0; j < 8; ++j) s += (v[j][0] + v[j][1]) + (v[j][2] + v[j][3]);
        const float mean = wave_sum(s) * (1.0f / DM); float s2 = 0.f;
#pragma unroll
        for (int j = 0; j < 8; ++j) { v[j] = v[j] - mean; s2 += (v[j][0] * v[j][0] + v[j][1] * v[j][1]) + (v[j][2] * v[j][2] + v[j][3] * v[j][3]); }
        const float rstd = 1.0f / sqrtf(wave_sum(s2) * (1.0f / DM) + LN_EPS);
#pragma unroll
        for (int j = 0; j < 8; ++j) { const f32x4 g = ((const GAS f32x4*)gam)[lane + 64 * j], b = ((const GAS f32x4*)bet)[lane + 64 * j]; v[j] = v[j] * rstd * g + b; }
        if (OF) { GAS f32x4* of = (GAS f32x4*)(OF + (size_t)row * DM) + lane;
#pragma unroll
            for (int j = 0; j < 8; ++j) of[64 * j] = v[j]; }
        if (OB) { GAS v2u* ob = (GAS v2u*)(OB + (size_t)row * DM) + lane;
#pragma unroll
            for (int j = 0; j < 8; ++j) { v2u o; o.x = pk2h(v[j][0], v[j][1]); o.y = pk2h(v[j][2], v[j][3]); ob[64 * j] = o; } }
        if (ROUTE) {
            float lg[8];
#pragma unroll
            for (int e = 0; e < 8; ++e) lg[e] = 0.f;
#pragma unroll
            for (int j = 0; j < 8; ++j) { __builtin_amdgcn_sched_barrier(0);
#pragma unroll
                for (int k = 0; k < 4; ++k) { const int col = 4 * (lane + 64 * j) + k; const f32x4 wa = *(const LAS f32x4*)(Wr + col * 8), wb = *(const LAS f32x4*)(Wr + col * 8 + 4); const float xv = v[j][k];
                    lg[0] += xv * wa[0]; lg[1] += xv * wa[1]; lg[2] += xv * wa[2]; lg[3] += xv * wa[3]; lg[4] += xv * wb[0]; lg[5] += xv * wb[1]; lg[6] += xv * wb[2]; lg[7] += xv * wb[3]; } }
#pragma unroll
            for (int e = 0; e < 8; ++e) lg[e] = wave_sum(lg[e]);
            int i0 = 0; float v0 = lg[0];
#pragma unroll
            for (int e = 1; e < 8; ++e) if (lg[e] > v0) { v0 = lg[e]; i0 = e; }
            int i1 = -1; float v1 = -3.0e38f;
#pragma unroll
            for (int e = 0; e < 8; ++e) if (e != i0 && lg[e] > v1) { v1 = lg[e]; i1 = e; }
            if (lane == 0) { const float w0 = 1.0f / (1.0f + __expf(v1 - v0));
                const int p0 = (int)__hip_atomic_fetch_add(F.ctl + CW_ECNT + i0, 1u, RLX_AGENT), p1 = (int)__hip_atomic_fetch_add(F.ctl + CW_ECNT + i1, 1u, RLX_AGENT);
                int* te = (int*)(ws + WS_ROUTE + RT_E) + 2 * row; int* tp = (int*)(ws + WS_ROUTE + RT_POS) + 2 * row; float* tw = (float*)(ws + WS_ROUTE + RT_W) + 2 * row;
                te[0] = i0; te[1] = i1; tp[0] = p0; tp[1] = p1; tw[0] = w0; tw[1] = 1.0f - w0; }
        }
    }
    if (ROUTE) __syncthreads();
}
__device__ __forceinline__ void moe_tables(Frame& F) {
    LAS int* TE = (LAS int*)(F.lds + TE_OFF); LAS int* TR = TE + TBL; LAS int* TV = TR + TBL; LAS int* CN = TE + MAXTILES + 8;
    if (F.tid < NE) CN[F.tid] = (int)__hip_atomic_load(F.ctl + CW_ECNT + F.tid, RLX_AGENT);
    __syncthreads();
    if (F.tid == 0) { int t = 0;
        for (int pass = 0; pass < 2; ++pass) { int ptile = 0;
            for (int e = 0; e < NE; ++e) { const int cnt = CN[e], nt = (cnt + 255) >> 8;
                for (int k = 0; k < nt; ++k, ++ptile) { const int rows = (cnt - 256 * k) < 256 ? (cnt - 256 * k) : 256;
                    if ((MOE_PARTIAL ? ((rows < 256) == (pass == 0)) : (pass == 0)) && t < MAXTILES) { TE[t] = e; TR[t] = ptile; TV[t] = rows; ++t; } } } }
        TE[MAXTILES] = t; }
    __syncthreads();
}
__device__ __forceinline__ void moe_gather(Frame& F, const bf16* X1B, bf16* XG) {
    unsigned char* ws = F.ws;
    int base[NE]; { int acc = 0;
#pragma unroll
        for (int e = 0; e < NE; ++e) { base[e] = acc; const int cnt = (int)__hip_atomic_load(F.ctl + CW_ECNT + e, RLX_AGENT); acc += ((cnt + 255) >> 8) << 8; } }
    const int gw = F.c * NWAVES + F.wave, NGW = F.G * NWAVES, lane = F.lane;
    for (int it = gw; it < 2 * S; it += NGW) { const int row = it >> 1, k = it & 1;
        const int e = ((const int*)(ws + WS_ROUTE + RT_E))[it], pos = ((const int*)(ws + WS_ROUTE + RT_POS))[it];
        int b = 0;
#pragma unroll
        for (int j = 0; j < NE; ++j) b = (e == j) ? base[j] : b;
        const int slot = b + pos;
        if (lane == 0) ((int*)(ws + WS_ROUTE + RT_SLOT))[it] = slot;
        const GAS v4u* src = (const GAS v4u*)(X1B + (size_t)row * DM) + lane; GAS v4u* dst = (GAS v4u*)(XG + (size_t)slot * DM) + lane;
#pragma unroll
        for (int j = 0; j < 4; ++j) dst[64 * j] = src[64 * j]; (void)k; }
}

#ifndef PG8_SP2
#define PG8_SP2 true
#endif
constexpr int PT_OFF = TE_OFF + 3 * TBL * 4;
static_assert(PT_OFF % 8 == 0 && PT_OFF + 32 * 8 <= LDS_BYTES, "LDS map");
extern __shared__ __attribute__((aligned(16))) unsigned char lds_dyn[];
__device__ __forceinline__ const float* ptr_in(int i) { const unsigned long long v = ((const LAS unsigned long long*)((LAS unsigned char*)lds_dyn + PT_OFF))[i];
    const unsigned lo = __builtin_amdgcn_readfirstlane((unsigned)v), hi = __builtin_amdgcn_readfirstlane((unsigned)(v >> 32)); return (const float*)(const GAS float*)(((unsigned long long)hi << 32) | lo); }
__device__ __forceinline__ void make_frame(Frame& F) {
    F.lds = (LAS unsigned char*)lds_dyn; F.MISC = (volatile LAS unsigned*)(F.lds + MISC_OFF);
    { int t = threadIdx.x; asm volatile("" : "+v"(t)); F.tid = t; } F.lane = F.tid & 63; F.wave = __builtin_amdgcn_readfirstlane(F.tid >> 6);
    { int gg = gridDim.x, cc = blockIdx.x; asm volatile("" : "+s"(gg), "+s"(cc)); F.G = gg; F.c = cc; } F.ws = (unsigned char*)ptr_in(29); F.ctl = (gu32*)(F.ws + WS_CTL);
}
__device__ __forceinline__ void load_in(In& I) {
    I.x = ptr_in(0); I.p = ptr_in(1); I.pos = (const int*)ptr_in(2); I.w_in = ptr_in(3); I.q_gain = ptr_in(4); I.w_qb = ptr_in(5); I.kv_gain = ptr_in(6); I.w_kvb = ptr_in(7);
    I.gla_wg = ptr_in(8); I.gla_bg = ptr_in(9); I.gla_ng = ptr_in(10); I.sinks = ptr_in(11); I.relb = ptr_in(12); I.w_out = ptr_in(13); I.ln1g = ptr_in(14); I.ln1b = ptr_in(15);
    I.f_wg = ptr_in(16); I.f_wu = ptr_in(17); I.f_wd = ptr_in(18); I.router = ptr_in(19); I.m_wg = ptr_in(20); I.m_wu = ptr_in(21); I.m_wd = ptr_in(22); I.p_wu = ptr_in(23);
    I.p_wg = ptr_in(24); I.p_bg = ptr_in(25); I.ln2g = ptr_in(26); I.ln2b = ptr_in(27);
}
typedef pg8::bf16_t pb;
#define WSP(T, off) ((T*)(F.ws + (off)))
#ifndef PHASE_ATTR
#define PHASE_ATTR __forceinline__
#endif
#define PHASE static __device__ PHASE_ATTR void

PHASE ph_prologue() { Frame F; make_frame(F); In I; load_in(I); p0_prologue(F, I); }
PHASE ph_in(int l) { Frame F; make_frame(F);
    pg8::Gemm g{WSP(const pb, WS_XB), WSP(const pb, WS_WIN) + (size_t)l * LDH * DM, DM, DM, DM}; pg8::StaticOrder So; So.init(S, LDH, F.G, F.c);
    pg8::EpiIn E{WSP(pb, WS_HB), LDH, WSP(float, WS_SSQ), WSP(const float, WS_CS)};
    pg8::gemm_phase<pg8::EpiIn, pg8::StaticOrder, true, PG8_SP2>(F.lds + RING_OFF, g, So, E, F.tid);
    if (F.G == 256 && F.c >= 256 - HOLE1_WG) { In I; load_in(I); if (l == 0) bg_convert(F, I, N_HOLE0, F.c - (256 - HOLE1_WG), HOLE1_WG, BGQ1); else bg_convert(F, I, N_HOLE0 + HOLE1_N + HOLE2_N, F.c - (256 - HOLE3_WG), HOLE3_WG, BGQ3); } }
PHASE ph_upq(int l) { Frame F; make_frame(F);
    pg8::Gemm g{WSP(const pb, WS_HB) + H_QA, WSP(const pb, WS_WQB) + (size_t)l * QW * 512, LDH, 512, 512}; pg8::StaticOrder So; So.init(S, QW, F.G, F.c);
    pg8::EpiUp<true> E{WSP(pb, WS_QB), QW, WSP(const float, WS_SSQ), WSP(const float, WS_CS)};
    pg8::gemm_phase<pg8::EpiUp<true>, pg8::StaticOrder, true, PG8_SP2>(F.lds + RING_OFF, g, So, E, F.tid); }
PHASE ph_upkv(int l) { Frame F; make_frame(F);
    pg8::Gemm g{WSP(const pb, WS_HB) + H_KVA, WSP(const pb, WS_WKVB) + (size_t)l * KVW * 256, LDH, 256, 256}; pg8::StaticOrder So; So.init(S, KVW, F.G, F.c);
    pg8::EpiUp<false> E{WSP(pb, WS_KVB), KVW, WSP(const float, WS_SSQ), WSP(const float, WS_CS)};
    pg8::gemm_phase<pg8::EpiUp<false>, pg8::StaticOrder, true, PG8_SP2>(F.lds + RING_OFF, g, So, E, F.tid); }
PHASE ph_swa(int l) { Frame F; make_frame(F); const float* sinks = ptr_in(11) + l * 8; const float* relb = ptr_in(12);
    for (int u = F.c; u < 512; u += F.G) swa_unit(F, u >> 3, u & 7, WSP(const bf16, WS_HB), WSP(bf16, WS_MIX), sinks, relb); }
PHASE ph_gla1(int l) { Frame F; make_frame(F); const float* wg = ptr_in(8) + (size_t)l * 16 * 256; const float* bg = ptr_in(9) + l * 256; const float* ng = ptr_in(10) + l * 512;
    for (int u = F.c; u < 512; u += F.G) gla_unit<1>(F, u >> 2, u & 3, WSP(const bf16, WS_HB), wg, bg, WSP(float, WS_GUT), WSP(float, WS_GDEC), WSP(const bf16, WS_GSP), ng, WSP(bf16, WS_MIX)); }
PHASE ph_gla3(int l) { Frame F; make_frame(F); const float* wg = ptr_in(8) + (size_t)l * 16 * 256; const float* bg = ptr_in(9) + l * 256; const float* ng = ptr_in(10) + l * 512;
    for (int u = F.c; u < 512; u += F.G) gla_unit<3>(F, u >> 2, u & 3, WSP(const bf16, WS_HB), wg, bg, WSP(float, WS_GUT), WSP(float, WS_GDEC), WSP(const bf16, WS_GSP), ng, WSP(bf16, WS_MIX)); }
PHASE ph_scan() { Frame F; make_frame(F); gla_scan(F, WSP(const float, WS_GUT), WSP(const float, WS_GDEC), WSP(bf16, WS_GSP)); }
PHASE ph_mla(int l) { Frame F; make_frame(F);
    const int trk = (F.G == 256) ? l * TRK_PER_LAYER + F.c * NWAVES + F.wave : -1;
    const float* m_wg = ptr_in(20); const float* m_wu = ptr_in(21);
    for (int pr = F.c; pr < 256; pr += F.G) { const int h = pr & 7, qb = pr >> 3;
#pragma unroll 1
        for (int k = 0; k < 2; ++k) mla_unit(F, h, k ? qb : 63 - qb, WSP(const bf16, WS_QB), WSP(const bf16, WS_KVB), WSP(const bf16, WS_HB), WSP(bf16, WS_MIX), k ? 128 - 2 * qb : 0, trk, m_wg, m_wu, WSP(bf16, WS_MGU)); } }
PHASE ph_out(int l) { Frame F; make_frame(F);
    pg8::Gemm g{WSP(const pb, WS_MIX), WSP(const pb, WS_WOUT) + (size_t)l * DM * DM, DM, DM, DM}; pg8::StaticOrder So; So.init(S, DM, F.G, F.c);
    pg8::EpiOutRes E{WSP(float, WS_R2), DM, WSP(const pb, WS_XB), ALPHA};
    pg8::gemm_phase<pg8::EpiOutRes, pg8::StaticOrder, true, PG8_SP2>(F.lds + RING_OFF, g, So, E, F.tid); }
PHASE ph_ln1(int l) { Frame F; make_frame(F);
    ln_phase<0, false>(F, WSP(const void, WS_R2), nullptr, nullptr, ptr_in(14) + l * DM, ptr_in(15) + l * DM, nullptr, WSP(bf16, WS_X1B), nullptr); }
PHASE ph_ln1_route(int l) { Frame F; make_frame(F);
    ln_phase<0, true>(F, WSP(const void, WS_R2), nullptr, nullptr, ptr_in(14) + l * DM, ptr_in(15) + l * DM, nullptr, WSP(bf16, WS_X1B), ptr_in(19)); }
PHASE ph_gu_dense() { Frame F; make_frame(F);
    pg8::Gemm g{WSP(const pb, WS_X1B), WSP(const pb, WS_FGU), DM, DM, DM}; pg8::StaticOrder So; So.init(S, NGU, F.G, F.c);
    pg8::EpiSwiGLU E{WSP(pb, WS_HMID), DFF};
    pg8::gemm_phase<pg8::EpiSwiGLU, pg8::StaticOrder, true, PG8_SP2>(F.lds + RING_OFF, g, So, E, F.tid);
    if (F.G == 256 && F.c >= 256 - HOLE2_WG) { In I; load_in(I); bg_convert(F, I, N_HOLE0 + HOLE1_N, F.c - (256 - HOLE2_WG), HOLE2_WG, BGQ2); } }
PHASE ph_gather() { Frame F; make_frame(F); moe_gather(F, WSP(const bf16, WS_X1B), WSP(bf16, WS_XG)); }
PHASE ph_gu_moe() { Frame F; make_frame(F); moe_tables(F);
    pg8::Gemm g{WSP(const pb, WS_XG), WSP(const pb, WS_MGU), DM, DM, DM};
    pg8::MoeOrder<NGU / 256> Mo{(const PG8_LAS int*)(F.lds + TE_OFF), (const PG8_LAS int*)(F.lds + TE_OFF) + TBL, (const PG8_LAS int*)(F.lds + TE_OFF) + 2 * TBL, ((const LAS int*)(F.lds + TE_OFF))[MAXTILES], F.G, F.c};
    pg8::EpiSwiGLU E{WSP(pb, WS_HMID), DFF};
    pg8::gemm_phase<pg8::EpiSwiGLU, pg8::MoeOrder<NGU / 256>, true, PG8_SP2>(F.lds + RING_OFF, g, Mo, E, F.tid); }
PHASE ph_plegate(int l) { Frame F; make_frame(F);
    pg8::Gemm g{WSP(const pb, WS_X1B), WSP(const pb, WS_WPG) + (size_t)l * DM * DM, DM, DM, DM}; pg8::StaticOrder So; So.init(S, DM, F.G, F.c);
    pg8::EpiPle<0> E{WSP(pb, WS_PLE), DM, ptr_in(25) + l * DM};
    pg8::gemm_phase<pg8::EpiPle<0>, pg8::StaticOrder, true, PG8_SP2>(F.lds + RING_OFF, g, So, E, F.tid); }
PHASE ph_ple_light(int l) { Frame F; make_frame(F); moe_tables(F);
    const int ntot = ((const LAS int*)(F.lds + TE_OFF))[MAXTILES] * (DM / 256), nheavy = ntot - (ntot / F.G) * F.G;
    if (F.c < nheavy) return;
    pg8::StaticOrder So; So.init(S, DM, F.G - nheavy, F.c - nheavy);
    { pg8::Gemm g{WSP(const pb, WS_X1B), WSP(const pb, WS_WPG) + (size_t)l * DM * DM, DM, DM, DM}; pg8::EpiPle<0> E{WSP(pb, WS_PLE), DM, ptr_in(25) + l * DM};
      pg8::gemm_phase<pg8::EpiPle<0>, pg8::StaticOrder, true, PG8_SP2>(F.lds + RING_OFF, g, So, E, F.tid); }
    { pg8::Gemm g{WSP(const pb, WS_PB) + (size_t)l * S * PLE, WSP(const pb, WS_WPU) + (size_t)l * DM * PLE, PLE, PLE, PLE}; pg8::EpiPle<1> E{WSP(pb, WS_PLE), DM, nullptr};
      pg8::gemm_phase<pg8::EpiPle<1>, pg8::StaticOrder, true, PG8_SP2>(F.lds + RING_OFF, g, So, E, F.tid); } }
PHASE ph_down_dense() { Frame F; make_frame(F);
    pg8::Gemm g{WSP(const pb, WS_HMID), WSP(const pb, WS_FD), DFF, DFF, DFF}; pg8::StaticOrder So; So.init(S, DM, F.G, F.c);
    pg8::EpiBf16 E{WSP(pb, WS_R2), DM};
    pg8::gemm_phase<pg8::EpiBf16, pg8::StaticOrder, true, PG8_SP2>(F.lds + RING_OFF, g, So, E, F.tid); }
PHASE ph_down_moe() { Frame F; make_frame(F); moe_tables(F);
    pg8::Gemm g{WSP(const pb, WS_HMID), WSP(const pb, WS_MD), DFF, DFF, DFF};
    pg8::MoeOrder<DM / 256> Mo{(const PG8_LAS int*)(F.lds + TE_OFF), (const PG8_LAS int*)(F.lds + TE_OFF) + TBL, (const PG8_LAS int*)(F.lds + TE_OFF) + 2 * TBL, ((const LAS int*)(F.lds + TE_OFF))[MAXTILES], F.G, F.c};
    pg8::EpiBf16 E{WSP(pb, WS_R2), DM};
    pg8::gemm_phase<pg8::EpiBf16, pg8::MoeOrder<DM / 256>, true, PG8_SP2>(F.lds + RING_OFF, g, Mo, E, F.tid); }
PHASE ph_pleup(int l) { Frame F; make_frame(F);
    pg8::Gemm g{WSP(const pb, WS_PB) + (size_t)l * S * PLE, WSP(const pb, WS_WPU) + (size_t)l * DM * PLE, PLE, PLE, PLE}; pg8::StaticOrder So; So.init(S, DM, F.G, F.c);
    pg8::EpiPle<1> E{WSP(pb, WS_PLE), DM, nullptr};
    pg8::gemm_phase<pg8::EpiPle<1>, pg8::StaticOrder, true, PG8_SP2>(F.lds + RING_OFF, g, So, E, F.tid); }
PHASE ph_ln2_dense(int l) { Frame F; make_frame(F);
    ln_phase<1, false>(F, WSP(const void, WS_R2), WSP(const bf16, WS_X1B), WSP(const bf16, WS_PLE), ptr_in(26) + l * DM, ptr_in(27) + l * DM, nullptr, WSP(bf16, WS_XB), nullptr); }
PHASE ph_ln2_moe(int l) { Frame F; make_frame(F);
    ln_phase<2, false>(F, WSP(const void, WS_R2), WSP(const bf16, WS_X1B), WSP(const bf16, WS_PLE), ptr_in(26) + l * DM, ptr_in(27) + l * DM, (float*)ptr_in(28), nullptr, nullptr); }
PHASE ph_bar() { Frame F; make_frame(F); XcdBarrier bar; bar.bar = (unsigned*)(F.ctl + CW_BAR); bar.x = xb_xcc_id(); bar.st = F.MISC + 8; xcd_barrier(bar); }

struct Args { const float* in[28]; float* out; unsigned char* ws; };
__global__ void __launch_bounds__(NWAVES * 64, 2) fwd_kernel(Args args) {
    { LAS unsigned char* L = (LAS unsigned char*)lds_dyn;
      for (int u = threadIdx.x; u < (LDS_BYTES - LDSCTL_OFF) / 4; u += NWAVES * 64) ((LAS unsigned*)(L + LDSCTL_OFF))[u] = 0u;
      __syncthreads();
      if (threadIdx.x == 0) { LAS unsigned long long* pt = (LAS unsigned long long*)(L + PT_OFF);
#pragma unroll
          for (int i = 0; i < 28; ++i) pt[i] = (unsigned long long)args.in[i];
          pt[28] = (unsigned long long)args.out; pt[29] = (unsigned long long)args.ws; }
      __syncthreads();
      (void)xcd_barrier_post((unsigned*)((gu32*)(args.ws + WS_CTL) + CW_BAR), (volatile LAS unsigned*)(L + MISC_OFF) + 8); }
#ifndef DUP
#define DUP 0
#endif
#define D(bit, call) do { call; if (DUP & (bit)) { call; } } while (0)
#ifdef ONLY
    ONLY; ph_bar();
#else
    D(1, ph_prologue()); ph_bar();
    D(2, ph_in(0)); ph_bar();
    D(4, ph_upq(0)); D(4, ph_upkv(0)); D(8, ph_swa(0)); D(16, ph_gla1(0)); ph_bar();
    D(32, ph_scan()); D(64, ph_mla(0)); ph_bar();
    D(128, ph_gla3(0)); ph_bar();
    D(256, ph_out(0)); ph_bar();
    D(512, ph_ln1(0)); ph_bar();
    D(1024, ph_gu_dense()); D(2048, ph_plegate(0)); ph_bar();
    D(4096, ph_down_dense()); ph_pleup(0); ph_bar();
    D(512, ph_ln2_dense(0)); ph_bar();
    D(2, ph_in(1)); ph_bar();
    D(4, ph_upq(1)); D(4, ph_upkv(1)); D(8, ph_swa(1)); D(16, ph_gla1(1)); ph_bar();
    D(32, ph_scan()); D(64, ph_mla(1)); ph_bar();
    D(128, ph_gla3(1)); ph_bar();
    D(256, ph_out(1)); ph_bar();
    ph_ln1_route(1); ph_bar();
    D(8192, ph_gather()); ph_bar();
#ifdef PLE_LIGHT
    D(16384, ph_gu_moe()); ph_bar();
    D(32768, ph_down_moe()); ph_ple_light(1); ph_bar();
#else
    D(16384, ph_gu_moe()); D(2048, ph_plegate(1)); ph_bar();
    D(32768, ph_down_moe()); ph_pleup(1); ph_bar();
#endif
    ph_ln2_moe(1);
#endif
}

extern "C" void kernel_launch(void* const* d_in, const int* in_sizes, int n_in, void* d_out, int out_size, void* d_ws, size_t ws_size, hipStream_t stream) {
    static int grid = 0;
    if (grid == 0) {
        if (n_in != 28 || in_sizes[0] != S * DM || out_size != S * DM || ws_size < WS_END) { fprintf(stderr, "kernel_launch: unexpected shapes / workspace (n_in %d, ws %zu, need %zu); nothing launched\n", n_in, ws_size, (size_t)WS_END); grid = -1; return; }
        int dev = 0, cus = 0, per_cu = 0;
        if (hipGetDevice(&dev) != hipSuccess || hipDeviceGetAttribute(&cus, hipDeviceAttributeMultiprocessorCount, dev) != hipSuccess) { grid = -1; return; }
        if (hipFuncSetAttribute((const void*)fwd_kernel, hipFuncAttributeMaxDynamicSharedMemorySize, LDS_BYTES) != hipSuccess) { fprintf(stderr, "kernel_launch: hipFuncSetAttribute failed\n"); grid = -1; return; }
        if (hipOccupancyMaxActiveBlocksPerMultiprocessor(&per_cu, (const void*)fwd_kernel, NWAVES * 64, LDS_BYTES) != hipSuccess || per_cu < 1) { fprintf(stderr, "kernel_launch: occupancy query reports %d workgroups per CU\n", per_cu); (void)hipGetLastError(); grid = -1; return; }
        grid = cus;
    }
    if (grid < 0) return;
    if (hipMemsetAsync((char*)d_ws + WS_CTL, 0, CTL_ZERO_BYTES, stream) != hipSuccess) return;
    Args a{};
    for (int i = 0; i < 28; ++i) a.in[i] = (const float*)d_in[i];
    a.out = (float*)d_out; a.ws = (unsigned char*)d_ws;
    hipLaunchKernelGGL(fwd_kernel, dim3(grid), dim3(NWAVES * 64), LDS_BYTES, stream, a);
}
```
